# Optimizing an MI355X kernel written in HIP

```python
import jax, jax.numpy as jnp
from jax import lax
import numpy as np

D_MODEL = 2048
BATCH = 4
SEQ = 4096
DEPTH = 4

N_MIXERS = 2
N_HEADS = 16
N_KV_HEADS = 4
HEAD_DIM = D_MODEL // N_HEADS
GROUP = N_HEADS // N_KV_HEADS
ROPE_DIM = HEAD_DIM // 4
ROPE_THETA = 500000.0
IDX_HEADS = 16
IDX_DIM = 64
IDX_ROPE_DIM = IDX_DIM // 4
TOPK_MAX = 256
Q_BLOCK = 128
Q_W = N_HEADS * HEAD_DIM
KV_W = N_KV_HEADS * HEAD_DIM
IDX_Q_W = IDX_HEADS * IDX_DIM
ATTN_PROJ = Q_W + 2 * KV_W + IDX_Q_W + IDX_DIM + IDX_HEADS
CONV_WIDTH = 3
D_FF = 4 * D_MODEL
EPS = 1e-6
N_ATTN_LAYERS = (DEPTH + 1) // 2
N_CONV_LAYERS = DEPTH // 2
MAX_POS_OFFSET = 1024

kernel_name = "hybrid_dsa_shortconv_sqrelu_trunk"


def _rmsnorm(x, g):
    xf = x.astype(jnp.float32)
    y = xf * lax.rsqrt(jnp.mean(xf * xf, axis=-1, keepdims=True) + EPS)
    return (y * g.astype(jnp.float32)).astype(x.dtype)


def _rope_tables(positions, rot_dim, dtype):
    inv = ROPE_THETA ** (-jnp.arange(0, rot_dim, 2, dtype=jnp.float32) / rot_dim)
    ang = positions.astype(jnp.float32)[..., None] * inv
    return jnp.cos(ang)[:, :, None, :].astype(dtype), jnp.sin(ang)[:, :, None, :].astype(dtype)


def _partial_rope(x, cos, sin):
    half = cos.shape[-1]
    x1 = x[..., :half]
    x2 = x[..., half:2 * half]
    return jnp.concatenate([x1 * cos - x2 * sin, x2 * cos + x1 * sin, x[..., 2 * half:]], axis=-1)


def _dsa_mixer(h, w_in, q_g, k_g, w_out, positions):
    B, S, _ = h.shape
    proj = h @ w_in
    cuts = [Q_W, Q_W + KV_W, Q_W + 2 * KV_W, Q_W + 2 * KV_W + IDX_Q_W,
            Q_W + 2 * KV_W + IDX_Q_W + IDX_DIM]
    q, k, v, qi, ki, wi = jnp.split(proj, cuts, axis=-1)
    q = _rmsnorm(q.reshape(B, S, N_HEADS, HEAD_DIM), q_g)
    k = _rmsnorm(k.reshape(B, S, N_KV_HEADS, HEAD_DIM), k_g)
    v = v.reshape(B, S, N_KV_HEADS, HEAD_DIM)
    cos, sin = _rope_tables(positions, ROPE_DIM, h.dtype)
    q = _partial_rope(q, cos, sin)
    k = _partial_rope(k, cos, sin)
    ci, si = _rope_tables(positions, IDX_ROPE_DIM, h.dtype)
    qi = _partial_rope(qi.reshape(B, S, IDX_HEADS, IDX_DIM), ci, si)
    ki = _partial_rope(ki.reshape(B, S, 1, IDX_DIM), ci, si)[:, :, 0]
    wi = wi * (IDX_HEADS ** -0.5 * IDX_DIM ** -0.5)

    top_k = min(TOPK_MAX, S // 4)
    qb = min(Q_BLOCK, S)
    nb = S // qb
    scale = HEAD_DIM ** -0.5
    key_pos = jnp.arange(S)

    def to_blocks(a):
        return a.reshape((B, nb, qb) + a.shape[2:]).swapaxes(0, 1)

    def block(args):
        q_blk, qi_blk, wi_blk, b_idx = args
        t = b_idx * qb + jnp.arange(qb)
        rel = jax.nn.relu(jnp.einsum('bqhd,bsd->bqhs', qi_blk, ki)).astype(jnp.float32)
        score = jnp.einsum('bqhs,bqh->bqs', rel, wi_blk.astype(jnp.float32))
        causal = key_pos[None, :] <= t[:, None]
        score = jnp.where(causal[None], score, -jnp.inf)
        _, idx = lax.top_k(score, top_k)
        valid = idx <= t[None, :, None]
        k_sel = jax.vmap(lambda kb, ib: kb[ib])(k, idx)
        v_sel = jax.vmap(lambda vb, ib: vb[ib])(v, idx)
        qg = q_blk.reshape(B, qb, N_KV_HEADS, GROUP, HEAD_DIM)
        s = jnp.einsum('bqngd,bqknd->bqngk', qg, k_sel).astype(jnp.float32) * scale
        s = jnp.where(valid[:, :, None, None, :], s, -jnp.inf)
        p = jax.nn.softmax(s, axis=-1).astype(v.dtype)
        o = jnp.einsum('bqngk,bqknd->bqngd', p, v_sel)
        return o.reshape(B, qb, Q_W)

    out = lax.map(block, (to_blocks(q), to_blocks(qi), to_blocks(wi), jnp.arange(nb)))
    out = out.swapaxes(0, 1).reshape(B, S, Q_W)
    return out @ w_out


def _short_conv_mixer(h, w_in, conv_w, w_out):
    S = h.shape[1]
    b_gate, c_gate, u = jnp.split(h @ w_in, 3, axis=-1)
    z = c_gate * u
    zp = jnp.pad(z, ((0, 0), (CONV_WIDTH - 1, 0), (0, 0)))
    y = sum(zp[:, j:j + S] * conv_w[j] for j in range(CONV_WIDTH))
    return (b_gate * y) @ w_out


def _sqrelu_mlp(h, w1, w2):
    a = jax.nn.relu(h @ w1)
    return (a * a) @ w2


def setup_inputs(seed: int = 0) -> dict:
    key = jax.random.key(seed)
    ks = jax.random.split(key, 16)
    f32 = jnp.float32

    def nrm(k, shape, fan_in):
        return jax.random.normal(k, shape, f32) * (fan_in ** -0.5)

    def gain(k, shape):
        return 1.0 + 0.02 * jax.random.normal(k, shape, f32)

    x = jax.random.normal(ks[0], (BATCH, SEQ, D_MODEL), f32)
    offs = jax.random.randint(ks[1], (BATCH, 1), 0, MAX_POS_OFFSET, dtype=jnp.int32)
    positions = offs + jnp.arange(SEQ, dtype=jnp.int32)[None, :]
    return {
        "x": x,
        "positions": positions,
        "attn_norm_g": gain(ks[2], (N_ATTN_LAYERS, D_MODEL)),
        "attn_w_in": nrm(ks[3], (N_ATTN_LAYERS, D_MODEL, ATTN_PROJ), D_MODEL),
        "attn_q_norm_g": gain(ks[4], (N_ATTN_LAYERS, HEAD_DIM)),
        "attn_k_norm_g": gain(ks[5], (N_ATTN_LAYERS, HEAD_DIM)),
        "attn_w_out": nrm(ks[6], (N_ATTN_LAYERS, Q_W, D_MODEL), Q_W),
        "conv_norm_g": gain(ks[7], (N_CONV_LAYERS, D_MODEL)),
        "conv_w_in": nrm(ks[8], (N_CONV_LAYERS, D_MODEL, 3 * D_MODEL), D_MODEL),
        "conv_w": nrm(ks[9], (N_CONV_LAYERS, CONV_WIDTH, D_MODEL), CONV_WIDTH),
        "conv_w_out": nrm(ks[10], (N_CONV_LAYERS, D_MODEL, D_MODEL), D_MODEL),
        "mlp_norm_g": gain(ks[11], (DEPTH, D_MODEL)),
        "mlp_w1": nrm(ks[12], (DEPTH, D_MODEL, D_FF), D_MODEL),
        "mlp_w2": nrm(ks[13], (DEPTH, D_FF, D_MODEL), D_FF),
    }


def reference(x, positions, attn_norm_g, attn_w_in, attn_q_norm_g, attn_k_norm_g, attn_w_out,
              conv_norm_g, conv_w_in, conv_w, conv_w_out, mlp_norm_g, mlp_w1, mlp_w2):
    for i in range(DEPTH):
        j = i // N_MIXERS
        if i % N_MIXERS == 0:
            x = x + _dsa_mixer(_rmsnorm(x, attn_norm_g[j]), attn_w_in[j], attn_q_norm_g[j],
                               attn_k_norm_g[j], attn_w_out[j], positions)
        else:
            x = x + _short_conv_mixer(_rmsnorm(x, conv_norm_g[j]), conv_w_in[j], conv_w[j],
                                      conv_w_out[j])
        x = x + _sqrelu_mlp(_rmsnorm(x, mlp_norm_g[i]), mlp_w1[i], mlp_w2[i])
    return x
```

```cpp
#define MK_PER_PHASE 0
#include <hip/hip_runtime.h>
#include <cstdio>
#include <cstdint>
namespace pg8 {
#define PG8_LAS __attribute__((address_space(3)))
typedef unsigned short bf16_t;
typedef short bf16x8 __attribute__((ext_vector_type(8)));
typedef float f32x4 __attribute__((ext_vector_type(4)));
typedef unsigned u32x4 __attribute__((ext_vector_type(4)));
constexpr int BM = 256, BK = 64, HALF = 128, HTB = HALF * BK * 2  , STAGE_BYTES = 8 * HTB, NXCD = 8, WGM = 8;

__host__ __device__ __forceinline__ int lds_byte(int r, int c) { const int st = (r >> 4) * 2 + (c >> 5), rr = r & 15, cc = c & 31, ob = rr * 64 + cc * 2; return st * 1024 + (ob ^ (((ob >> 9) & 1) << 5)); }
__host__ __device__ __forceinline__ void stage_rc(int b, int& R, int& C) { const int st = b / 1024, sb = b % 1024, swz = sb ^ (((sb >> 9) & 1) << 5); R = (st >> 1) * 16 + swz / 64; C = (st & 1) * 32 + (swz % 64) / 2; }
__host__ __device__ __forceinline__ int perm32(int rho) { const int n = rho >> 4, i = rho & 15; return 8 * (i >> 2) + 4 * n + (i & 3); }

struct Unit { int pm, pn; };
struct Gemm { const bf16_t* A; const bf16_t* Bt; int M, N, K; };

struct StaticOrder {
    int nM, nN, nwg, G, c;
    __host__ __device__ void init(int M, int N, int G_, int c_) { nM = M / BM; nN = N / BM; nwg = nM * nN; G = G_; c = c_; }
    __host__ __device__ bool next(int i, Unit& u) const {
        const long L = (long)i * G + c; if (L >= nwg) return false;
        int wgid = (int)L; { const int q = nwg / NXCD, r = nwg % NXCD, xcd = wgid % NXCD, off = wgid / NXCD; wgid = (xcd < r ? xcd * (q + 1) : r * (q + 1) + (xcd - r) * q) + off; }
        const int nig = WGM * nN, gid = wgid / nig, fm = gid * WGM, gsz = (nM - fm) < WGM ? (nM - fm) : WGM;
        u.pm = fm + ((wgid % nig) % gsz); u.pn = (wgid % nig) / gsz; return true;
    }
    __device__ __forceinline__ void a_ready(const Unit&) const {}
    __device__ __forceinline__ void done(const Unit&) const {}
};
__device__ __forceinline__ unsigned cvt_pk_bf16(float lo, float hi) { unsigned r; asm volatile("v_cvt_pk_bf16_f32 %0, %1, %2" : "=v"(r) : "v"(lo), "v"(hi)); return r; }
typedef unsigned u32x2 __attribute__((ext_vector_type(2)));
constexpr float RMS_EPS = 1e-6f;
typedef unsigned long long ssq_t;
__device__ __forceinline__ float rstd_of(ssq_t ssq) { return __builtin_amdgcn_rsqf((float)ssq * (1.0f / (2048.0f * 1048576.0f)) + RMS_EPS); }
__device__ __forceinline__ ssq_t ssq_fix(float s) { return (ssq_t)(s * 1048576.0f + 0.5f); }

struct EpiRes {
    static constexpr bool PERM = false, AFTER_DRAIN = false;
    const float* base; float* out; bf16_t* xb; ssq_t* ssq;
    __device__ __forceinline__ void operator()(const f32x4 (&acc)[2][2][4][2], const Unit& u, int wr, int wc, int fr, int fq) const {
        const int row0 = u.pm * BM + wr * 64 + fr, col0 = u.pn * BM + wc * 32 + 4 * fq;
#pragma unroll
        for (int ai = 0; ai < 2; ++ai)
#pragma unroll
            for (int m = 0; m < 4; ++m) {
                const int row = row0 + ai * HALF + m * 16; const size_t off = (size_t)row * 2048 + col0; float s = 0.f;
#pragma unroll
                for (int bj = 0; bj < 2; ++bj)
#pragma unroll
                    for (int n = 0; n < 2; ++n) {
                        const f32x4 b = *(const f32x4*)(base + off + bj * HALF + n * 16);
                        const f32x4 o = b + acc[ai][bj][m][n];
                        *(f32x4*)(out + off + bj * HALF + n * 16) = o;
                        s += (o[0] * o[0] + o[1] * o[1]) + (o[2] * o[2] + o[3] * o[3]);
                        u32x2 w; w.x = cvt_pk_bf16(o[0], o[1]); w.y = cvt_pk_bf16(o[2], o[3]);
                        *(u32x2*)(xb + off + bj * HALF + n * 16) = w;
                    }
                s += __shfl_xor(s, 16); s += __shfl_xor(s, 32);
                if (fq == 0) __hip_atomic_fetch_add(ssq + row, ssq_fix(s), __ATOMIC_RELAXED, __HIP_MEMORY_SCOPE_AGENT);
                asm volatile("" ::: "memory");
            }
    }
};

struct EpiM1 {
    static constexpr bool PERM = true, AFTER_DRAIN = false;
    bf16_t* H; const ssq_t* ssq;
    __device__ __forceinline__ void operator()(const f32x4 (&acc)[2][2][4][2], const Unit& u, int wr, int wc, int fr, int fq) const {
        const int row0 = u.pm * BM + wr * 64 + fr, col0 = u.pn * BM + wc * 32 + 8 * fq;
#pragma unroll
        for (int ai = 0; ai < 2; ++ai)
#pragma unroll
            for (int m = 0; m < 4; ++m) {
                const int row = row0 + ai * HALF + m * 16; const float r = rstd_of(ssq[row]); bf16_t* rowp = H + (size_t)row * 8192 + col0;
#pragma unroll
                for (int bj = 0; bj < 2; ++bj) {
                    f32x4 v0 = acc[ai][bj][m][0] * r, v1 = acc[ai][bj][m][1] * r;
#pragma unroll
                    for (int j = 0; j < 4; ++j) { v0[j] = fmaxf(v0[j], 0.f); v1[j] = fmaxf(v1[j], 0.f); }
                    v0 = v0 * v0; v1 = v1 * v1;
                    u32x4 w; w.x = cvt_pk_bf16(v0[0], v0[1]); w.y = cvt_pk_bf16(v0[2], v0[3]); w.z = cvt_pk_bf16(v1[0], v1[1]); w.w = cvt_pk_bf16(v1[2], v1[3]);
                    *(u32x4*)(rowp + bj * HALF) = w; }
            }
    }
};

struct EpiC1 {
    static constexpr bool PERM = true, AFTER_DRAIN = false;
    bf16_t* Bg; bf16_t* Z; const ssq_t* ssq;
    __device__ __forceinline__ void operator()(const f32x4 (&acc)[2][2][4][2], const Unit& u, int wr, int wc, int fr, int fq) const {
        const int row0 = u.pm * BM + wr * 64 + fr;
        if (u.pn < 8) {
            const int col0 = u.pn * BM + wc * 32 + 8 * fq;
#pragma unroll
            for (int ai = 0; ai < 2; ++ai)
#pragma unroll
                for (int m = 0; m < 4; ++m) {
                    const int row = row0 + ai * HALF + m * 16; const float r = rstd_of(ssq[row]); bf16_t* rowp = Bg + (size_t)row * 2048 + col0;
#pragma unroll
                    for (int bj = 0; bj < 2; ++bj) {
                        const f32x4 v0 = acc[ai][bj][m][0] * r, v1 = acc[ai][bj][m][1] * r;
                        u32x4 w; w.x = cvt_pk_bf16(v0[0], v0[1]); w.y = cvt_pk_bf16(v0[2], v0[3]); w.z = cvt_pk_bf16(v1[0], v1[1]); w.w = cvt_pk_bf16(v1[2], v1[3]);
                        *(u32x4*)(rowp + bj * HALF) = w; }
                }
        } else {
            const int col0 = (u.pn - 8) * HALF + wc * 32 + 8 * fq;
#pragma unroll
            for (int ai = 0; ai < 2; ++ai)
#pragma unroll
                for (int m = 0; m < 4; ++m) {
                    const int row = row0 + ai * HALF + m * 16; const float r = rstd_of(ssq[row]); const float r2 = r * r;
                    const f32x4 v0 = acc[ai][0][m][0] * acc[ai][1][m][0] * r2, v1 = acc[ai][0][m][1] * acc[ai][1][m][1] * r2;
                    u32x4 w; w.x = cvt_pk_bf16(v0[0], v0[1]); w.y = cvt_pk_bf16(v0[2], v0[3]); w.z = cvt_pk_bf16(v1[0], v1[1]); w.w = cvt_pk_bf16(v1[2], v1[3]);
                    *(u32x4*)(Z + (size_t)row * 2048 + col0) = w;
                }
        }
    }
};

struct EpiA1 {
    static constexpr bool PERM = false, AFTER_DRAIN = false;
    const ssq_t* ssq; bf16_t *Q, *K, *V, *QI, *KI; float* WI; const float *qg, *kg, *ropeM, *ropeI; PG8_LAS float* P;
    __device__ __forceinline__ void operator()(const f32x4 (&acc)[2][2][4][2], const Unit& u, int wr, int wc, int fr, int fq) const {
        const int pn = u.pn, rl0 = wr * 64 + fr, row0 = u.pm * BM + rl0;
        if (pn < 10) {
            const bool isq = pn < 8; const float* g = isq ? qg : kg;
            const f32x4 g0 = *(const f32x4*)(g + 32 * wc + 4 * fq), g1 = *(const f32x4*)(g + 32 * wc + 16 + 4 * fq);
#pragma unroll
            for (int ai = 0; ai < 2; ++ai)
#pragma unroll
                for (int m = 0; m < 4; ++m) { const int rl = rl0 + ai * HALF + m * 16;
#pragma unroll
                    for (int bj = 0; bj < 2; ++bj) { const f32x4 a = acc[ai][bj][m][0], b = acc[ai][bj][m][1];
                        float s = ((a[0] * a[0] + a[1] * a[1]) + (a[2] * a[2] + a[3] * a[3])) + ((b[0] * b[0] + b[1] * b[1]) + (b[2] * b[2] + b[3] * b[3]));
                        s += __shfl_xor(s, 16); s += __shfl_xor(s, 32);
                        if (fq == 0) P[(rl * 2 + bj) * 4 + wc] = s; } }
            asm volatile("s_waitcnt lgkmcnt(0)" ::: "memory"); __builtin_amdgcn_s_barrier(); asm volatile("" ::: "memory");
#pragma unroll
            for (int ai = 0; ai < 2; ++ai)
#pragma unroll
                for (int m = 0; m < 4; ++m) { const int rl = rl0 + ai * HALF + m * 16, row = row0 + ai * HALF + m * 16; const float rs = rstd_of(ssq[row]);
                    f32x4 cs = {1.f, 1.f, 1.f, 1.f}, sn = {0.f, 0.f, 0.f, 0.f};
                    if (wc == 0) { cs = *(const f32x4*)(ropeM + (size_t)row * 32 + 4 * fq); sn = *(const f32x4*)(ropeM + (size_t)row * 32 + 16 + 4 * fq); }
                    bf16_t* dst = isq ? Q + (size_t)row * 2048 + pn * BM + wc * 32 + 4 * fq : K + (size_t)row * 512 + (pn - 8) * BM + wc * 32 + 4 * fq;
#pragma unroll
                    for (int bj = 0; bj < 2; ++bj) { const f32x4 pp = *(const PG8_LAS f32x4*)(P + (rl * 2 + bj) * 4);
                        const float tot = (pp[0] + pp[1]) + (pp[2] + pp[3]);
                        const float sc = rs * __builtin_amdgcn_rsqf(rs * rs * tot * (1.0f / 128.0f) + RMS_EPS);
                        f32x4 v0 = acc[ai][bj][m][0] * sc * g0, v1 = acc[ai][bj][m][1] * sc * g1;
                        if (wc == 0) { const f32x4 x1 = v0, x2 = v1; v0 = x1 * cs - x2 * sn; v1 = x2 * cs + x1 * sn; }
                        u32x2 w0, w1; w0.x = cvt_pk_bf16(v0[0], v0[1]); w0.y = cvt_pk_bf16(v0[2], v0[3]); w1.x = cvt_pk_bf16(v1[0], v1[1]); w1.y = cvt_pk_bf16(v1[2], v1[3]);
                        *(u32x2*)(dst + bj * HALF) = w0; *(u32x2*)(dst + bj * HALF + 16) = w1; } }
        } else if (pn < 12) {
#pragma unroll
            for (int ai = 0; ai < 2; ++ai)
#pragma unroll
                for (int m = 0; m < 4; ++m) { const int row = row0 + ai * HALF + m * 16; const float rs = rstd_of(ssq[row]);
                    bf16_t* dst = V + (size_t)row * 512 + (pn - 10) * BM + wc * 32 + 4 * fq;
#pragma unroll
                    for (int bj = 0; bj < 2; ++bj) { const f32x4 v0 = acc[ai][bj][m][0] * rs, v1 = acc[ai][bj][m][1] * rs;
                        u32x2 w0, w1; w0.x = cvt_pk_bf16(v0[0], v0[1]); w0.y = cvt_pk_bf16(v0[2], v0[3]); w1.x = cvt_pk_bf16(v1[0], v1[1]); w1.y = cvt_pk_bf16(v1[2], v1[3]);
                        *(u32x2*)(dst + bj * HALF) = w0; *(u32x2*)(dst + bj * HALF + 16) = w1; } }
        } else {
            const bool rot = ((wc & 1) == 0) && fq < 2;
            const int d0 = (wc & 1) ? 32 + 4 * fq : (fq < 2 ? 4 * fq : 16 + 4 * (fq - 2)), d1 = (wc & 1) ? 48 + 4 * fq : (fq < 2 ? 8 + 4 * fq : 24 + 4 * (fq - 2));
            const bool iski = pn == 16;
#pragma unroll
            for (int ai = 0; ai < 2; ++ai)
#pragma unroll
                for (int m = 0; m < 4; ++m) { const int row = row0 + ai * HALF + m * 16; const float rs = rstd_of(ssq[row]);
                    f32x4 cs = {1.f, 1.f, 1.f, 1.f}, sn = {0.f, 0.f, 0.f, 0.f};
                    if (rot) { cs = *(const f32x4*)(ropeI + (size_t)row * 16 + 4 * fq); sn = *(const f32x4*)(ropeI + (size_t)row * 16 + 8 + 4 * fq); }
#pragma unroll
                    for (int bj = 0; bj < 2; ++bj) {
                        f32x4 v0 = acc[ai][bj][m][0] * rs, v1 = acc[ai][bj][m][1] * rs;
                        if (iski) {
                            if (bj == 0) {
                                if (wc < 2) { if (rot) { const f32x4 x1 = v0, x2 = v1; v0 = x1 * cs - x2 * sn; v1 = x2 * cs + x1 * sn; }
                                    u32x2 w0, w1; w0.x = cvt_pk_bf16(v0[0], v0[1]); w0.y = cvt_pk_bf16(v0[2], v0[3]); w1.x = cvt_pk_bf16(v1[0], v1[1]); w1.y = cvt_pk_bf16(v1[2], v1[3]);
                                    bf16_t* dst = KI + (size_t)row * 64; *(u32x2*)(dst + d0) = w0; *(u32x2*)(dst + d1) = w1; }
                                else if (wc == 2) { *(f32x4*)(WI + (size_t)row * 16 + 4 * fq) = v0 * 0.03125f; }
                            }
                        } else {
                            if (rot) { const f32x4 x1 = v0, x2 = v1; v0 = x1 * cs - x2 * sn; v1 = x2 * cs + x1 * sn; }
                            u32x2 w0, w1; w0.x = cvt_pk_bf16(v0[0], v0[1]); w0.y = cvt_pk_bf16(v0[2], v0[3]); w1.x = cvt_pk_bf16(v1[0], v1[1]); w1.y = cvt_pk_bf16(v1[2], v1[3]);
                            bf16_t* dst = QI + (size_t)row * 1024 + ((pn - 12) * 4 + 2 * bj + (wc >> 1)) * 64; *(u32x2*)(dst + d0) = w0; *(u32x2*)(dst + d1) = w1; }
                    } }
        }
    }
};
template <class Epi, class Sched, bool ALIGN_EPI = false, bool SP2 = false>
__device__ __forceinline__ void gemm_phase(PG8_LAS unsigned char* lds, const Gemm g, const Sched& S, const Epi& E) {
    const int tid = threadIdx.x, wid = __builtin_amdgcn_readfirstlane(tid >> 6), lane = tid & 63, wr = wid >> 2, wc = wid & 3, fr = lane & 15, fq = lane >> 4;
    const int K = g.K, nt = K / BK;
    unsigned voffA[2], voffB[2];
#pragma unroll
    for (int i = 0; i < 2; ++i) { int R, C; stage_rc(tid * 16 + i * 8192, R, C); const int Rb = Epi::PERM ? ((R & ~31) + perm32(R & 31)) : R;
        voffA[i] = (unsigned)(R * K + C) * 2u; voffB[i] = (unsigned)(Rb * K + C) * 2u; }
    const size_t kstep = (size_t)(BK * 2);
    const size_t hstep = (size_t)HALF * K * 2;
    const size_t tstep = 2 * hstep;
    const unsigned ldsw = (unsigned)wid * 1024u;
    const int aoff = lds_byte(wr * 64 + fr, fq * 8), boff = lds_byte(wc * 32 + fr, fq * 8);
#define PG8_SA(b, h) (((b) * 2 + (h)) * HTB)
#define PG8_SB(b, h) ((4 + (b) * 2 + (h)) * HTB)
#define PG8_STAGE(bufoff, gbase, voff) do { _Pragma("unroll") for (int _i = 0; _i < 2; ++_i) \
        __builtin_amdgcn_global_load_lds((const unsigned*)((const char*)(gbase) + (voff)[_i]), (PG8_LAS unsigned*)(lds + (bufoff) + ldsw + _i * 8192), 16, 0, 0); } while (0)
#define PG8_LDA(dst, b, h) do { _Pragma("unroll") for (int m = 0; m < 4; ++m) _Pragma("unroll") for (int k = 0; k < 2; ++k) dst[m][k] = *(const PG8_LAS bf16x8*)(lds + PG8_SA(b, h) + aoff + m * 2048 + k * 1024); } while (0)
#define PG8_LDB(dst, b, h) do { _Pragma("unroll") for (int n = 0; n < 2; ++n) _Pragma("unroll") for (int k = 0; k < 2; ++k) dst[n][k] = *(const PG8_LAS bf16x8*)(lds + PG8_SB(b, h) + boff + n * 2048 + k * 1024); } while (0)
#define PG8_MMA(ai, bj, At, Bt) do { __builtin_amdgcn_s_setprio(1); _Pragma("unroll") for (int m = 0; m < 4; ++m) _Pragma("unroll") for (int n = 0; n < 2; ++n) _Pragma("unroll") for (int k = 0; k < 2; ++k) \
        acc[ai][bj][m][n] = __builtin_amdgcn_mfma_f32_16x16x32_bf16(Bt[n][k], At[m][k], acc[ai][bj][m][n], 0, 0, 0); __builtin_amdgcn_s_setprio(0); } while (0)
#define PG8_WAIT_V(n) asm volatile("s_waitcnt vmcnt(" #n ")" ::: "memory")
#define PG8_WAIT_L(n) asm volatile("s_waitcnt lgkmcnt(" #n ")" ::: "memory")
#define PG8_BAR __builtin_amdgcn_s_barrier()
#define PG8_SCHED __builtin_amdgcn_sched_barrier(0)
    Unit cur, nxt; int ui = 0;
    if (!S.next(0, cur)) return;
    f32x4 acc[2][2][4][2];
#pragma unroll
    for (int a = 0; a < 2; ++a)
#pragma unroll
        for (int b = 0; b < 2; ++b)
#pragma unroll
            for (int m = 0; m < 4; ++m)
#pragma unroll
                for (int n = 0; n < 2; ++n) acc[a][b][m][n] = (f32x4){0.f, 0.f, 0.f, 0.f};
    bf16x8 At[4][2], B0[2][2], B1[2][2];
    const char* cA = (const char*)g.A + (size_t)cur.pm * tstep; const char* cB = (const char*)g.Bt + (size_t)cur.pn * tstep;
    S.a_ready(cur);
    if constexpr (SP2) {
        PG8_STAGE(PG8_SB(0, 0), cB, voffB); PG8_STAGE(PG8_SB(0, 1), cB + hstep, voffB); PG8_STAGE(PG8_SA(0, 0), cA, voffA); PG8_STAGE(PG8_SA(0, 1), cA + hstep, voffA);
        if (wr == 1) PG8_BAR;
        PG8_WAIT_V(2); PG8_BAR;
        PG8_STAGE(PG8_SB(1, 0), cB + kstep, voffB); PG8_STAGE(PG8_SA(1, 0), cA + kstep, voffA); PG8_STAGE(PG8_SB(1, 1), cB + hstep + kstep, voffB);
        PG8_WAIT_V(6); PG8_BAR;
    } else {
        PG8_STAGE(PG8_SB(0, 0), cB, voffB); PG8_STAGE(PG8_SA(0, 0), cA, voffA); PG8_STAGE(PG8_SB(0, 1), cB + hstep, voffB); PG8_STAGE(PG8_SA(0, 1), cA + hstep, voffA);
        if (wr == 1) PG8_BAR;
        PG8_WAIT_V(4); PG8_BAR;
        PG8_STAGE(PG8_SB(1, 0), cB + kstep, voffB); PG8_STAGE(PG8_SA(1, 0), cA + kstep, voffA); PG8_STAGE(PG8_SB(1, 1), cB + hstep + kstep, voffB);
        PG8_WAIT_V(6); PG8_BAR;
    }
    for (;;) {
        const bool has_next = S.next(ui + 1, nxt);
        const char* nA = has_next ? (const char*)g.A + (size_t)nxt.pm * tstep : cA; const char* nB = has_next ? (const char*)g.Bt + (size_t)nxt.pn * tstep : cB;
        for (int t = 0; t < nt; t += 2) {
            const bool last = (t == nt - 2);
            const char* a1 = cA + (size_t)(t + 1) * kstep;
            const char* a2 = last ? nA : cA + (size_t)(t + 2) * kstep; const char* b2 = last ? nB : cB + (size_t)(t + 2) * kstep;
            const char* a3 = a2 + kstep; const char* b3 = b2 + kstep;
            if (last && has_next) S.a_ready(nxt);
            if constexpr (SP2) {
            PG8_LDB(B0, 0, 0); PG8_LDB(B1, 0, 1); PG8_SCHED; PG8_LDA(At, 0, 0); PG8_STAGE(PG8_SA(1, 1), a1 + hstep, voffA);
            PG8_WAIT_V(8); PG8_WAIT_L(0); PG8_BAR; PG8_MMA(0, 0, At, B0); PG8_MMA(0, 1, At, B1); PG8_BAR; PG8_SCHED;
            PG8_LDA(At, 0, 1); PG8_STAGE(PG8_SB(0, 0), b2, voffB); PG8_STAGE(PG8_SB(0, 1), b2 + hstep, voffB); PG8_STAGE(PG8_SA(0, 0), a2, voffA);
            PG8_WAIT_V(8); PG8_WAIT_L(0); PG8_BAR; PG8_MMA(1, 0, At, B0); PG8_MMA(1, 1, At, B1); PG8_BAR; PG8_SCHED;
            PG8_LDB(B0, 1, 0); PG8_LDB(B1, 1, 1); PG8_SCHED; PG8_LDA(At, 1, 0); PG8_STAGE(PG8_SA(0, 1), a2 + hstep, voffA);
            PG8_WAIT_V(8); PG8_WAIT_L(0); PG8_BAR; PG8_MMA(0, 0, At, B0); PG8_MMA(0, 1, At, B1); PG8_BAR; PG8_SCHED;
            PG8_LDA(At, 1, 1); PG8_STAGE(PG8_SB(1, 0), b3, voffB); PG8_STAGE(PG8_SB(1, 1), b3 + hstep, voffB); PG8_STAGE(PG8_SA(1, 0), a3, voffA);
            PG8_WAIT_V(8); PG8_WAIT_L(0); PG8_BAR; PG8_MMA(1, 0, At, B0); PG8_MMA(1, 1, At, B1); PG8_BAR; PG8_SCHED;
            } else {
            PG8_LDB(B0, 0, 0); PG8_SCHED; PG8_LDA(At, 0, 0); PG8_STAGE(PG8_SA(1, 1), a1 + hstep, voffA);
            PG8_WAIT_L(8); PG8_BAR; PG8_WAIT_L(0); PG8_MMA(0, 0, At, B0); PG8_BAR; PG8_SCHED;
            PG8_LDB(B1, 0, 1); PG8_STAGE(PG8_SB(0, 0), b2, voffB);
            PG8_BAR; PG8_WAIT_L(0); PG8_MMA(0, 1, At, B1); PG8_BAR;
            PG8_LDA(At, 0, 1); PG8_STAGE(PG8_SA(0, 0), a2, voffA);
            PG8_BAR; PG8_WAIT_L(0); PG8_MMA(1, 0, At, B0); PG8_BAR; PG8_SCHED;
            PG8_STAGE(PG8_SB(0, 1), b2 + hstep, voffB);
            PG8_WAIT_V(6); PG8_BAR; PG8_MMA(1, 1, At, B1); PG8_BAR;
            PG8_LDB(B0, 1, 0); PG8_SCHED; PG8_LDA(At, 1, 0); PG8_STAGE(PG8_SA(0, 1), a2 + hstep, voffA);
            PG8_WAIT_L(8); PG8_BAR; PG8_WAIT_L(0); PG8_MMA(0, 0, At, B0); PG8_BAR; PG8_SCHED;
            PG8_LDB(B1, 1, 1); PG8_STAGE(PG8_SB(1, 0), b3, voffB);
            PG8_BAR; PG8_WAIT_L(0); PG8_MMA(0, 1, At, B1); PG8_BAR;
            PG8_LDA(At, 1, 1); PG8_STAGE(PG8_SA(1, 0), a3, voffA);
            PG8_BAR; PG8_WAIT_L(0); PG8_MMA(1, 0, At, B0); PG8_BAR; PG8_SCHED;
            PG8_STAGE(PG8_SB(1, 1), b3 + hstep, voffB);
            PG8_WAIT_V(6); PG8_BAR; PG8_MMA(1, 1, At, B1); PG8_BAR;
            }
        }
        if constexpr (ALIGN_EPI) { if (wr == 0) PG8_BAR; }
        if constexpr (!Epi::AFTER_DRAIN) { E(acc, cur, wr, wc, fr, fq); S.done(cur); }
        if (!has_next) break;
#pragma unroll
        for (int a = 0; a < 2; ++a)
#pragma unroll
            for (int b = 0; b < 2; ++b)
#pragma unroll
                for (int m = 0; m < 4; ++m)
#pragma unroll
                    for (int n = 0; n < 2; ++n) acc[a][b][m][n] = (f32x4){0.f, 0.f, 0.f, 0.f};
        cur = nxt; cA = nA; cB = nB; ++ui;
        if constexpr (ALIGN_EPI) { if (wr == 1) PG8_BAR; }
    }
    PG8_WAIT_V(0);
    if constexpr (!ALIGN_EPI) { if (wr == 0) PG8_BAR; }
    PG8_BAR;
    if constexpr (Epi::AFTER_DRAIN) { E.fused(acc, cur, wr, wc, fr, fq, lds, wid, lane); S.done(cur); }
#undef PG8_SA
#undef PG8_SB
#undef PG8_STAGE
#undef PG8_LDA
#undef PG8_LDB
#undef PG8_MMA
#undef PG8_WAIT_V
#undef PG8_WAIT_L
#undef PG8_BAR
#undef PG8_SCHED
}
}
namespace att {
typedef unsigned short bf16;
typedef short bf16x8 __attribute__((ext_vector_type(8)));
typedef short s16x4 __attribute__((ext_vector_type(4)));
typedef float f32x16 __attribute__((ext_vector_type(16)));
typedef float f32x4 __attribute__((ext_vector_type(4)));
typedef unsigned u32x4 __attribute__((ext_vector_type(4)));
typedef unsigned long long u64;
constexpr int D = 128, SEQ = 4096, QP = 2048, KP = 512;
constexpr float SCALE = 0.08838834764831845f;
constexpr float THR = 8.f;
constexpr int NW = 8, QBLK = 32, KVBLK = 64, QB = NW * QBLK;
constexpr int SHM_V = KVBLK * D * 2, SHM_K = KVBLK * D * 2;
constexpr int LDS_BYTES = 2 * SHM_V + 2 * SHM_K + NW * 64 * 4;

#define KSWZ(row, colB) ((row) * 256 + ((colB) ^ (((row) & 7) << 4)))
#define SBAR() __builtin_amdgcn_sched_barrier(0)
__device__ __forceinline__ int v_st(int k, int c) { const int kk = (k & ~0xC) | ((k & 4) << 1) | ((k & 8) >> 1); return ((kk >> 3) * 4 + (c >> 5)) * 512 + ((kk & 7) * 32 + (c & 31)) * 2; }
__device__ __forceinline__ int v_rd_base(int lane) { return ((lane & 3) << 3) | (((lane >> 2) & 3) << 6) | (((lane >> 4) & 1) << 5) | (((lane >> 5) & 1) << 8); }
constexpr int v_rd_off(int d0, int ks, int half) { return d0 * 512 + ks * 4096 + half * 2048; }
__device__ __forceinline__ int crow(int r, int hi) { return (r & 3) + 8 * (r >> 2) + 4 * hi; }
__device__ __forceinline__ unsigned cvtpk(float lo, float hi) { unsigned r; asm volatile("v_cvt_pk_bf16_f32 %0, %1, %2" : "=v"(r) : "v"(lo), "v"(hi)); return r; }
__device__ __forceinline__ bf16x8 load8(const bf16* p) { return *reinterpret_cast<const bf16x8*>(p); }
__device__ __forceinline__ void mask_tile(f32x16& p0, f32x16& p1, u64 mk, int hi) {
    const unsigned m0 = (unsigned)mk >> (4 * hi), m1 = (unsigned)(mk >> 32) >> (4 * hi);
    const unsigned NEGINF = 0xFF800000u;
    asm volatile("s_nop 15\n\ts_nop 7" ::: "memory");
#pragma unroll
    for (int r = 0; r < 16; ++r) {
        const int c = (r & 3) + 8 * (r >> 2);
        unsigned t0, t1;
        asm volatile("v_bfe_i32 %0, %1, %2, 1" : "=v"(t0) : "v"(m0), "n"(c));
        asm volatile("v_bfi_b32 %0, %1, %0, %2" : "+v"(p0[r]) : "v"(t0), "s"(NEGINF));
        asm volatile("v_bfe_i32 %0, %1, %2, 1" : "=v"(t1) : "v"(m1), "n"(c));
        asm volatile("v_bfi_b32 %0, %1, %0, %2" : "+v"(p1[r]) : "v"(t1), "s"(NEGINF));
    }
}
__device__ __forceinline__ void partialSM(f32x16& p0, f32x16& p1, float& m_reg, float& mn, float& alpha) {
    float pmax = p0[0]; for (int r = 1; r < 16; ++r) pmax = fmaxf(pmax, p0[r]); for (int r = 0; r < 16; ++r) pmax = fmaxf(pmax, p1[r]);
    { auto rr = __builtin_amdgcn_permlane32_swap(__float_as_uint(pmax), __float_as_uint(pmax), false, false);
      pmax = fmaxf(__uint_as_float(rr[0]), __uint_as_float(rr[1])); }
    constexpr float C2 = 1.4426950408889634f * SCALE;
    if (__builtin_expect(__all((pmax - m_reg) * SCALE <= THR), 1)) { mn = m_reg; alpha = 1.f; }
    else { mn = fmaxf(m_reg, pmax); alpha = __builtin_amdgcn_exp2f((m_reg - mn) * C2); m_reg = mn; }
    const float mnL = -mn * C2;
    for (int r = 0; r < 16; ++r) p0[r] = fmaf(p0[r], C2, mnL); for (int r = 0; r < 16; ++r) p1[r] = fmaf(p1[r], C2, mnL);
    for (int r = 0; r < 16; ++r) p0[r] = __builtin_amdgcn_exp2f(p0[r]);
}
__device__ __forceinline__ void finishSM(f32x16& p0, f32x16& p1, float alpha, float& l_reg, bf16x8& pa0, bf16x8& pa1, bf16x8& pa2, bf16x8& pa3) {
    for (int r = 0; r < 16; ++r) p1[r] = __builtin_amdgcn_exp2f(p1[r]);
    float ps = 0; for (int r = 0; r < 16; ++r) ps += p0[r]; for (int r = 0; r < 16; ++r) ps += p1[r];
    { auto rr = __builtin_amdgcn_permlane32_swap(__float_as_uint(ps), __float_as_uint(ps), false, false);
      ps = __uint_as_float(rr[0]) + __uint_as_float(rr[1]); }
    l_reg = l_reg * alpha + ps;
#define PK4(P, B_, OUT) do { unsigned a0 = cvtpk(P[B_+0], P[B_+1]), a1 = cvtpk(P[B_+2], P[B_+3]);                          \
        unsigned b0 = cvtpk(P[B_+4], P[B_+5]), b1 = cvtpk(P[B_+6], P[B_+7]);                                             \
        auto r0 = __builtin_amdgcn_permlane32_swap(a0, b0, false, false); auto r1 = __builtin_amdgcn_permlane32_swap(a1, b1, false, false); \
        u32x4 w = {r0[0], r1[0], r0[1], r1[1]}; OUT = *reinterpret_cast<bf16x8*>(&w); } while (0)
    PK4(p0, 0, pa0); PK4(p0, 8, pa1); PK4(p1, 0, pa2); PK4(p1, 8, pa3);
#undef PK4
}
template <int KB>
__device__ __forceinline__ void qkt(f32x16& p0, f32x16& p1, const char* K_lds, int r32, int hi, const bf16x8* qr) {
    p0 = f32x16{}; p1 = f32x16{};
    const char* kb[4];
#pragma unroll
    for (int dd = 0; dd < 4; ++dd) kb[dd] = K_lds + KB * SHM_K + KSWZ(r32, (dd * 16 + hi * 8) * 2);
#pragma unroll
    for (int d0 = 0; d0 < 8; ++d0) { const char* a = kb[d0 & 3] + (d0 >> 2) * 128;
        bf16x8 b0 = *reinterpret_cast<const bf16x8*>(a);
        bf16x8 b1 = *reinterpret_cast<const bf16x8*>(a + 32 * 256);
        p0 = __builtin_amdgcn_mfma_f32_32x32x16_bf16(b0, qr[d0], p0, 0, 0, 0);
        p1 = __builtin_amdgcn_mfma_f32_32x32x16_bf16(b1, qr[d0], p1, 0, 0, 0); }
}
template <int VB>
__device__ __forceinline__ void pv_tile(f32x16* o, int vb0, bf16x8 pa0, bf16x8 pa1, bf16x8 pa2, bf16x8 pa3) {
#define TRRD(dst, off) asm volatile("ds_read_b64_tr_b16 %0, %1 offset:%2" : "=&v"(dst) : "v"(vb0), "i"(off) : "memory")
#define PV_D0(d0) do { s16x4 l0, l1, l2, l3, h0, h1, h2, h3; constexpr int b_ = VB * SHM_V + v_rd_off(d0, 0, 0); \
        TRRD(l0, b_); TRRD(h0, b_ + 2048); TRRD(l1, b_ + 4096); TRRD(h1, b_ + 6144); TRRD(l2, b_ + 8192); TRRD(h2, b_ + 10240); TRRD(l3, b_ + 12288); TRRD(h3, b_ + 14336); \
        asm volatile("s_waitcnt lgkmcnt(0)" ::: "memory"); SBAR();   \
        o[d0] = __builtin_amdgcn_mfma_f32_32x32x16_bf16(pa0, (bf16x8){l0[0], l0[1], l0[2], l0[3], h0[0], h0[1], h0[2], h0[3]}, o[d0], 0, 0, 0);   \
        o[d0] = __builtin_amdgcn_mfma_f32_32x32x16_bf16(pa1, (bf16x8){l1[0], l1[1], l1[2], l1[3], h1[0], h1[1], h1[2], h1[3]}, o[d0], 0, 0, 0);   \
        o[d0] = __builtin_amdgcn_mfma_f32_32x32x16_bf16(pa2, (bf16x8){l2[0], l2[1], l2[2], l2[3], h2[0], h2[1], h2[2], h2[3]}, o[d0], 0, 0, 0);   \
        o[d0] = __builtin_amdgcn_mfma_f32_32x32x16_bf16(pa3, (bf16x8){l3[0], l3[1], l3[2], l3[3], h3[0], h3[1], h3[2], h3[3]}, o[d0], 0, 0, 0); } while (0)
    PV_D0(0); PV_D0(1); PV_D0(2); PV_D0(3);
#undef PV_D0
#undef TRRD
}
__device__ __forceinline__ u64 causal_word(int n) { return n >= 64 ? ~0ull : (n <= 0 ? 0ull : ((1ull << n) - 1ull)); }
struct BlockRef { const bf16* Q; const bf16* K; const bf16* V; bf16* O; const u64* M; int P0; };
struct Seam { bf16x8 qr[8]; bf16x8 st_v0, st_v1, st_k0, st_k1; };
#define ROW(p, k0, rr) ((p) + (unsigned)(((k0) + (rr)) * KP + sc))
#define VMW() asm volatile("s_waitcnt vmcnt(0)" ::: "memory")
#define VMWN(n) asm volatile("s_waitcnt vmcnt(%0)" :: "i"(n) : "memory")
#define SLOAD_H(Kp, Vp, k0) do { S.st_v0 = load8(ROW(Vp, k0, sr)); S.st_v1 = load8(ROW(Vp, k0, 32 + sr));              \
                         S.st_k0 = load8(ROW(Kp, k0, sr)); S.st_k1 = load8(ROW(Kp, k0, 32 + sr)); } while (0)
#define SWRITE_HK(bf) do { *(bf16x8*)(K_lds + (bf) * SHM_K + kws) = S.st_k0; *(bf16x8*)(K_lds + (bf) * SHM_K + kws + 32 * 256) = S.st_k1; } while (0)
#define SWRITE_HV(bf) do { *(bf16x8*)(V_lds + (bf) * SHM_V + vst0) = S.st_v0; *(bf16x8*)(V_lds + (bf) * SHM_V + vst1) = S.st_v1; } while (0)
#define SWRITE_H(bf) do { SWRITE_HV(bf); SWRITE_HK(bf); } while (0)
__device__ __forceinline__ void attn_prime(const BlockRef& cur, char* lds, Seam& S) {
    const int tid = threadIdx.x, wid = __builtin_amdgcn_readfirstlane(tid >> 6), lane = tid & 63, r32 = lane & 31, hi = lane >> 5;
    const int sr = tid >> 4, sc = (tid & 15) * 8, kws = KSWZ(sr, sc * 2); char* K_lds = lds + 2 * SHM_V;
    for (int d0 = 0; d0 < 8; ++d0) S.qr[d0] = load8(cur.Q + (unsigned)((wid * QBLK + r32) * QP + d0 * 16 + hi * 8));
    SLOAD_H(cur.K, cur.V, 0); VMW(); SWRITE_HK(0);
    __syncthreads();
}
__device__ __forceinline__ void attn_block(const BlockRef& cur, const BlockRef& nxt, char* lds, Seam& S) {
    const int tid = threadIdx.x, wid = __builtin_amdgcn_readfirstlane(tid >> 6), lane = tid & 63, r32 = lane & 31, hi = lane >> 5;
    const int NT = (cur.P0 + QB - 1) / KVBLK + 1;
    char* V_lds = lds; char* K_lds = lds + 2 * SHM_V;
    float* ws = (float*)(lds + 2 * SHM_V + 2 * SHM_K) + wid * 64; float* li_l = ws, * al_l = ws + 32;
    float m_reg = -1e30f, l_reg = 0; f32x16 o[4] = {};
    const int sr = tid >> 4, sc = (tid & 15) * 8, vst0 = v_st(sr, sc), vst1 = v_st(32 + sr, sc), kws = KSWZ(sr, sc * 2);
    const int vb0 = (int)(uintptr_t)V_lds + v_rd_base(lane);
    const bf16* Kh = cur.K; const bf16* Vh = cur.V;
    const u64* Mb = cur.M; const unsigned mo = (unsigned)(cur.P0 + wid * QBLK + r32);
#if defined(DBG_CAUSAL_ONLY)
#define LOADMK(t) causal_word((int)mo - 64 * (t) + 1)
#else
#define LOADMK(t) Mb[mo + (unsigned)((t) * SEQ)]
#endif
#define RESC(a) do { if (__any((a) < 1.f)) { if (hi == 0) al_l[r32] = (a); asm volatile("s_waitcnt lgkmcnt(0)" ::: "memory");              \
                     for (int d_ = 0; d_ < 4; ++d_) for (int r = 0; r < 16; ++r) o[d_][r] *= al_l[crow(r, hi)]; } } while (0)
#define KBASE(t) ((t) * KVBLK)
#define SEAM_K0() do { VMWN(8); SWRITE_HK(0); SBAR(); } while (0)
    f32x16 pA0, pA1, pB0, pB1; float mnA, mnB, alA, alB; bf16x8 pa0, pa1, pa2, pa3; u64 mk;
    SWRITE_HV(0); SBAR();
    mk = LOADMK(0);
    if (NT > 1) { SLOAD_H(Kh, Vh, KBASE(1)); }
    SBAR(); qkt<0>(pA0, pA1, K_lds, r32, hi, S.qr); SBAR();
    VMW();
    mask_tile(pA0, pA1, mk, hi); partialSM(pA0, pA1, m_reg, mnA, alA);
    if (NT > 1) { SWRITE_H(1); }
    __syncthreads();
#define HALF_STEP(PX0, PX1, mnX, alX, PY0, PY1, alY, t, KB, VB, SB) do {                                                     \
        mk = LOADMK(t);                                                                                           \
        SBAR(); qkt<KB>(PX0, PX1, K_lds, r32, hi, S.qr);                                                                      \
        finishSM(PY0, PY1, alY, l_reg, pa0, pa1, pa2, pa3); SBAR();                                                           \
        if ((t) + 1 < NT) { SLOAD_H(Kh, Vh, KBASE((t) + 1)); SBAR(); }                                                        \
        pv_tile<VB>(o, vb0, pa0, pa1, pa2, pa3);                                                                              \
        if ((t) + 1 < NT) VMWN(4); else VMW();                                                                                \
        mask_tile(PX0, PX1, mk, hi); partialSM(PX0, PX1, m_reg, mnX, alX);                                                    \
        __syncthreads();                                                                                                      \
        if ((t) + 1 < NT) { VMW(); SWRITE_H(SB); }                                                                            \
        RESC(alX); __syncthreads(); } while (0)
    for (int t = 1; t + 1 < NT; t += 2) {
        HALF_STEP(pB0, pB1, mnB, alB, pA0, pA1, alA, t, 1, 0, 0);
        HALF_STEP(pA0, pA1, mnA, alA, pB0, pB1, alB, t + 1, 0, 1, 1);
    }
    const bool even = (NT & 1) == 0;
    if (even) { mk = LOADMK(NT - 1); SBAR(); qkt<1>(pB0, pB1, K_lds, r32, hi, S.qr); SBAR(); }
    SLOAD_H(nxt.K, nxt.V, 0); SBAR();
#pragma unroll
    for (int d0 = 0; d0 < 8; ++d0) S.qr[d0] = load8(nxt.Q + (unsigned)((wid * QBLK + r32) * QP + d0 * 16 + hi * 8));
    SBAR();
    finishSM(pA0, pA1, alA, l_reg, pa0, pa1, pa2, pa3); SBAR();
    pv_tile<0>(o, vb0, pa0, pa1, pa2, pa3);
    if (even) { VMWN(12); mask_tile(pB0, pB1, mk, hi); partialSM(pB0, pB1, m_reg, mnB, alB); __syncthreads(); RESC(alB);
        finishSM(pB0, pB1, alB, l_reg, pa0, pa1, pa2, pa3); SBAR(); pv_tile<1>(o, vb0, pa0, pa1, pa2, pa3); }
    SBAR(); SEAM_K0();
    if (hi == 0) li_l[r32] = l_reg; asm volatile("s_waitcnt lgkmcnt(0)" ::: "memory");
    float rli[16];
#pragma unroll
    for (int r = 0; r < 16; ++r) rli[r] = __builtin_amdgcn_rcpf(li_l[crow(r, hi)]);
    bf16* Ow = cur.O + (unsigned)((wid * QBLK) * QP);
#pragma unroll
    for (int r = 0; r < 16; ++r) { const int orow = crow(r, hi);
#pragma unroll
        for (int d0 = 0; d0 < 4; ++d0) { const float v = o[d0][r] * rli[r];
            const float vn = __shfl_xor(v, 1);
            if ((r32 & 1) == 0) *(unsigned*)(Ow + (unsigned)(orow * QP + d0 * 32 + r32)) = cvtpk(v, vn); } }
    __syncthreads();
#undef RESC
#undef KBASE
#undef SEAM_K0
#undef HALF_STEP
}
#undef ROW
#undef VMW
#undef VMWN
#undef SLOAD_H
#undef SWRITE_HK
#undef SWRITE_HV
#undef SWRITE_H
struct Item { int bh, qb0, qb1; };
__device__ __forceinline__ Item decode(int L) {
    constexpr int G = 4, nx = 8, per = G * nx; Item it;
    const int xcd = L & 7, k = L >> 3, gi = k / per, r = k - gi * per;
    it.bh = (gi * 8 + xcd) * G + r / nx; const int x = r % nx;
    it.qb0 = x; it.qb1 = 15 - x; return it;
}
struct Tensors { const bf16* Q; const bf16* K; const bf16* V; bf16* O; const u64* M; };
__device__ __forceinline__ BlockRef make_ref(const Item& it, int pass, const Tensors& T) {
    const int qb = pass ? it.qb1 : it.qb0, b = it.bh >> 4, h = it.bh & 15, kvh = h >> 2;
    BlockRef r;
    r.Q = T.Q + ((size_t)b * SEQ + (size_t)qb * QB) * QP + h * D; r.O = T.O + ((size_t)b * SEQ + (size_t)qb * QB) * QP + h * D;
    r.K = T.K + (size_t)b * SEQ * KP + kvh * D; r.V = T.V + (size_t)b * SEQ * KP + kvh * D; r.M = T.M + (size_t)b * 64 * SEQ; r.P0 = qb * QB;
    return r;
}
__device__ __forceinline__ void attn_phase(char* lds, const Tensors& T, int wg, int nwg) {
    constexpr int total = 512;
    int L = wg; if (L >= total) return;
    Item it = decode(L); int pass = 0;
    BlockRef cur = make_ref(it, 0, T);
    Seam S;
    attn_prime(cur, lds, S);
    for (;;) {
        const bool more_pass = pass == 0 && it.qb1 != it.qb0, more_item = L + nwg < total, last = !more_pass && !more_item;
        Item itn = it; int passn = pass + 1, Ln = L;
        if (!more_pass) { passn = 0; Ln = more_item ? L + nwg : L; itn = decode(Ln); }
        const BlockRef nxt = last ? cur : make_ref(itn, passn, T);
        attn_block(cur, nxt, lds, S);
        if (last) break;
        cur = nxt; it = itn; pass = passn; L = Ln;
    }
}
#undef KSWZ
#undef SBAR
}
constexpr int NWAVES = 8;
#ifndef DBG_A4_SRC
#define DBG_A4_SRC WS_O
#endif
#ifndef MK_PER_PHASE
#define MK_PER_PHASE 0
#endif
constexpr int BATCH = 4, SEQ = 4096, DM = 2048, M = BATCH * SEQ, DFF = 8192, DEPTH = 4;
constexpr int NA1 = 4352, NA1_SRC = 4176, NC1 = 6144;
constexpr int TOPK = 256;
constexpr size_t MiB = 1u << 20;
constexpr size_t WS_CTL = 0, CTL_ZERO_BYTES = 3 * MiB;
constexpr int CW_BAR = 4096;
constexpr size_t WS_SSQ = 1 * MiB;
constexpr size_t WS_ROPEM = 3 * MiB;
constexpr size_t WS_ROPEI = 5 * MiB;
constexpr size_t WS_WA1 = 6 * MiB;  static_assert(WS_SSQ + 9 * (size_t)M * 8 <= CTL_ZERO_BYTES, "ssq inside memset");
constexpr size_t SZ_WA1 = (size_t)NA1 * DM * 2;
constexpr size_t WS_WA4 = WS_WA1 + 2 * SZ_WA1;
constexpr size_t SZ_WSQ = (size_t)DM * DM * 2;
constexpr size_t WS_WC1 = WS_WA4 + 2 * SZ_WSQ;
constexpr size_t SZ_WC1 = (size_t)NC1 * DM * 2;
constexpr size_t WS_WC2 = WS_WC1 + 2 * SZ_WC1;
constexpr size_t WS_WM1 = WS_WC2 + 2 * SZ_WSQ;
constexpr size_t SZ_WM = (size_t)DFF * DM * 2;
constexpr size_t WS_WM2 = WS_WM1 + 4 * SZ_WM;
constexpr size_t WS_XB = WS_WM2 + 4 * SZ_WM;
constexpr size_t WS_ACT = WS_XB + (size_t)M * DM * 2;
constexpr size_t SZ_MD = (size_t)M * DM * 2;
constexpr size_t WS_H = WS_ACT;
constexpr size_t WS_Q = WS_ACT, WS_O = WS_ACT + SZ_MD, WS_K = WS_ACT + 2 * SZ_MD, WS_V = WS_K + 16 * MiB, WS_QI = WS_V + 16 * MiB, WS_KI = WS_QI + 32 * MiB,
                 WS_WI = WS_KI + 2 * MiB, WS_MASK = WS_WI + 1 * MiB;
constexpr size_t WS_BG = WS_ACT, WS_Z = WS_ACT + SZ_MD, WS_G = WS_ACT + 2 * SZ_MD;
constexpr size_t WS_END = WS_ACT + 256 * MiB;
static_assert(WS_MASK + 8 * MiB <= WS_END && WS_G + SZ_MD <= WS_END && WS_H + (size_t)M * DFF * 2 <= WS_END, "d_ws map");
constexpr int RING_OFF = 0, RING_BYTES = 131072;
constexpr int AUX_OFF = RING_BYTES, AUX_BYTES = 16384 + 2048;
constexpr int MISC_OFF = AUX_OFF + AUX_BYTES;
constexpr int LDS_BYTES = MISC_OFF + 256;
static_assert(LDS_BYTES <= 160 * 1024, "LDS map");

#define GAS __attribute__((address_space(1)))
#define LAS __attribute__((address_space(3)))
typedef unsigned short bf16;
typedef unsigned v4u __attribute__((ext_vector_type(4)));
typedef unsigned v2u __attribute__((ext_vector_type(2)));
typedef float f32x4 __attribute__((ext_vector_type(4)));
typedef short bf16x8 __attribute__((ext_vector_type(8)));
typedef float f32x16 __attribute__((ext_vector_type(16)));
typedef GAS unsigned gu32;
#define RLX_AGENT __ATOMIC_RELAXED, __HIP_MEMORY_SCOPE_AGENT
#define LDS_WAIT() asm volatile("s_waitcnt lgkmcnt(0)" ::: "memory")
#define VM_WAIT() asm volatile("s_waitcnt vmcnt(0)" ::: "memory")
__device__ __forceinline__ unsigned f2bf(float f) { unsigned u = __builtin_bit_cast(unsigned, f); return (u + 0x7fffu + ((u >> 16) & 1u)) >> 16; }
__device__ __forceinline__ unsigned pk2(float lo, float hi) { return f2bf(lo) | (f2bf(hi) << 16); }
__device__ __forceinline__ float bf2f(unsigned short b) { return __uint_as_float((unsigned)b << 16); }
__device__ __forceinline__ float wave_sum(float v) {
#pragma unroll
    for (int o = 1; o < 64; o <<= 1) v += __shfl_xor(v, o);
    return v;
}
__device__ __forceinline__ float wave_min(float v) {
#pragma unroll
    for (int o = 1; o < 64; o <<= 1) v = fminf(v, __shfl_xor(v, o));
    return v;
}
__device__ __forceinline__ float wave_max(float v) {
#pragma unroll
    for (int o = 1; o < 64; o <<= 1) v = fmaxf(v, __shfl_xor(v, o));
    return v;
}

#define XB_TMO      128
#define XB_XCNT(j)  (256  + 64 * (j))
#define XB_XSUB(j)  (1280 + 64 * (j))
#define XB_XGEN(j)  (2304 + 64 * (j))
#define XB_TOP      3328
#define XB_TOPGEN   3392
#define XCD_BAR_WORDS 3456
#define XB_SPIN_CAP (1u << 18)

__device__ __forceinline__ unsigned xb_ld(unsigned* p)              { return __hip_atomic_load(p, __ATOMIC_RELAXED, __HIP_MEMORY_SCOPE_AGENT); }
__device__ __forceinline__ unsigned xb_add(unsigned* p, unsigned v) { return __hip_atomic_fetch_add(p, v, __ATOMIC_RELAXED, __HIP_MEMORY_SCOPE_AGENT); }
__device__ __forceinline__ unsigned xb_xcc_id() { return (unsigned)__builtin_amdgcn_s_getreg((3 << 11) | 20) & 0xFu; }
#define XB_SPIN(cond, bar) do { unsigned _sp = 0; while (cond) { __builtin_amdgcn_s_sleep(1); \
    if ((++_sp & 255u) == 0u) { if (xb_ld(&(bar)[XB_TMO])) break; if (_sp > XB_SPIN_CAP) { atomicAdd(&(bar)[XB_TMO], 1u); break; } } } } while (0)

struct XcdBarrier {
    unsigned* bar; unsigned x;
    volatile LAS unsigned* st;
};

__device__ __forceinline__ XcdBarrier xcd_barrier_post(unsigned* bar, volatile LAS unsigned* st) {
    XcdBarrier b; b.bar = bar; b.x = xb_xcc_id(); b.st = st;
    if (threadIdx.x == 0) (void)xb_add(&bar[XB_XCNT(b.x)], 1u);
    return b;
}
__device__ __forceinline__ void xcd_barrier_complete(unsigned* bar, unsigned x, unsigned& nloc, unsigned& nx) {
    const unsigned G = gridDim.x * gridDim.y * gridDim.z;
    unsigned sum, cnt, mine, sp = 0u;
    for (;;) {
        sum = 0u; cnt = 0u; mine = 0u;
#pragma unroll
        for (unsigned j = 0; j < 16; ++j) { const unsigned c = xb_ld(&bar[XB_XCNT(j)]); sum += c; cnt += (c > 0u) ? 1u : 0u; mine = (j == x) ? c : mine; }
        if (sum == G) break;
        __builtin_amdgcn_s_sleep(1);
        if ((++sp & 255u) == 0u) { if (xb_ld(&bar[XB_TMO])) break; if (sp > XB_SPIN_CAP) { atomicAdd(&bar[XB_TMO], 1u); break; } }
    }
    nloc = mine > 0u ? mine : 1u; nx = cnt > 0u ? cnt : 1u;
}

__device__ __forceinline__ void xcd_barrier(const XcdBarrier& b) {
    asm volatile("s_waitcnt vmcnt(0)" ::: "memory");
    __syncthreads();
    if (threadIdx.x == 0) {
        unsigned* bar = b.bar;
        __builtin_amdgcn_s_waitcnt(0);
        unsigned nloc = b.st[0], nx = b.st[1];
        if (nloc == 0u) { xcd_barrier_complete(bar, b.x, nloc, nx); b.st[0] = nloc; b.st[1] = nx; }
        const unsigned old = xb_add(&bar[XB_XSUB(b.x)], 1u);
        const unsigned gen = old / nloc;
        if (old + 1u == (gen + 1u) * nloc) {
            __builtin_amdgcn_fence(__ATOMIC_RELEASE, "agent");
            asm volatile("s_waitcnt vmcnt(0)" ::: "memory");
            const unsigned og = xb_add(&bar[XB_TOP], 1u);
            const unsigned tg = og / nx;
            if (og + 1u == (tg + 1u) * nx) xb_add(&bar[XB_TOPGEN], 1u);
            else XB_SPIN(xb_ld(&bar[XB_TOPGEN]) == tg, bar);
            __builtin_amdgcn_fence(__ATOMIC_ACQUIRE, "agent");
            xb_add(&bar[XB_XGEN(b.x)], 1u);
            asm volatile("s_waitcnt vmcnt(0)" ::: "memory");
        } else {
            XB_SPIN(xb_ld(&bar[XB_XGEN(b.x)]) == gen, bar);
            __builtin_amdgcn_fence(__ATOMIC_ACQUIRE, "agent");
            asm volatile("s_waitcnt vmcnt(0)" ::: "memory");
        }
    }
    __syncthreads();
}

struct Frame {
    LAS unsigned char* lds;
    volatile LAS unsigned* MISC;
    gu32* ctl;
    int tid, lane, wave, vcu, G;
    unsigned char* ws;
};

__device__ __forceinline__ int dmap64(int s) { if (s >= 32) return s; const int nn = s >> 4, fq = (s >> 2) & 3, j = s & 3; return fq < 2 ? 8 * nn + 4 * fq + j : 16 + 8 * nn + 4 * (fq - 2) + j; }
__device__ __forceinline__ int src_col(int kind, int n) {
    if (kind == 0) return n;
    const int pn = n >> 8, p = n & 255;
    if (kind == 1) {
        if (pn < 12) return n;
        if (pn < 16) return 3072 + (pn - 12) * 256 + (p >> 6) * 64 + dmap64(p & 63);
        if (p < 64) return 4096 + dmap64(p);
        if (p < 80) return 4160 + (p - 64);
        return -1;
    }
    if (pn < 8) return n;
    const int i = pn - 8; return p < 128 ? 2048 + 128 * i + p : 4096 + 128 * i + (p - 128);
}
__device__ __forceinline__ void p0_transpose_item(const float* W, const float* g, int K, int Nsrc, int Npad, int kind, bf16* WT, LAS float* scr, int item, int lane) {
    const int nblk = Npad / 32, kb = item / nblk, nb = item % nblk, k0 = 64 * kb, n0 = 32 * nb;
    const int col = src_col(kind, n0 + (lane & 31));
#pragma unroll 8
    for (int i = 0; i < 32; ++i) { const int kk = 2 * i + (lane >> 5); float v = 0.f; if (col >= 0) { v = W[(size_t)(k0 + kk) * Nsrc + col]; if (g) v *= g[k0 + kk]; } scr[kk * 33 + (lane & 31)] = v; }
    LDS_WAIT(); asm volatile("" ::: "memory");
    const int c = lane & 7;
#pragma unroll
    for (int j = 0; j < 4; ++j) { const int n = (lane >> 3) + 8 * j; const LAS float* s = scr + (8 * c) * 33 + n;
        v4u o; o.x = pk2(s[0 * 33], s[1 * 33]); o.y = pk2(s[2 * 33], s[3 * 33]); o.z = pk2(s[4 * 33], s[5 * 33]); o.w = pk2(s[6 * 33], s[7 * 33]);
        *(GAS v4u*)(WT + (size_t)(n0 + n) * K + k0 + 8 * c) = o; }
    LDS_WAIT(); asm volatile("" ::: "memory");
}
struct Inputs { const float* x; const int* pos; const float *attn_norm_g, *attn_w_in, *attn_q_g, *attn_k_g, *attn_w_out, *conv_norm_g, *conv_w_in, *conv_w, *conv_w_out, *mlp_norm_g, *mlp_w1, *mlp_w2; };
__device__ __forceinline__ void p0_prologue(Frame& F, const Inputs& I, float* out) {
    LAS float* scr = (LAS float*)(F.lds + RING_OFF + F.wave * 16384);
    const int gw = F.vcu * NWAVES + F.wave, NGW = F.G * NWAVES;
    constexpr int I_A1 = (DM / 64) * (NA1 / 32), I_SQ = (DM / 64) * (DM / 32), I_C1 = (DM / 64) * (NC1 / 32), I_M1 = (DM / 64) * (DFF / 32), I_M2 = (DFF / 64) * (DM / 32);
    constexpr int PER_J = I_A1 + I_SQ + I_C1 + I_SQ, PER_I = I_M1 + I_M2, NITEMS = 2 * PER_J + 4 * PER_I;
    for (int it = gw; it < NITEMS; it += NGW) {
        int r = it;
        if (r < 2 * PER_J) { const int j = r / PER_J; r -= j * PER_J;
            if (r < I_A1) { p0_transpose_item(I.attn_w_in + (size_t)j * DM * NA1_SRC, I.attn_norm_g + j * DM, DM, NA1_SRC, NA1, 1, (bf16*)(F.ws + WS_WA1 + j * SZ_WA1), scr, r, F.lane); continue; } r -= I_A1;
            if (r < I_SQ) { p0_transpose_item(I.attn_w_out + (size_t)j * DM * DM, nullptr, DM, DM, DM, 0, (bf16*)(F.ws + WS_WA4 + j * SZ_WSQ), scr, r, F.lane); continue; } r -= I_SQ;
            if (r < I_C1) { p0_transpose_item(I.conv_w_in + (size_t)j * DM * NC1, I.conv_norm_g + j * DM, DM, NC1, NC1, 2, (bf16*)(F.ws + WS_WC1 + j * SZ_WC1), scr, r, F.lane); continue; } r -= I_C1;
            p0_transpose_item(I.conv_w_out + (size_t)j * DM * DM, nullptr, DM, DM, DM, 0, (bf16*)(F.ws + WS_WC2 + j * SZ_WSQ), scr, r, F.lane); continue; }
        r -= 2 * PER_J; { const int i = r / PER_I; r -= i * PER_I;
            if (r < I_M1) { p0_transpose_item(I.mlp_w1 + (size_t)i * DM * DFF, I.mlp_norm_g + i * DM, DM, DFF, DFF, 0, (bf16*)(F.ws + WS_WM1 + i * SZ_WM), scr, r, F.lane); continue; } r -= I_M1;
            p0_transpose_item(I.mlp_w2 + (size_t)i * DFF * DM, nullptr, DFF, DM, DM, 0, (bf16*)(F.ws + WS_WM2 + i * SZ_WM), scr, r, F.lane); }
    }
    bf16* xb = (bf16*)(F.ws + WS_XB); pg8::ssq_t* ssq0 = (pg8::ssq_t*)(F.ws + WS_SSQ);
    for (int m = gw; m < M; m += NGW) {
        const GAS f32x4* xr = (const GAS f32x4*)(I.x + (size_t)m * DM) + F.lane; GAS unsigned long long* o8 = (GAS unsigned long long*)(xb + (size_t)m * DM) + F.lane;
        float s = 0.f;
#pragma unroll
        for (int j = 0; j < 8; ++j) { const f32x4 v = xr[64 * j]; s += (v.x * v.x + v.y * v.y) + (v.z * v.z + v.w * v.w);
            o8[64 * j] = (unsigned long long)pk2(v.x, v.y) | ((unsigned long long)pk2(v.z, v.w) << 32); }
        s = wave_sum(s); if (F.lane == 0) ssq0[m] = pg8::ssq_fix(s);
    }
    float* ropeM = (float*)(F.ws + WS_ROPEM); float* ropeI = (float*)(F.ws + WS_ROPEI);
    for (int e = F.vcu * 512 + F.tid; e < M * 24; e += F.G * 512) {
        const int row = e / 24, d = e % 24; const float p = (float)I.pos[row];
        const float ex = d < 16 ? -(float)d * (1.0f / 16.0f) : -(float)(d - 16) * (1.0f / 8.0f);
        const float inv = __builtin_amdgcn_exp2f(ex * 18.931568569324174f);
        const float ang = p * inv;
        double rev = (double)ang * 0.15915494309189535; rev -= __builtin_floor(rev); const float rf = (float)rev;
        const float c = __builtin_amdgcn_cosf(rf), s = __builtin_amdgcn_sinf(rf);
        if (d < 16) { ropeM[(size_t)row * 32 + d] = c; ropeM[(size_t)row * 32 + 16 + d] = s; } else { ropeI[(size_t)row * 16 + (d - 16)] = c; ropeI[(size_t)row * 16 + 8 + (d - 16)] = s; }
    }
    (void)out;
}

struct IdxTensors { const bf16* QI; const bf16* KI; const float* WI; unsigned long long* MASK; float* dbg; };
#define DBG_OUT T.dbg
__device__ __forceinline__ void idx_phase(Frame& F, const IdxTensors& T) {
    LAS float* scores = (LAS float*)(F.lds + RING_OFF);
    LAS unsigned* hist = (LAS unsigned*)(F.lds + AUX_OFF) + F.wave * 512;
    LAS float* cand = (LAS float*)(F.lds + AUX_OFF + 16384) + F.wave * 64;
    const int lane = F.lane, w = F.wave, c32 = lane & 31, hi = lane >> 5;
    for (int uu = blockIdx.x; uu < 2048; uu += F.G) {
        const int idx = uu & 255, rr = uu >> 8, b = rr >> 1, tb = (rr & 1) ? 511 - idx : idx, t0 = tb * 8;
        {
            const int p = w >> 1, par = w & 1;
            const int qsel = (c32 >> 2) & 1, hh = (c32 & 3) + 4 * (c32 >> 3);
            const bf16* qrow = T.QI + ((size_t)(b * SEQ + t0 + 2 * p + qsel) * 16 + hh) * 64 + 8 * hi;
            bf16x8 afr[4];
#pragma unroll
            for (int kk = 0; kk < 4; ++kk) afr[kk] = *(const bf16x8*)(qrow + 16 * kk);
            const float* wrow = T.WI + (size_t)(b * SEQ + t0 + 2 * p + hi) * 16;
            f32x4 wq[4];
#pragma unroll
            for (int i = 0; i < 4; ++i) wq[i] = *(const f32x4*)(wrow + 4 * i);
            const int ntile = (t0 + 7) / 32 + 1;
            const bf16* kbase = T.KI + (size_t)b * SEQ * 64 + (size_t)c32 * 64 + 8 * hi;
            LAS float* srow = scores + (2 * p + hi) * 4096 + c32;
            bf16x8 bcur[4], bnxt[4];
            if (par < ntile) {
#pragma unroll
                for (int kk = 0; kk < 4; ++kk) bcur[kk] = *(const bf16x8*)(kbase + (size_t)par * 32 * 64 + 16 * kk);
            }
            for (int jt = par; jt < ntile; jt += 2) {
                const int jn = jt + 2 < ntile ? jt + 2 : jt;
#pragma unroll
                for (int kk = 0; kk < 4; ++kk) bnxt[kk] = *(const bf16x8*)(kbase + (size_t)jn * 32 * 64 + 16 * kk);
                f32x16 acc = {};
#pragma unroll
                for (int kk = 0; kk < 4; ++kk) acc = __builtin_amdgcn_mfma_f32_32x32x16_bf16(afr[kk], bcur[kk], acc, 0, 0, 0);
                float s = 0.f;
#pragma unroll
                for (int r = 0; r < 16; ++r) s = fmaf(wq[r >> 2][r & 3], fmaxf(acc[r], 0.f), s);
                srow[jt * 32] = s;
#pragma unroll
                for (int kk = 0; kk < 4; ++kk) bcur[kk] = bnxt[kk];
            }
        }
        LDS_WAIT(); __syncthreads();
        {
            const int t = t0 + w, n = t + 1;
            const LAS float* sc = scores + w * 4096;
            const float INF = __builtin_inff();
#if defined(DBG_DUMP2)
            for (int i = lane; i < 2048; i += 64) DBG_OUT[(size_t)(b * SEQ + t) * 2048 + i] = (i + DBG_DUMP2 < n) ? sc[i + DBG_DUMP2] : 0.f;
#endif
            float tau = -INF;
            if (n > TOPK) {
                float lo = INF, hv = -INF;
                for (int i = lane; i < n; i += 64) { const float v = sc[i]; lo = fminf(lo, v); hv = fmaxf(hv, v); }
                lo = wave_min(lo); hv = wave_max(hv);
                int need = TOPK; bool done = false;
                for (int level = 0; level < 6 && !done; ++level) {
                    if (!(hv > lo)) { tau = lo; done = true; break; }
                    const float scale = fminf(512.0f / (hv - lo), 3.0e37f);
#pragma unroll
                    for (int k = 0; k < 8; ++k) hist[k * 64 + lane] = 0u;
                    LDS_WAIT();
                    for (int i = lane; i < n; i += 64) { const float v = sc[i];
                        if (v >= lo && v <= hv) { int bin = (int)((v - lo) * scale); bin = bin > 511 ? 511 : bin; __hip_atomic_fetch_add(hist + bin, 1u, __ATOMIC_RELAXED, __HIP_MEMORY_SCOPE_WORKGROUP); } }
                    LDS_WAIT();
                    unsigned h[8]; unsigned ssum = 0;
                    { const v4u a = *(const LAS v4u*)(hist + 8 * lane), bq = *(const LAS v4u*)(hist + 8 * lane + 4); h[0] = a.x; h[1] = a.y; h[2] = a.z; h[3] = a.w; h[4] = bq.x; h[5] = bq.y; h[6] = bq.z; h[7] = bq.w; }
#pragma unroll
                    for (int k = 0; k < 8; ++k) ssum += h[k];
                    unsigned S = ssum;
#pragma unroll
                    for (int o = 1; o < 64; o <<= 1) { const unsigned tt = __shfl_down(S, o); if (lane + o < 64) S += tt; }
                    const unsigned long long bal = __ballot(S >= (unsigned)need);
                    const int L = __popcll(bal) - 1;
                    const int Lc = L < 0 ? 0 : L;
                    unsigned cum = (Lc < 63) ? (unsigned)__shfl(S, Lc + 1) : 0u; if (Lc >= 63) cum = 0u;
                    int bstar = 8 * Lc; unsigned cstar = 0, abv = cum; bool found = false;
#pragma unroll
                    for (int k = 7; k >= 0; --k) { const unsigned hk = (unsigned)__shfl(h[k], Lc);
                        if (!found && cum + hk >= (unsigned)need) { bstar = 8 * Lc + k; cstar = hk; abv = cum; found = true; }
                        cum += hk; }
                    need -= (int)abv;
                    float nlo = INF, nhv = -INF; int base = 0; const bool few = cstar <= 64u;
                    for (int i0 = 0; i0 < n; i0 += 64) { const int i = i0 + lane; bool inb = false; float v = 0.f;
                        if (i < n) { v = sc[i]; if (v >= lo && v <= hv) { int bin = (int)((v - lo) * scale); bin = bin > 511 ? 511 : bin; inb = bin == bstar; } }
                        if (inb) { nlo = fminf(nlo, v); nhv = fmaxf(nhv, v); }
                        if (few) { const unsigned long long mk = __ballot(inb);
                            if (inb) { const int pos = base + __popcll(mk & ((1ull << lane) - 1ull)); if (pos < 64) cand[pos] = v; }
                            base += __popcll(mk); } }
                    lo = wave_min(nlo); hv = wave_max(nhv);
                    if (few) {
                        LDS_WAIT();
                        const int nc = base < 64 ? base : 64;
                        const float myv = lane < nc ? cand[lane] : -INF; int cnt = 0;
                        for (int i = 0; i < nc; ++i) cnt += (cand[i] > myv) ? 1 : 0;
                        const bool sel = lane < nc && cnt < need;
                        tau = wave_min(sel ? myv : INF); done = true;
                    }
                }
                if (!done) tau = lo;
            }
            unsigned long long myword = 0ull;
            const int nw = (n + 63) >> 6;
            for (int j = 0; j < nw; ++j) { const int i = 64 * j + lane;
#if defined(DBG_TRIV_MASK)
            const bool bit = (i < n);
#elif defined(DBG_SCORE_MASK)
            const bool bit = (i < n) && ((sc[i] > 0.f) || i == t);
#else
            const bool bit = (i < n) && (sc[i] >= tau);
#endif

                const unsigned long long mk = __ballot(bit); if (lane == j) myword = mk; }
            const int nwords = ((t | 255) + 1) >> 6;
            if (lane < nwords) T.MASK[((size_t)b * 64 + lane) * SEQ + t] = myword;
        }
        LDS_WAIT(); __syncthreads();
    }
}

__device__ __forceinline__ void conv_phase(Frame& F, const bf16* Bg, const bf16* Z, const float* cw, bf16* Gout) {
    const int nunit = (M / 32) * 4;
    for (int uu = (blockIdx.x * NWAVES + F.wave); uu < nunit; uu += F.G * NWAVES) {
        const int run = uu >> 2, cb = (uu & 3) * 512 + F.lane * 8, r0 = run * 32;
        float w0[8], w1[8], w2[8];
#pragma unroll
        for (int j = 0; j < 8; ++j) { w0[j] = cw[cb + j]; w1[j] = cw[DM + cb + j]; w2[j] = cw[2 * DM + cb + j]; }
        float zm2[8], zm1[8];
        const bool first = (r0 % SEQ) == 0;
        { v4u a = {0, 0, 0, 0}, bq = {0, 0, 0, 0};
          if (!first) { a = *(const v4u*)(Z + (size_t)(r0 - 2) * DM + cb); bq = *(const v4u*)(Z + (size_t)(r0 - 1) * DM + cb); }
          const unsigned aw[4] = {a.x, a.y, a.z, a.w}, bw[4] = {bq.x, bq.y, bq.z, bq.w};
#pragma unroll
          for (int j = 0; j < 4; ++j) { zm2[2 * j] = __uint_as_float(aw[j] << 16); zm2[2 * j + 1] = __uint_as_float(aw[j] & 0xffff0000u); zm1[2 * j] = __uint_as_float(bw[j] << 16); zm1[2 * j + 1] = __uint_as_float(bw[j] & 0xffff0000u); } }
#pragma unroll 4
        for (int r = 0; r < 32; ++r) {
            const v4u zz = *(const v4u*)(Z + (size_t)(r0 + r) * DM + cb), bb = *(const v4u*)(Bg + (size_t)(r0 + r) * DM + cb);
            const unsigned zw[4] = {zz.x, zz.y, zz.z, zz.w}, bw[4] = {bb.x, bb.y, bb.z, bb.w};
            float z0[8], o[8];
#pragma unroll
            for (int j = 0; j < 4; ++j) { z0[2 * j] = __uint_as_float(zw[j] << 16); z0[2 * j + 1] = __uint_as_float(zw[j] & 0xffff0000u); }
#pragma unroll
            for (int j = 0; j < 8; ++j) { const float bv = (j & 1) ? __uint_as_float(bw[j >> 1] & 0xffff0000u) : __uint_as_float(bw[j >> 1] << 16);
                o[j] = bv * (w0[j] * zm2[j] + w1[j] * zm1[j] + w2[j] * z0[j]); zm2[j] = zm1[j]; zm1[j] = z0[j]; }
            v4u ov; ov.x = pk2(o[0], o[1]); ov.y = pk2(o[2], o[3]); ov.z = pk2(o[4], o[5]); ov.w = pk2(o[6], o[7]);
            *(v4u*)(Gout + (size_t)(r0 + r) * DM + cb) = ov;
        }
    }
}

#ifndef PH_P0
#define PH_P0 1
#endif
#ifndef PH_A1
#define PH_A1 1
#endif
#ifndef PH_A2
#define PH_A2 1
#endif
#ifndef PH_A3
#define PH_A3 1
#endif
#ifndef PH_A4
#define PH_A4 1
#endif
#ifndef PH_C1
#define PH_C1 1
#endif
#ifndef PH_C1B
#define PH_C1B 1
#endif
#ifndef PH_C2
#define PH_C2 1
#endif
#ifndef PH_M1
#define PH_M1 1
#endif
#ifndef PH_M2
#define PH_M2 1
#endif
struct Args { Inputs in; float* out; unsigned char* ws; int ph_lo, ph_hi; };
#define IN(k) (lo <= (k) && (k) < hi)
#define SEAM(k) do { if (IN(k) && IN((k) + 1)) { if (!MK_PER_PHASE) xcd_barrier(bar); } } while (0)
template <int li> __device__ __forceinline__ void layer_body(Frame& F, const Args& args, const XcdBarrier& bar, const int lo, const int hi, unsigned char* lds) {
    const Inputs& I = args.in; unsigned char* ws = args.ws;
    bf16* const XB = (bf16*)(ws + WS_XB); pg8::ssq_t* const SSQ = (pg8::ssq_t*)(ws + WS_SSQ);
    const float* const ropeM = (const float*)(ws + WS_ROPEM); const float* const ropeI = (const float*)(ws + WS_ROPEI);

        const int j = li >> 1, pb = 1 + 6 * li;
        const float* xin = (li == 0) ? I.x : args.out;
        if ((li & 1) == 0) {
            if (PH_A1 && IN(pb + 0)) {
                pg8::Gemm g{XB, (const bf16*)(ws + WS_WA1 + j * SZ_WA1), M, NA1, DM}; pg8::StaticOrder S; S.init(M, NA1, F.G, (int)blockIdx.x);
                pg8::EpiA1 E{SSQ + (size_t)(2 * li) * M, (bf16*)(ws + WS_Q), (bf16*)(ws + WS_K), (bf16*)(ws + WS_V), (bf16*)(ws + WS_QI), (bf16*)(ws + WS_KI), (float*)(ws + WS_WI),
                             I.attn_q_g + j * 128, I.attn_k_g + j * 128, ropeM, ropeI, (PG8_LAS float*)(F.lds + AUX_OFF)};
                pg8::gemm_phase<pg8::EpiA1, pg8::StaticOrder, true, true>(F.lds + RING_OFF, g, S, E);
            } SEAM(pb + 0);
            if (PH_A2 && IN(pb + 1)) { IdxTensors T{(const bf16*)(ws + WS_QI), (const bf16*)(ws + WS_KI), (const float*)(ws + WS_WI), (unsigned long long*)(ws + WS_MASK), args.out};
#if defined(DBG_DUMP)
                for (size_t e = (size_t)blockIdx.x * 512 + F.tid; e < (size_t)M * DM; e += (size_t)F.G * 512) { const int row = (int)(e / DM), c = (int)(e % DM); float v = 0.f;
                    if (c < 1024) v = bf2f(T.QI[(size_t)row * 1024 + c]); else if (c < 1088) v = bf2f(T.KI[(size_t)row * 64 + c - 1024]); else if (c < 1104) v = T.WI[(size_t)row * 16 + c - 1088];
                    args.out[e] = v; }
#else
                idx_phase(F, T);
#endif
                } SEAM(pb + 1);
            if (PH_A3 && IN(pb + 2)) { const att::Tensors T{(const att::bf16*)(ws + WS_Q), (const att::bf16*)(ws + WS_K), (const att::bf16*)(ws + WS_V), (att::bf16*)(ws + WS_O), (const att::u64*)(ws + WS_MASK)};
                att::attn_phase((char*)lds + RING_OFF, T, (int)blockIdx.x, F.G); } SEAM(pb + 2);
            if (PH_A4 && IN(pb + 3)) {
                pg8::Gemm g{(const bf16*)(ws + DBG_A4_SRC), (const bf16*)(ws + WS_WA4 + j * SZ_WSQ), M, DM, DM}; pg8::StaticOrder S; S.init(M, DM, F.G, (int)blockIdx.x);
                pg8::EpiRes E{xin, args.out, XB, SSQ + (size_t)(2 * li + 1) * M};
                pg8::gemm_phase<pg8::EpiRes, pg8::StaticOrder, true, true>(F.lds + RING_OFF, g, S, E);
            } SEAM(pb + 3);
        } else {
            if (PH_C1 && IN(pb + 0)) {
                pg8::Gemm g{XB, (const bf16*)(ws + WS_WC1 + j * SZ_WC1), M, NC1, DM}; pg8::StaticOrder S; S.init(M, NC1, F.G, (int)blockIdx.x);
                pg8::EpiC1 E{(bf16*)(ws + WS_BG), (bf16*)(ws + WS_Z), SSQ + (size_t)(2 * li) * M};
                pg8::gemm_phase<pg8::EpiC1, pg8::StaticOrder, true, true>(F.lds + RING_OFF, g, S, E);
            } SEAM(pb + 0);
            if (PH_C1B && IN(pb + 1)) { conv_phase(F, (const bf16*)(ws + WS_BG), (const bf16*)(ws + WS_Z), I.conv_w + (size_t)j * 3 * DM, (bf16*)(ws + WS_G)); } SEAM(pb + 1);
            if (PH_C2 && IN(pb + 2)) {
                pg8::Gemm g{(const bf16*)(ws + WS_G), (const bf16*)(ws + WS_WC2 + j * SZ_WSQ), M, DM, DM}; pg8::StaticOrder S; S.init(M, DM, F.G, (int)blockIdx.x);
                pg8::EpiRes E{xin, args.out, XB, SSQ + (size_t)(2 * li + 1) * M};
                pg8::gemm_phase<pg8::EpiRes, pg8::StaticOrder, true, true>(F.lds + RING_OFF, g, S, E);
            } SEAM(pb + 2);
            SEAM(pb + 3);
        }
        if (PH_M1 && IN(pb + 4)) {
            pg8::Gemm g{XB, (const bf16*)(ws + WS_WM1 + li * SZ_WM), M, DFF, DM}; pg8::StaticOrder S; S.init(M, DFF, F.G, (int)blockIdx.x);
            pg8::EpiM1 E{(bf16*)(ws + WS_H), SSQ + (size_t)(2 * li + 1) * M};
            pg8::gemm_phase<pg8::EpiM1, pg8::StaticOrder, true, true>(F.lds + RING_OFF, g, S, E);
        } SEAM(pb + 4);
        if (PH_M2 && IN(pb + 5)) {
            pg8::Gemm g{(const bf16*)(ws + WS_H), (const bf16*)(ws + WS_WM2 + li * SZ_WM), M, DM, DFF}; pg8::StaticOrder S; S.init(M, DM, F.G, (int)blockIdx.x);
            pg8::EpiRes E{args.out, args.out, XB, SSQ + (size_t)(2 * li + 2) * M};
            pg8::gemm_phase<pg8::EpiRes, pg8::StaticOrder, true, true>(F.lds + RING_OFF, g, S, E);
        } SEAM(pb + 5);
    }
#undef IN
#undef SEAM
__global__ void __launch_bounds__(NWAVES * 64, 2) trunk_fwd(Args args) {
    extern __shared__ __attribute__((aligned(16))) unsigned char lds[];
    Frame F;
    F.lds = (LAS unsigned char*)lds;
    F.MISC = (volatile LAS unsigned*)(F.lds + MISC_OFF);
    F.tid = threadIdx.x; F.lane = F.tid & 63; F.wave = __builtin_amdgcn_readfirstlane(F.tid >> 6);
    F.G = gridDim.x; { const int bx = blockIdx.x; F.vcu = (F.G % 8 == 0) ? (bx % 8) * (F.G / 8) + bx / 8 : bx; }
    F.ws = args.ws; F.ctl = (gu32*)(args.ws + WS_CTL);
    for (int u = F.tid; u < 64; u += NWAVES * 64) ((LAS unsigned*)(F.lds + MISC_OFF))[u] = 0u;
    __syncthreads();
    XcdBarrier bar; bar.bar = (unsigned*)(F.ctl + CW_BAR); bar.x = 0; bar.st = nullptr;
    if (!MK_PER_PHASE) bar = xcd_barrier_post((unsigned*)(F.ctl + CW_BAR), F.MISC + 8);
    const int lo = args.ph_lo, hi = args.ph_hi;
    const Inputs& I = args.in;
    unsigned char* ws = args.ws;
#define IN(k) (lo <= (k) && (k) < hi)
#define SEAM(k) do { if (IN(k) && IN((k) + 1)) { if (!MK_PER_PHASE) xcd_barrier(bar); } } while (0)
    bf16* const XB = (bf16*)(ws + WS_XB);
    pg8::ssq_t* const SSQ = (pg8::ssq_t*)(ws + WS_SSQ);
    const float* const ropeM = (const float*)(ws + WS_ROPEM); const float* const ropeI = (const float*)(ws + WS_ROPEI);

    if (PH_P0 && IN(0)) { p0_prologue(F, I, args.out); } SEAM(0);

    layer_body<0>(F, args, bar, lo, hi, lds); layer_body<1>(F, args, bar, lo, hi, lds); layer_body<2>(F, args, bar, lo, hi, lds); layer_body<3>(F, args, bar, lo, hi, lds);
#undef IN
#undef SEAM
}

#ifndef DBG_NPH
#define DBG_NPH (1 + 6 * DEPTH)
#endif
constexpr int N_PHASES = DBG_NPH;
extern "C" void kernel_launch(void* const* d_in, const int* in_sizes, int n_in, void* d_out, int out_size, void* d_ws, size_t ws_size, hipStream_t stream) {
    static int grid = 0;
    if (grid == 0) {
        if (n_in != 14 || in_sizes[0] != M * DM || out_size != M * DM || ws_size < WS_END) { fprintf(stderr, "kernel_launch: shape/workspace mismatch (n_in %d, in0 %d, out %d, ws %zu, need %zu)\n", n_in, n_in > 0 ? in_sizes[0] : -1, out_size, ws_size, (size_t)WS_END); grid = -1; return; }
        int dev = 0, cus = 0, per_cu = 0;
        if (hipGetDevice(&dev) != hipSuccess || hipDeviceGetAttribute(&cus, hipDeviceAttributeMultiprocessorCount, dev) != hipSuccess) { grid = -1; return; }
        if (hipFuncSetAttribute((const void*)trunk_fwd, hipFuncAttributeMaxDynamicSharedMemorySize, LDS_BYTES) != hipSuccess) { fprintf(stderr, "kernel_launch: hipFuncSetAttribute failed\n"); grid = -1; return; }
        if (hipOccupancyMaxActiveBlocksPerMultiprocessor(&per_cu, (const void*)trunk_fwd, NWAVES * 64, LDS_BYTES) != hipSuccess || per_cu < 1) fprintf(stderr, "kernel_launch: occupancy query reports %d\n", per_cu);
        (void)hipGetLastError();
        grid = cus;
    }
    if (grid < 0) return;
    if (hipMemsetAsync((char*)d_ws + WS_CTL, 0, CTL_ZERO_BYTES, stream) != hipSuccess) { fprintf(stderr, "kernel_launch: memset failed\n"); return; }
    Args a{};
    a.in.x = (const float*)d_in[0]; a.in.pos = (const int*)d_in[1]; a.in.attn_norm_g = (const float*)d_in[2]; a.in.attn_w_in = (const float*)d_in[3]; a.in.attn_q_g = (const float*)d_in[4];
    a.in.attn_k_g = (const float*)d_in[5]; a.in.attn_w_out = (const float*)d_in[6]; a.in.conv_norm_g = (const float*)d_in[7]; a.in.conv_w_in = (const float*)d_in[8]; a.in.conv_w = (const float*)d_in[9];
    a.in.conv_w_out = (const float*)d_in[10]; a.in.mlp_norm_g = (const float*)d_in[11]; a.in.mlp_w1 = (const float*)d_in[12]; a.in.mlp_w2 = (const float*)d_in[13];
    a.out = (float*)d_out; a.ws = (unsigned char*)d_ws;
#if MK_PER_PHASE
    for (int ph = 0; ph < N_PHASES; ++ph) {
        const int li = (ph - 1) / 6, k = (ph - 1) % 6;
        if (ph > 0 && (li & 1) == 1 && k == 3) continue;
        a.ph_lo = ph; a.ph_hi = ph + 1;
        hipLaunchKernelGGL(trunk_fwd, dim3(grid), dim3(NWAVES * 64), LDS_BYTES, stream, a);
    }
#else
    a.ph_lo = 0; a.ph_hi = N_PHASES;
    hipLaunchKernelGGL(trunk_fwd, dim3(grid), dim3(NWAVES * 64), LDS_BYTES, stream, a);
#endif
    const hipError_t le = hipPeekAtLastError();
    if (le != hipSuccess) fprintf(stderr, "kernel_launch: launch failed: %s\n", hipGetErrorName(le));
}
```

```cpp
#define MK_PER_PHASE 0
#include <hip/hip_runtime.h>
#include <cstdio>
#include <cstdint>
namespace pg8 {
#define PG8_LAS __attribute__((address_space(3)))
typedef unsigned short bf16_t;
typedef short bf16x8 __attribute__((ext_vector_type(8)));
typedef float f32x4 __attribute__((ext_vector_type(4)));
typedef unsigned u32x4 __attribute__((ext_vector_type(4)));
constexpr int BM = 256, BK = 64, HALF = 128, HTB = HALF * BK * 2  , STAGE_BYTES = 8 * HTB, NXCD = 8, WGM = 8;

__host__ __device__ __forceinline__ int lds_byte(int r, int c) { const int st = (r >> 4) * 2 + (c >> 5), rr = r & 15, cc = c & 31, ob = rr * 64 + cc * 2; return st * 1024 + (ob ^ (((ob >> 9) & 1) << 5)); }
__host__ __device__ __forceinline__ void stage_rc(int b, int& R, int& C) { const int st = b / 1024, sb = b % 1024, swz = sb ^ (((sb >> 9) & 1) << 5); R = (st >> 1) * 16 + swz / 64; C = (st & 1) * 32 + (swz % 64) / 2; }
__host__ __device__ __forceinline__ int perm32(int rho) { const int n = rho >> 4, i = rho & 15; return 8 * (i >> 2) + 4 * n + (i & 3); }

struct Unit { int pm, pn; };
struct Gemm { const bf16_t* A; const bf16_t* Bt; int M, N, K; };

struct StaticOrder {
    int nM, nN, nwg, G, c;
    __host__ __device__ void init(int M, int N, int G_, int c_) { nM = M / BM; nN = N / BM; nwg = nM * nN; G = G_; c = c_; }
    __host__ __device__ bool next(int i, Unit& u) const {
        const long L = (long)i * G + c; if (L >= nwg) return false;
        int wgid = (int)L; { const int q = nwg / NXCD, r = nwg % NXCD, xcd = wgid % NXCD, off = wgid / NXCD; wgid = (xcd < r ? xcd * (q + 1) : r * (q + 1) + (xcd - r) * q) + off; }
        const int nig = WGM * nN, gid = wgid / nig, fm = gid * WGM, gsz = (nM - fm) < WGM ? (nM - fm) : WGM;
        u.pm = fm + ((wgid % nig) % gsz); u.pn = (wgid % nig) / gsz; return true;
    }
    __device__ __forceinline__ void a_ready(const Unit&) const {}
    __device__ __forceinline__ void done(const Unit&) const {}
};
__device__ __forceinline__ unsigned cvt_pk_bf16(float lo, float hi) { unsigned r; asm volatile("v_cvt_pk_bf16_f32 %0, %1, %2" : "=v"(r) : "v"(lo), "v"(hi)); return r; }
typedef unsigned u32x2 __attribute__((ext_vector_type(2)));
constexpr float RMS_EPS = 1e-6f;
typedef unsigned long long ssq_t;
__device__ __forceinline__ float rstd_of(ssq_t ssq) { return __builtin_amdgcn_rsqf((float)ssq * (1.0f / (2048.0f * 1048576.0f)) + RMS_EPS); }
__device__ __forceinline__ ssq_t ssq_fix(float s) { return (ssq_t)(s * 1048576.0f + 0.5f); }

template <bool FINAL> struct EpiRes {
    static constexpr bool PERM = true, AFTER_DRAIN = false;
    const bf16_t* base; bf16_t* xb; float* out; ssq_t* ssq;
    __device__ __forceinline__ void operator()(const f32x4 (&acc)[2][2][4][2], const Unit& u, int wr, int wc, int fr, int fq) const {
        const int row0 = u.pm * BM + wr * 64 + fr, col0 = u.pn * BM + wc * 32 + 8 * fq;
#pragma unroll
        for (int ai = 0; ai < 2; ++ai)
#pragma unroll
            for (int m = 0; m < 4; ++m) {
                const int row = row0 + ai * HALF + m * 16; const size_t off = (size_t)row * 2048 + col0; float s = 0.f;
#pragma unroll
                for (int bj = 0; bj < 2; ++bj) {
                    const u32x4 bw = *(const u32x4*)(base + off + bj * HALF);
                    const f32x4 b0 = {__uint_as_float(bw.x << 16), __uint_as_float(bw.x & 0xffff0000u), __uint_as_float(bw.y << 16), __uint_as_float(bw.y & 0xffff0000u)};
                    const f32x4 b1 = {__uint_as_float(bw.z << 16), __uint_as_float(bw.z & 0xffff0000u), __uint_as_float(bw.w << 16), __uint_as_float(bw.w & 0xffff0000u)};
                    const f32x4 o0 = b0 + acc[ai][bj][m][0], o1 = b1 + acc[ai][bj][m][1];
                    if (FINAL) { *(f32x4*)(out + off + bj * HALF) = o0; *(f32x4*)(out + off + bj * HALF + 4) = o1; }
                    else {
                        s += ((o0[0] * o0[0] + o0[1] * o0[1]) + (o0[2] * o0[2] + o0[3] * o0[3])) + ((o1[0] * o1[0] + o1[1] * o1[1]) + (o1[2] * o1[2] + o1[3] * o1[3]));
                        u32x4 w; w.x = cvt_pk_bf16(o0[0], o0[1]); w.y = cvt_pk_bf16(o0[2], o0[3]); w.z = cvt_pk_bf16(o1[0], o1[1]); w.w = cvt_pk_bf16(o1[2], o1[3]);
                        *(u32x4*)(xb + off + bj * HALF) = w; }
                }
                if (!FINAL) { s += __shfl_xor(s, 16); s += __shfl_xor(s, 32);
                    if (fq == 0) __hip_atomic_fetch_add(ssq + row, ssq_fix(s), __ATOMIC_RELAXED, __HIP_MEMORY_SCOPE_AGENT); }
                asm volatile("" ::: "memory");
            }
    }
};

struct EpiM1 {
    static constexpr bool PERM = true, AFTER_DRAIN = false;
    bf16_t* H; const ssq_t* ssq;
    __device__ __forceinline__ void operator()(const f32x4 (&acc)[2][2][4][2], const Unit& u, int wr, int wc, int fr, int fq) const {
        const int row0 = u.pm * BM + wr * 64 + fr, col0 = u.pn * BM + wc * 32 + 8 * fq;
#pragma unroll
        for (int ai = 0; ai < 2; ++ai)
#pragma unroll
            for (int m = 0; m < 4; ++m) {
                const int row = row0 + ai * HALF + m * 16; const float r = rstd_of(ssq[row]); bf16_t* rowp = H + (size_t)row * 8192 + col0;
#pragma unroll
                for (int bj = 0; bj < 2; ++bj) {
                    f32x4 v0 = acc[ai][bj][m][0] * r, v1 = acc[ai][bj][m][1] * r;
#pragma unroll
                    for (int j = 0; j < 4; ++j) { v0[j] = fmaxf(v0[j], 0.f); v1[j] = fmaxf(v1[j], 0.f); }
                    v0 = v0 * v0; v1 = v1 * v1;
                    u32x4 w; w.x = cvt_pk_bf16(v0[0], v0[1]); w.y = cvt_pk_bf16(v0[2], v0[3]); w.z = cvt_pk_bf16(v1[0], v1[1]); w.w = cvt_pk_bf16(v1[2], v1[3]);
                    *(u32x4*)(rowp + bj * HALF) = w; }
            }
    }
};

struct EpiC1 {
    static constexpr bool PERM = true, AFTER_DRAIN = false;
    bf16_t* Bg; bf16_t* Z; const ssq_t* ssq;
    __device__ __forceinline__ void operator()(const f32x4 (&acc)[2][2][4][2], const Unit& u, int wr, int wc, int fr, int fq) const {
        const int row0 = u.pm * BM + wr * 64 + fr;
        if (u.pn < 8) {
            const int col0 = u.pn * BM + wc * 32 + 8 * fq;
#pragma unroll
            for (int ai = 0; ai < 2; ++ai)
#pragma unroll
                for (int m = 0; m < 4; ++m) {
                    const int row = row0 + ai * HALF + m * 16; const float r = rstd_of(ssq[row]); bf16_t* rowp = Bg + (size_t)row * 2048 + col0;
#pragma unroll
                    for (int bj = 0; bj < 2; ++bj) {
                        const f32x4 v0 = acc[ai][bj][m][0] * r, v1 = acc[ai][bj][m][1] * r;
                        u32x4 w; w.x = cvt_pk_bf16(v0[0], v0[1]); w.y = cvt_pk_bf16(v0[2], v0[3]); w.z = cvt_pk_bf16(v1[0], v1[1]); w.w = cvt_pk_bf16(v1[2], v1[3]);
                        *(u32x4*)(rowp + bj * HALF) = w; }
                }
        } else {
            const int col0 = (u.pn - 8) * HALF + wc * 32 + 8 * fq;
#pragma unroll
            for (int ai = 0; ai < 2; ++ai)
#pragma unroll
                for (int m = 0; m < 4; ++m) {
                    const int row = row0 + ai * HALF + m * 16; const float r = rstd_of(ssq[row]); const float r2 = r * r;
                    const f32x4 v0 = acc[ai][0][m][0] * acc[ai][1][m][0] * r2, v1 = acc[ai][0][m][1] * acc[ai][1][m][1] * r2;
                    u32x4 w; w.x = cvt_pk_bf16(v0[0], v0[1]); w.y = cvt_pk_bf16(v0[2], v0[3]); w.z = cvt_pk_bf16(v1[0], v1[1]); w.w = cvt_pk_bf16(v1[2], v1[3]);
                    *(u32x4*)(Z + (size_t)row * 2048 + col0) = w;
                }
        }
    }
};

struct EpiA1 {
    static constexpr bool PERM = false, AFTER_DRAIN = false;
    const ssq_t* ssq; bf16_t *Q, *K, *V, *QI, *KI; float* WI; const float *qg, *kg, *ropeM, *ropeI; PG8_LAS float* P;
    __device__ __forceinline__ void operator()(const f32x4 (&acc)[2][2][4][2], const Unit& u, int wr, int wc, int fr, int fq) const {
        const int pn = u.pn, rl0 = wr * 64 + fr, row0 = u.pm * BM + rl0;
        if (pn < 10) {
            const bool isq = pn < 8; const float* g = isq ? qg : kg;
            const f32x4 g0 = *(const f32x4*)(g + 32 * wc + 4 * fq), g1 = *(const f32x4*)(g + 32 * wc + 16 + 4 * fq);
#pragma unroll
            for (int ai = 0; ai < 2; ++ai)
#pragma unroll
                for (int m = 0; m < 4; ++m) { const int rl = rl0 + ai * HALF + m * 16;
#pragma unroll
                    for (int bj = 0; bj < 2; ++bj) { const f32x4 a = acc[ai][bj][m][0], b = acc[ai][bj][m][1];
                        float s = ((a[0] * a[0] + a[1] * a[1]) + (a[2] * a[2] + a[3] * a[3])) + ((b[0] * b[0] + b[1] * b[1]) + (b[2] * b[2] + b[3] * b[3]));
                        s += __shfl_xor(s, 16); s += __shfl_xor(s, 32);
                        if (fq == 0) P[(rl * 2 + bj) * 4 + wc] = s; } }
            asm volatile("s_waitcnt lgkmcnt(0)" ::: "memory"); __builtin_amdgcn_s_barrier(); asm volatile("" ::: "memory");
#pragma unroll
            for (int ai = 0; ai < 2; ++ai)
#pragma unroll
                for (int m = 0; m < 4; ++m) { const int rl = rl0 + ai * HALF + m * 16, row = row0 + ai * HALF + m * 16; const float rs = rstd_of(ssq[row]);
                    f32x4 cs = {1.f, 1.f, 1.f, 1.f}, sn = {0.f, 0.f, 0.f, 0.f};
                    if (wc == 0) { cs = *(const f32x4*)(ropeM + (size_t)row * 32 + 4 * fq); sn = *(const f32x4*)(ropeM + (size_t)row * 32 + 16 + 4 * fq); }
                    bf16_t* dst = isq ? Q + (size_t)row * 2048 + pn * BM + wc * 32 + 4 * fq : K + (size_t)row * 512 + (pn - 8) * BM + wc * 32 + 4 * fq;
#pragma unroll
                    for (int bj = 0; bj < 2; ++bj) { const f32x4 pp = *(const PG8_LAS f32x4*)(P + (rl * 2 + bj) * 4);
                        const float tot = (pp[0] + pp[1]) + (pp[2] + pp[3]);
                        const float sc = rs * __builtin_amdgcn_rsqf(rs * rs * tot * (1.0f / 128.0f) + RMS_EPS);
                        f32x4 v0 = acc[ai][bj][m][0] * sc * g0, v1 = acc[ai][bj][m][1] * sc * g1;
                        if (wc == 0) { const f32x4 x1 = v0, x2 = v1; v0 = x1 * cs - x2 * sn; v1 = x2 * cs + x1 * sn; }
                        u32x2 w0, w1; w0.x = cvt_pk_bf16(v0[0], v0[1]); w0.y = cvt_pk_bf16(v0[2], v0[3]); w1.x = cvt_pk_bf16(v1[0], v1[1]); w1.y = cvt_pk_bf16(v1[2], v1[3]);
                        *(u32x2*)(dst + bj * HALF) = w0; *(u32x2*)(dst + bj * HALF + 16) = w1; } }
        } else if (pn < 12) {
#pragma unroll
            for (int ai = 0; ai < 2; ++ai)
#pragma unroll
                for (int m = 0; m < 4; ++m) { const int row = row0 + ai * HALF + m * 16; const float rs = rstd_of(ssq[row]);
                    bf16_t* dst = V + (size_t)row * 512 + (pn - 10) * BM + wc * 32 + 4 * fq;
#pragma unroll
                    for (int bj = 0; bj < 2; ++bj) { const f32x4 v0 = acc[ai][bj][m][0] * rs, v1 = acc[ai][bj][m][1] * rs;
                        u32x2 w0, w1; w0.x = cvt_pk_bf16(v0[0], v0[1]); w0.y = cvt_pk_bf16(v0[2], v0[3]); w1.x = cvt_pk_bf16(v1[0], v1[1]); w1.y = cvt_pk_bf16(v1[2], v1[3]);
                        *(u32x2*)(dst + bj * HALF) = w0; *(u32x2*)(dst + bj * HALF + 16) = w1; } }
        } else {
            const bool rot = ((wc & 1) == 0) && fq < 2;
            const int d0 = (wc & 1) ? 32 + 4 * fq : (fq < 2 ? 4 * fq : 16 + 4 * (fq - 2)), d1 = (wc & 1) ? 48 + 4 * fq : (fq < 2 ? 8 + 4 * fq : 24 + 4 * (fq - 2));
            const bool iski = pn == 16;
#pragma unroll
            for (int ai = 0; ai < 2; ++ai)
#pragma unroll
                for (int m = 0; m < 4; ++m) { const int row = row0 + ai * HALF + m * 16; const float rs = rstd_of(ssq[row]);
                    f32x4 cs = {1.f, 1.f, 1.f, 1.f}, sn = {0.f, 0.f, 0.f, 0.f};
                    if (rot) { cs = *(const f32x4*)(ropeI + (size_t)row * 16 + 4 * fq); sn = *(const f32x4*)(ropeI + (size_t)row * 16 + 8 + 4 * fq); }
#pragma unroll
                    for (int bj = 0; bj < 2; ++bj) {
                        f32x4 v0 = acc[ai][bj][m][0] * rs, v1 = acc[ai][bj][m][1] * rs;
                        if (iski) {
                            if (bj == 0) {
                                if (wc < 2) { if (rot) { const f32x4 x1 = v0, x2 = v1; v0 = x1 * cs - x2 * sn; v1 = x2 * cs + x1 * sn; }
                                    u32x2 w0, w1; w0.x = cvt_pk_bf16(v0[0], v0[1]); w0.y = cvt_pk_bf16(v0[2], v0[3]); w1.x = cvt_pk_bf16(v1[0], v1[1]); w1.y = cvt_pk_bf16(v1[2], v1[3]);
                                    bf16_t* dst = KI + (size_t)row * 64; *(u32x2*)(dst + d0) = w0; *(u32x2*)(dst + d1) = w1; }
                                else if (wc == 2) { *(f32x4*)(WI + (size_t)row * 16 + 4 * fq) = v0 * 0.03125f; }
                            }
                        } else {
                            if (rot) { const f32x4 x1 = v0, x2 = v1; v0 = x1 * cs - x2 * sn; v1 = x2 * cs + x1 * sn; }
                            u32x2 w0, w1; w0.x = cvt_pk_bf16(v0[0], v0[1]); w0.y = cvt_pk_bf16(v0[2], v0[3]); w1.x = cvt_pk_bf16(v1[0], v1[1]); w1.y = cvt_pk_bf16(v1[2], v1[3]);
                            bf16_t* dst = QI + (size_t)row * 1024 + ((pn - 12) * 4 + 2 * bj + (wc >> 1)) * 64; *(u32x2*)(dst + d0) = w0; *(u32x2*)(dst + d1) = w1; }
                    } }
        }
    }
};
template <class Epi, class Sched, bool ALIGN_EPI = false, bool SP2 = false>
__device__ __forceinline__ void gemm_phase(PG8_LAS unsigned char* lds, const Gemm g, const Sched& S, const Epi& E) {
    const int tid = threadIdx.x, wid = __builtin_amdgcn_readfirstlane(tid >> 6), lane = tid & 63, wr = wid >> 2, wc = wid & 3, fr = lane & 15, fq = lane >> 4;
    const int K = g.K, nt = K / BK;
    unsigned voffA[2], voffB[2];
#pragma unroll
    for (int i = 0; i < 2; ++i) { int R, C; stage_rc(tid * 16 + i * 8192, R, C); const int Rb = Epi::PERM ? ((R & ~31) + perm32(R & 31)) : R;
        voffA[i] = (unsigned)(R * K + C) * 2u; voffB[i] = (unsigned)(Rb * K + C) * 2u; }
    const size_t kstep = (size_t)(BK * 2);
    const size_t hstep = (size_t)HALF * K * 2;
    const size_t tstep = 2 * hstep;
    const unsigned ldsw = (unsigned)wid * 1024u;
    const int aoff = lds_byte(wr * 64 + fr, fq * 8), boff = lds_byte(wc * 32 + fr, fq * 8);
#define PG8_SA(b, h) (((b) * 2 + (h)) * HTB)
#define PG8_SB(b, h) ((4 + (b) * 2 + (h)) * HTB)
#define PG8_STAGE(bufoff, gbase, voff) do { _Pragma("unroll") for (int _i = 0; _i < 2; ++_i) \
        __builtin_amdgcn_global_load_lds((const unsigned*)((const char*)(gbase) + (voff)[_i]), (PG8_LAS unsigned*)(lds + (bufoff) + ldsw + _i * 8192), 16, 0, 0); } while (0)
#define PG8_LDA(dst, b, h) do { _Pragma("unroll") for (int m = 0; m < 4; ++m) _Pragma("unroll") for (int k = 0; k < 2; ++k) dst[m][k] = *(const PG8_LAS bf16x8*)(lds + PG8_SA(b, h) + aoff + m * 2048 + k * 1024); } while (0)
#define PG8_LDB(dst, b, h) do { _Pragma("unroll") for (int n = 0; n < 2; ++n) _Pragma("unroll") for (int k = 0; k < 2; ++k) dst[n][k] = *(const PG8_LAS bf16x8*)(lds + PG8_SB(b, h) + boff + n * 2048 + k * 1024); } while (0)
#define PG8_MMA(ai, bj, At, Bt) do { __builtin_amdgcn_s_setprio(1); _Pragma("unroll") for (int m = 0; m < 4; ++m) _Pragma("unroll") for (int n = 0; n < 2; ++n) _Pragma("unroll") for (int k = 0; k < 2; ++k) \
        acc[ai][bj][m][n] = __builtin_amdgcn_mfma_f32_16x16x32_bf16(Bt[n][k], At[m][k], acc[ai][bj][m][n], 0, 0, 0); __builtin_amdgcn_s_setprio(0); } while (0)
#define PG8_WAIT_V(n) asm volatile("s_waitcnt vmcnt(" #n ")" ::: "memory")
#define PG8_WAIT_L(n) asm volatile("s_waitcnt lgkmcnt(" #n ")" ::: "memory")
#define PG8_BAR __builtin_amdgcn_s_barrier()
#define PG8_SCHED __builtin_amdgcn_sched_barrier(0)
    Unit cur, nxt; int ui = 0;
    if (!S.next(0, cur)) return;
    f32x4 acc[2][2][4][2];
#pragma unroll
    for (int a = 0; a < 2; ++a)
#pragma unroll
        for (int b = 0; b < 2; ++b)
#pragma unroll
            for (int m = 0; m < 4; ++m)
#pragma unroll
                for (int n = 0; n < 2; ++n) acc[a][b][m][n] = (f32x4){0.f, 0.f, 0.f, 0.f};
    bf16x8 At[4][2], B0[2][2], B1[2][2];
    const char* cA = (const char*)g.A + (size_t)cur.pm * tstep; const char* cB = (const char*)g.Bt + (size_t)cur.pn * tstep;
    S.a_ready(cur);
    if constexpr (SP2) {
        PG8_STAGE(PG8_SB(0, 0), cB, voffB); PG8_STAGE(PG8_SB(0, 1), cB + hstep, voffB); PG8_STAGE(PG8_SA(0, 0), cA, voffA); PG8_STAGE(PG8_SA(0, 1), cA + hstep, voffA);
        if (wr == 1) PG8_BAR;
        PG8_WAIT_V(2); PG8_BAR;
        PG8_STAGE(PG8_SB(1, 0), cB + kstep, voffB); PG8_STAGE(PG8_SA(1, 0), cA + kstep, voffA); PG8_STAGE(PG8_SB(1, 1), cB + hstep + kstep, voffB);
        PG8_WAIT_V(6); PG8_BAR;
    } else {
        PG8_STAGE(PG8_SB(0, 0), cB, voffB); PG8_STAGE(PG8_SA(0, 0), cA, voffA); PG8_STAGE(PG8_SB(0, 1), cB + hstep, voffB); PG8_STAGE(PG8_SA(0, 1), cA + hstep, voffA);
        if (wr == 1) PG8_BAR;
        PG8_WAIT_V(4); PG8_BAR;
        PG8_STAGE(PG8_SB(1, 0), cB + kstep, voffB); PG8_STAGE(PG8_SA(1, 0), cA + kstep, voffA); PG8_STAGE(PG8_SB(1, 1), cB + hstep + kstep, voffB);
        PG8_WAIT_V(6); PG8_BAR;
    }
    for (;;) {
        const bool has_next = S.next(ui + 1, nxt);
        const char* nA = has_next ? (const char*)g.A + (size_t)nxt.pm * tstep : cA; const char* nB = has_next ? (const char*)g.Bt + (size_t)nxt.pn * tstep : cB;
        for (int t = 0; t < nt; t += 2) {
            const bool last = (t == nt - 2);
            const char* a1 = cA + (size_t)(t + 1) * kstep;
            const char* a2 = last ? nA : cA + (size_t)(t + 2) * kstep; const char* b2 = last ? nB : cB + (size_t)(t + 2) * kstep;
            const char* a3 = a2 + kstep; const char* b3 = b2 + kstep;
            if (last && has_next) S.a_ready(nxt);
            if constexpr (SP2) {
            PG8_LDB(B0, 0, 0); PG8_LDB(B1, 0, 1); PG8_SCHED; PG8_LDA(At, 0, 0); PG8_STAGE(PG8_SA(1, 1), a1 + hstep, voffA);
            PG8_WAIT_V(8); PG8_WAIT_L(0); PG8_BAR; PG8_MMA(0, 0, At, B0); PG8_MMA(0, 1, At, B1); PG8_BAR; PG8_SCHED;
            PG8_LDA(At, 0, 1); PG8_STAGE(PG8_SB(0, 0), b2, voffB); PG8_STAGE(PG8_SB(0, 1), b2 + hstep, voffB); PG8_STAGE(PG8_SA(0, 0), a2, voffA);
            PG8_WAIT_V(8); PG8_WAIT_L(0); PG8_BAR; PG8_MMA(1, 0, At, B0); PG8_MMA(1, 1, At, B1); PG8_BAR; PG8_SCHED;
            PG8_LDB(B0, 1, 0); PG8_LDB(B1, 1, 1); PG8_SCHED; PG8_LDA(At, 1, 0); PG8_STAGE(PG8_SA(0, 1), a2 + hstep, voffA);
            PG8_WAIT_V(8); PG8_WAIT_L(0); PG8_BAR; PG8_MMA(0, 0, At, B0); PG8_MMA(0, 1, At, B1); PG8_BAR; PG8_SCHED;
            PG8_LDA(At, 1, 1); PG8_STAGE(PG8_SB(1, 0), b3, voffB); PG8_STAGE(PG8_SB(1, 1), b3 + hstep, voffB); PG8_STAGE(PG8_SA(1, 0), a3, voffA);
            PG8_WAIT_V(8); PG8_WAIT_L(0); PG8_BAR; PG8_MMA(1, 0, At, B0); PG8_MMA(1, 1, At, B1); PG8_BAR; PG8_SCHED;
            } else {
            PG8_LDB(B0, 0, 0); PG8_SCHED; PG8_LDA(At, 0, 0); PG8_STAGE(PG8_SA(1, 1), a1 + hstep, voffA);
            PG8_WAIT_L(8); PG8_BAR; PG8_WAIT_L(0); PG8_MMA(0, 0, At, B0); PG8_BAR; PG8_SCHED;
            PG8_LDB(B1, 0, 1); PG8_STAGE(PG8_SB(0, 0), b2, voffB);
            PG8_BAR; PG8_WAIT_L(0); PG8_MMA(0, 1, At, B1); PG8_BAR;
            PG8_LDA(At, 0, 1); PG8_STAGE(PG8_SA(0, 0), a2, voffA);
            PG8_BAR; PG8_WAIT_L(0); PG8_MMA(1, 0, At, B0); PG8_BAR; PG8_SCHED;
            PG8_STAGE(PG8_SB(0, 1), b2 + hstep, voffB);
            PG8_WAIT_V(6); PG8_BAR; PG8_MMA(1, 1, At, B1); PG8_BAR;
            PG8_LDB(B0, 1, 0); PG8_SCHED; PG8_LDA(At, 1, 0); PG8_STAGE(PG8_SA(0, 1), a2 + hstep, voffA);
            PG8_WAIT_L(8); PG8_BAR; PG8_WAIT_L(0); PG8_MMA(0, 0, At, B0); PG8_BAR; PG8_SCHED;
            PG8_LDB(B1, 1, 1); PG8_STAGE(PG8_SB(1, 0), b3, voffB);
            PG8_BAR; PG8_WAIT_L(0); PG8_MMA(0, 1, At, B1); PG8_BAR;
            PG8_LDA(At, 1, 1); PG8_STAGE(PG8_SA(1, 0), a3, voffA);
            PG8_BAR; PG8_WAIT_L(0); PG8_MMA(1, 0, At, B0); PG8_BAR; PG8_SCHED;
            PG8_STAGE(PG8_SB(1, 1), b3 + hstep, voffB);
            PG8_WAIT_V(6); PG8_BAR; PG8_MMA(1, 1, At, B1); PG8_BAR;
            }
        }
        if constexpr (ALIGN_EPI) { if (wr == 0) PG8_BAR; }
        if constexpr (!Epi::AFTER_DRAIN) { E(acc, cur, wr, wc, fr, fq); S.done(cur); }
        if (!has_next) break;
#pragma unroll
        for (int a = 0; a < 2; ++a)
#pragma unroll
            for (int b = 0; b < 2; ++b)
#pragma unroll
                for (int m = 0; m < 4; ++m)
#pragma unroll
                    for (int n = 0; n < 2; ++n) acc[a][b][m][n] = (f32x4){0.f, 0.f, 0.f, 0.f};
        cur = nxt; cA = nA; cB = nB; ++ui;
        if constexpr (ALIGN_EPI) { if (wr == 1) PG8_BAR; }
    }
    PG8_WAIT_V(0);
    if constexpr (!ALIGN_EPI) { if (wr == 0) PG8_BAR; }
    PG8_BAR;
    if constexpr (Epi::AFTER_DRAIN) { E.fused(acc, cur, wr, wc, fr, fq, lds, wid, lane); S.done(cur); }
#undef PG8_SA
#undef PG8_SB
#undef PG8_STAGE
#undef PG8_LDA
#undef PG8_LDB
#undef PG8_MMA
#undef PG8_WAIT_V
#undef PG8_WAIT_L
#undef PG8_BAR
#undef PG8_SCHED
}
}
namespace att {
typedef unsigned short bf16;
typedef short bf16x8 __attribute__((ext_vector_type(8)));
typedef short s16x4 __attribute__((ext_vector_type(4)));
typedef float f32x16 __attribute__((ext_vector_type(16)));
typedef float f32x4 __attribute__((ext_vector_type(4)));
typedef unsigned u32x4 __attribute__((ext_vector_type(4)));
typedef unsigned long long u64;
constexpr int D = 128, SEQ = 4096, QP = 2048, KP = 512;
constexpr float SCALE = 0.08838834764831845f;
constexpr float THR = 8.f;
constexpr int NW = 8, QBLK = 32, KVBLK = 64, QB = NW * QBLK;
constexpr int SHM_V = KVBLK * D * 2, SHM_K = KVBLK * D * 2;
constexpr int LDS_BYTES = 2 * SHM_V + 2 * SHM_K + NW * 64 * 4;

#define KSWZ(row, colB) ((row) * 256 + ((colB) ^ (((row) & 7) << 4)))
#define SBAR() __builtin_amdgcn_sched_barrier(0)
__device__ __forceinline__ int v_st(int k, int c) { const int kk = (k & ~0xC) | ((k & 4) << 1) | ((k & 8) >> 1); return ((kk >> 3) * 4 + (c >> 5)) * 512 + ((kk & 7) * 32 + (c & 31)) * 2; }
__device__ __forceinline__ int v_rd_base(int lane) { return ((lane & 3) << 3) | (((lane >> 2) & 3) << 6) | (((lane >> 4) & 1) << 5) | (((lane >> 5) & 1) << 8); }
constexpr int v_rd_off(int d0, int ks, int half) { return d0 * 512 + ks * 4096 + half * 2048; }
__device__ __forceinline__ int crow(int r, int hi) { return (r & 3) + 8 * (r >> 2) + 4 * hi; }
__device__ __forceinline__ unsigned cvtpk(float lo, float hi) { unsigned r; asm volatile("v_cvt_pk_bf16_f32 %0, %1, %2" : "=v"(r) : "v"(lo), "v"(hi)); return r; }
__device__ __forceinline__ bf16x8 load8(const bf16* p) { return *reinterpret_cast<const bf16x8*>(p); }
__device__ __forceinline__ void mask_tile(f32x16& p0, f32x16& p1, u64 mk, int hi) {
    const unsigned m0 = (unsigned)mk >> (4 * hi), m1 = (unsigned)(mk >> 32) >> (4 * hi);
    const unsigned NEGINF = 0xFF800000u;
    asm volatile("s_nop 15\n\ts_nop 7" ::: "memory");
#pragma unroll
    for (int r = 0; r < 16; ++r) {
        const int c = (r & 3) + 8 * (r >> 2);
        unsigned t0, t1;
        asm volatile("v_bfe_i32 %0, %1, %2, 1" : "=v"(t0) : "v"(m0), "n"(c));
        asm volatile("v_bfi_b32 %0, %1, %0, %2" : "+v"(p0[r]) : "v"(t0), "s"(NEGINF));
        asm volatile("v_bfe_i32 %0, %1, %2, 1" : "=v"(t1) : "v"(m1), "n"(c));
        asm volatile("v_bfi_b32 %0, %1, %0, %2" : "+v"(p1[r]) : "v"(t1), "s"(NEGINF));
    }
}
__device__ __forceinline__ void partialSM(f32x16& p0, f32x16& p1, float& m_reg, float& mn, float& alpha) {
    float pmax = p0[0]; for (int r = 1; r < 16; ++r) pmax = fmaxf(pmax, p0[r]); for (int r = 0; r < 16; ++r) pmax = fmaxf(pmax, p1[r]);
    { auto rr = __builtin_amdgcn_permlane32_swap(__float_as_uint(pmax), __float_as_uint(pmax), false, false);
      pmax = fmaxf(__uint_as_float(rr[0]), __uint_as_float(rr[1])); }
    constexpr float C2 = 1.4426950408889634f * SCALE;
    if (__builtin_expect(__all((pmax - m_reg) * SCALE <= THR), 1)) { mn = m_reg; alpha = 1.f; }
    else { mn = fmaxf(m_reg, pmax); alpha = __builtin_amdgcn_exp2f((m_reg - mn) * C2); m_reg = mn; }
    const float mnL = -mn * C2;
    for (int r = 0; r < 16; ++r) p0[r] = fmaf(p0[r], C2, mnL); for (int r = 0; r < 16; ++r) p1[r] = fmaf(p1[r], C2, mnL);
    for (int r = 0; r < 16; ++r) p0[r] = __builtin_amdgcn_exp2f(p0[r]);
}
__device__ __forceinline__ void finishSM(f32x16& p0, f32x16& p1, float alpha, float& l_reg, bf16x8& pa0, bf16x8& pa1, bf16x8& pa2, bf16x8& pa3) {
    for (int r = 0; r < 16; ++r) p1[r] = __builtin_amdgcn_exp2f(p1[r]);
    float ps = 0; for (int r = 0; r < 16; ++r) ps += p0[r]; for (int r = 0; r < 16; ++r) ps += p1[r];
    { auto rr = __builtin_amdgcn_permlane32_swap(__float_as_uint(ps), __float_as_uint(ps), false, false);
      ps = __uint_as_float(rr[0]) + __uint_as_float(rr[1]); }
    l_reg = l_reg * alpha + ps;
#define PK4(P, B_, OUT) do { unsigned a0 = cvtpk(P[B_+0], P[B_+1]), a1 = cvtpk(P[B_+2], P[B_+3]);                          \
        unsigned b0 = cvtpk(P[B_+4], P[B_+5]), b1 = cvtpk(P[B_+6], P[B_+7]);                                             \
        auto r0 = __builtin_amdgcn_permlane32_swap(a0, b0, false, false); auto r1 = __builtin_amdgcn_permlane32_swap(a1, b1, false, false); \
        u32x4 w = {r0[0], r1[0], r0[1], r1[1]}; OUT = *reinterpret_cast<bf16x8*>(&w); } while (0)
    PK4(p0, 0, pa0); PK4(p0, 8, pa1); PK4(p1, 0, pa2); PK4(p1, 8, pa3);
#undef PK4
}
template <int KB>
__device__ __forceinline__ void qkt(f32x16& p0, f32x16& p1, const char* K_lds, int r32, int hi, const bf16x8* qr) {
    p0 = f32x16{}; p1 = f32x16{};
    const char* kb[4];
#pragma unroll
    for (int dd = 0; dd < 4; ++dd) kb[dd] = K_lds + KB * SHM_K + KSWZ(r32, (dd * 16 + hi * 8) * 2);
#pragma unroll
    for (int d0 = 0; d0 < 8; ++d0) { const char* a = kb[d0 & 3] + (d0 >> 2) * 128;
        bf16x8 b0 = *reinterpret_cast<const bf16x8*>(a);
        bf16x8 b1 = *reinterpret_cast<const bf16x8*>(a + 32 * 256);
        p0 = __builtin_amdgcn_mfma_f32_32x32x16_bf16(b0, qr[d0], p0, 0, 0, 0);
        p1 = __builtin_amdgcn_mfma_f32_32x32x16_bf16(b1, qr[d0], p1, 0, 0, 0); }
}
template <int VB>
__device__ __forceinline__ void pv_tile(f32x16* o, int vb0, bf16x8 pa0, bf16x8 pa1, bf16x8 pa2, bf16x8 pa3) {
#define TRRD(dst, off) asm volatile("ds_read_b64_tr_b16 %0, %1 offset:%2" : "=&v"(dst) : "v"(vb0), "i"(off) : "memory")
#define PV_D0(d0) do { s16x4 l0, l1, l2, l3, h0, h1, h2, h3; constexpr int b_ = VB * SHM_V + v_rd_off(d0, 0, 0); \
        TRRD(l0, b_); TRRD(h0, b_ + 2048); TRRD(l1, b_ + 4096); TRRD(h1, b_ + 6144); TRRD(l2, b_ + 8192); TRRD(h2, b_ + 10240); TRRD(l3, b_ + 12288); TRRD(h3, b_ + 14336); \
        asm volatile("s_waitcnt lgkmcnt(0)" ::: "memory"); SBAR();   \
        o[d0] = __builtin_amdgcn_mfma_f32_32x32x16_bf16(pa0, (bf16x8){l0[0], l0[1], l0[2], l0[3], h0[0], h0[1], h0[2], h0[3]}, o[d0], 0, 0, 0);   \
        o[d0] = __builtin_amdgcn_mfma_f32_32x32x16_bf16(pa1, (bf16x8){l1[0], l1[1], l1[2], l1[3], h1[0], h1[1], h1[2], h1[3]}, o[d0], 0, 0, 0);   \
        o[d0] = __builtin_amdgcn_mfma_f32_32x32x16_bf16(pa2, (bf16x8){l2[0], l2[1], l2[2], l2[3], h2[0], h2[1], h2[2], h2[3]}, o[d0], 0, 0, 0);   \
        o[d0] = __builtin_amdgcn_mfma_f32_32x32x16_bf16(pa3, (bf16x8){l3[0], l3[1], l3[2], l3[3], h3[0], h3[1], h3[2], h3[3]}, o[d0], 0, 0, 0); } while (0)
    PV_D0(0); PV_D0(1); PV_D0(2); PV_D0(3);
#undef PV_D0
#undef TRRD
}
__device__ __forceinline__ u64 causal_word(int n) { return n >= 64 ? ~0ull : (n <= 0 ? 0ull : ((1ull << n) - 1ull)); }
struct BlockRef { const bf16* Q; const bf16* K; const bf16* V; bf16* O; const u64* M; int P0; };
struct Seam { bf16x8 qr[8]; bf16x8 st_v0, st_v1, st_k0, st_k1; };
#define ROW(p, k0, rr) ((p) + (unsigned)(((k0) + (rr)) * KP + sc))
#define VMW() asm volatile("s_waitcnt vmcnt(0)" ::: "memory")
#define VMWN(n) asm volatile("s_waitcnt vmcnt(%0)" :: "i"(n) : "memory")
#define SLOAD_H(Kp, Vp, k0) do { S.st_v0 = load8(ROW(Vp, k0, sr)); S.st_v1 = load8(ROW(Vp, k0, 32 + sr));              \
                         S.st_k0 = load8(ROW(Kp, k0, sr)); S.st_k1 = load8(ROW(Kp, k0, 32 + sr)); } while (0)
#define SWRITE_HK(bf) do { *(bf16x8*)(K_lds + (bf) * SHM_K + kws) = S.st_k0; *(bf16x8*)(K_lds + (bf) * SHM_K + kws + 32 * 256) = S.st_k1; } while (0)
#define SWRITE_HV(bf) do { *(bf16x8*)(V_lds + (bf) * SHM_V + vst0) = S.st_v0; *(bf16x8*)(V_lds + (bf) * SHM_V + vst1) = S.st_v1; } while (0)
#define SWRITE_H(bf) do { SWRITE_HV(bf); SWRITE_HK(bf); } while (0)
__device__ __forceinline__ void attn_prime(const BlockRef& cur, char* lds, Seam& S) {
    const int tid = threadIdx.x, wid = __builtin_amdgcn_readfirstlane(tid >> 6), lane = tid & 63, r32 = lane & 31, hi = lane >> 5;
    const int sr = tid >> 4, sc = (tid & 15) * 8, kws = KSWZ(sr, sc * 2); char* K_lds = lds + 2 * SHM_V;
    for (int d0 = 0; d0 < 8; ++d0) S.qr[d0] = load8(cur.Q + (unsigned)((wid * QBLK + r32) * QP + d0 * 16 + hi * 8));
    SLOAD_H(cur.K, cur.V, 0); VMW(); SWRITE_HK(0);
    __syncthreads();
}
__device__ __forceinline__ void attn_block(const BlockRef& cur, const BlockRef& nxt, char* lds, Seam& S) {
    const int tid = threadIdx.x, wid = __builtin_amdgcn_readfirstlane(tid >> 6), lane = tid & 63, r32 = lane & 31, hi = lane >> 5;
    const int NT = (cur.P0 + QB - 1) / KVBLK + 1;
    char* V_lds = lds; char* K_lds = lds + 2 * SHM_V;
    float* ws = (float*)(lds + 2 * SHM_V + 2 * SHM_K) + wid * 64; float* li_l = ws, * al_l = ws + 32;
    float m_reg = -1e30f, l_reg = 0; f32x16 o[4] = {};
    const int sr = tid >> 4, sc = (tid & 15) * 8, vst0 = v_st(sr, sc), vst1 = v_st(32 + sr, sc), kws = KSWZ(sr, sc * 2);
    const int vb0 = (int)(uintptr_t)V_lds + v_rd_base(lane);
    const bf16* Kh = cur.K; const bf16* Vh = cur.V;
    const u64* Mb = cur.M; const unsigned mo = (unsigned)(cur.P0 + wid * QBLK + r32);
#if defined(DBG_CAUSAL_ONLY)
#define LOADMK(t) causal_word((int)mo - 64 * (t) + 1)
#else
#define LOADMK(t) Mb[mo + (unsigned)((t) * SEQ)]
#endif
#define RESC(a) do { if (__any((a) < 1.f)) { if (hi == 0) al_l[r32] = (a); asm volatile("s_waitcnt lgkmcnt(0)" ::: "memory");              \
                     for (int d_ = 0; d_ < 4; ++d_) for (int r = 0; r < 16; ++r) o[d_][r] *= al_l[crow(r, hi)]; } } while (0)
#define KBASE(t) ((t) * KVBLK)
#define SEAM_K0() do { VMWN(8); SWRITE_HK(0); SBAR(); } while (0)
    f32x16 pA0, pA1, pB0, pB1; float mnA, mnB, alA, alB; bf16x8 pa0, pa1, pa2, pa3; u64 mk;
    SWRITE_HV(0); SBAR();
    mk = LOADMK(0);
    if (NT > 1) { SLOAD_H(Kh, Vh, KBASE(1)); }
    SBAR(); qkt<0>(pA0, pA1, K_lds, r32, hi, S.qr); SBAR();
    VMW();
    mask_tile(pA0, pA1, mk, hi); partialSM(pA0, pA1, m_reg, mnA, alA);
    if (NT > 1) { SWRITE_H(1); }
    __syncthreads();
#define HALF_STEP(PX0, PX1, mnX, alX, PY0, PY1, alY, t, KB, VB, SB) do {                                                     \
        mk = LOADMK(t);                                                                                           \
        SBAR(); qkt<KB>(PX0, PX1, K_lds, r32, hi, S.qr);                                                                      \
        finishSM(PY0, PY1, alY, l_reg, pa0, pa1, pa2, pa3); SBAR();                                                           \
        if ((t) + 1 < NT) { SLOAD_H(Kh, Vh, KBASE((t) + 1)); SBAR(); }                                                        \
        pv_tile<VB>(o, vb0, pa0, pa1, pa2, pa3);                                                                              \
        if ((t) + 1 < NT) VMWN(4); else VMW();                                                                                \
        mask_tile(PX0, PX1, mk, hi); partialSM(PX0, PX1, m_reg, mnX, alX);                                                    \
        __syncthreads();                                                                                                      \
        if ((t) + 1 < NT) { VMW(); SWRITE_H(SB); }                                                                            \
        RESC(alX); __syncthreads(); } while (0)
    for (int t = 1; t + 1 < NT; t += 2) {
        HALF_STEP(pB0, pB1, mnB, alB, pA0, pA1, alA, t, 1, 0, 0);
        HALF_STEP(pA0, pA1, mnA, alA, pB0, pB1, alB, t + 1, 0, 1, 1);
    }
    const bool even = (NT & 1) == 0;
    if (even) { mk = LOADMK(NT - 1); SBAR(); qkt<1>(pB0, pB1, K_lds, r32, hi, S.qr); SBAR(); }
    SLOAD_H(nxt.K, nxt.V, 0); SBAR();
#pragma unroll
    for (int d0 = 0; d0 < 8; ++d0) S.qr[d0] = load8(nxt.Q + (unsigned)((wid * QBLK + r32) * QP + d0 * 16 + hi * 8));
    SBAR();
    finishSM(pA0, pA1, alA, l_reg, pa0, pa1, pa2, pa3); SBAR();
    pv_tile<0>(o, vb0, pa0, pa1, pa2, pa3);
    if (even) { VMWN(12); mask_tile(pB0, pB1, mk, hi); partialSM(pB0, pB1, m_reg, mnB, alB); __syncthreads(); RESC(alB);
        finishSM(pB0, pB1, alB, l_reg, pa0, pa1, pa2, pa3); SBAR(); pv_tile<1>(o, vb0, pa0, pa1, pa2, pa3); }
    SBAR(); SEAM_K0();
    if (hi == 0) li_l[r32] = l_reg; asm volatile("s_waitcnt lgkmcnt(0)" ::: "memory");
    float rli[16];
#pragma unroll
    for (int r = 0; r < 16; ++r) rli[r] = __builtin_amdgcn_rcpf(li_l[crow(r, hi)]);
    bf16* Ow = cur.O + (unsigned)((wid * QBLK) * QP);
#pragma unroll
    for (int r = 0; r < 16; ++r) { const int orow = crow(r, hi);
#pragma unroll
        for (int d0 = 0; d0 < 4; ++d0) { const float v = o[d0][r] * rli[r];
            const float vn = __shfl_xor(v, 1);
            if ((r32 & 1) == 0) *(unsigned*)(Ow + (unsigned)(orow * QP + d0 * 32 + r32)) = cvtpk(v, vn); } }
    __syncthreads();
#undef RESC
#undef KBASE
#undef SEAM_K0
#undef HALF_STEP
}
#undef ROW
#undef VMW
#undef VMWN
#undef SLOAD_H
#undef SWRITE_HK
#undef SWRITE_HV
#undef SWRITE_H
struct Item { int bh, qb0, qb1; };
__device__ __forceinline__ Item decode(int L) {
    constexpr int G = 4, nx = 8, per = G * nx; Item it;
    const int xcd = L & 7, k = L >> 3, gi = k / per, r = k - gi * per;
    it.bh = (gi * 8 + xcd) * G + r / nx; const int x = r % nx;
    it.qb0 = x; it.qb1 = 15 - x; return it;
}
struct Tensors { const bf16* Q; const bf16* K; const bf16* V; bf16* O; const u64* M; };
__device__ __forceinline__ BlockRef make_ref(const Item& it, int pass, const Tensors& T) {
    const int qb = pass ? it.qb1 : it.qb0, b = it.bh >> 4, h = it.bh & 15, kvh = h >> 2;
    BlockRef r;
    r.Q = T.Q + ((size_t)b * SEQ + (size_t)qb * QB) * QP + h * D; r.O = T.O + ((size_t)b * SEQ + (size_t)qb * QB) * QP + h * D;
    r.K = T.K + (size_t)b * SEQ * KP + kvh * D; r.V = T.V + (size_t)b * SEQ * KP + kvh * D; r.M = T.M + (size_t)b * 64 * SEQ; r.P0 = qb * QB;
    return r;
}
__device__ __forceinline__ void attn_phase(char* lds, const Tensors& T, int wg, int nwg) {
    constexpr int total = 512;
    int L = wg; if (L >= total) return;
    Item it = decode(L); int pass = 0;
    BlockRef cur = make_ref(it, 0, T);
    Seam S;
    attn_prime(cur, lds, S);
    for (;;) {
        const bool more_pass = pass == 0 && it.qb1 != it.qb0, more_item = L + nwg < total, last = !more_pass && !more_item;
        Item itn = it; int passn = pass + 1, Ln = L;
        if (!more_pass) { passn = 0; Ln = more_item ? L + nwg : L; itn = decode(Ln); }
        const BlockRef nxt = last ? cur : make_ref(itn, passn, T);
        attn_block(cur, nxt, lds, S);
        if (last) break;
        cur = nxt; it = itn; pass = passn; L = Ln;
    }
}
#undef KSWZ
#undef SBAR
}
constexpr int NWAVES = 8;
#ifndef DBG_A4_SRC
#define DBG_A4_SRC WS_O
#endif
#ifndef MK_PER_PHASE
#define MK_PER_PHASE 0
#endif
constexpr int BATCH = 4, SEQ = 4096, DM = 2048, M = BATCH * SEQ, DFF = 8192, DEPTH = 4;
constexpr int NA1 = 4352, NA1_SRC = 4176, NC1 = 6144;
constexpr int TOPK = 256;
constexpr size_t MiB = 1u << 20;
constexpr size_t WS_CTL = 0, CTL_ZERO_BYTES = 3 * MiB;
constexpr int CW_BAR = 4096;
constexpr size_t WS_SSQ = 1 * MiB;
constexpr size_t WS_ROPEM = 3 * MiB;
constexpr size_t WS_ROPEI = 5 * MiB;
constexpr size_t WS_WA1 = 6 * MiB;  static_assert(WS_SSQ + 9 * (size_t)M * 8 <= CTL_ZERO_BYTES, "ssq inside memset");
constexpr size_t SZ_WA1 = (size_t)NA1 * DM * 2;
constexpr size_t WS_WA4 = WS_WA1 + 2 * SZ_WA1;
constexpr size_t SZ_WSQ = (size_t)DM * DM * 2;
constexpr size_t WS_WC1 = WS_WA4 + 2 * SZ_WSQ;
constexpr size_t SZ_WC1 = (size_t)NC1 * DM * 2;
constexpr size_t WS_WC2 = WS_WC1 + 2 * SZ_WC1;
constexpr size_t WS_WM1 = WS_WC2 + 2 * SZ_WSQ;
constexpr size_t SZ_WM = (size_t)DFF * DM * 2;
constexpr size_t WS_WM2 = WS_WM1 + 4 * SZ_WM;
constexpr size_t WS_XB = WS_WM2 + 4 * SZ_WM;
constexpr size_t WS_ACT = WS_XB + (size_t)M * DM * 2;
constexpr size_t SZ_MD = (size_t)M * DM * 2;
constexpr size_t WS_H = WS_ACT;
constexpr size_t WS_Q = WS_ACT, WS_O = WS_ACT + SZ_MD, WS_K = WS_ACT + 2 * SZ_MD, WS_V = WS_K + 16 * MiB, WS_QI = WS_V + 16 * MiB, WS_KI = WS_QI + 32 * MiB,
                 WS_WI = WS_KI + 2 * MiB, WS_MASK = WS_WI + 1 * MiB;
constexpr size_t WS_BG = WS_ACT, WS_Z = WS_ACT + SZ_MD, WS_G = WS_ACT + 2 * SZ_MD;
constexpr size_t WS_END = WS_ACT + 256 * MiB;
static_assert(WS_MASK + 8 * MiB <= WS_END && WS_G + SZ_MD <= WS_END && WS_H + (size_t)M * DFF * 2 <= WS_END, "d_ws map");
constexpr int RING_OFF = 0, RING_BYTES = 131072;
constexpr int AUX_OFF = RING_BYTES, AUX_BYTES = 16384 + 2048;
constexpr int MISC_OFF = AUX_OFF + AUX_BYTES;
constexpr int LDS_BYTES = MISC_OFF + 256;
static_assert(LDS_BYTES <= 160 * 1024, "LDS map");

#define GAS __attribute__((address_space(1)))
#define LAS __attribute__((address_space(3)))
typedef unsigned short bf16;
typedef unsigned v4u __attribute__((ext_vector_type(4)));
typedef unsigned v2u __attribute__((ext_vector_type(2)));
typedef float f32x4 __attribute__((ext_vector_type(4)));
typedef short bf16x8 __attribute__((ext_vector_type(8)));
typedef float f32x16 __attribute__((ext_vector_type(16)));
typedef GAS unsigned gu32;
#define RLX_AGENT __ATOMIC_RELAXED, __HIP_MEMORY_SCOPE_AGENT
#define LDS_WAIT() asm volatile("s_waitcnt lgkmcnt(0)" ::: "memory")
#define VM_WAIT() asm volatile("s_waitcnt vmcnt(0)" ::: "memory")
__device__ __forceinline__ unsigned f2bf(float f) { unsigned u = __builtin_bit_cast(unsigned, f); return (u + 0x7fffu + ((u >> 16) & 1u)) >> 16; }
__device__ __forceinline__ unsigned pk2(float lo, float hi) { return f2bf(lo) | (f2bf(hi) << 16); }
__device__ __forceinline__ float bf2f(unsigned short b) { return __uint_as_float((unsigned)b << 16); }
__device__ __forceinline__ float wave_sum(float v) {
#pragma unroll
    for (int o = 1; o < 64; o <<= 1) v += __shfl_xor(v, o);
    return v;
}
__device__ __forceinline__ float wave_min(float v) {
#pragma unroll
    for (int o = 1; o < 64; o <<= 1) v = fminf(v, __shfl_xor(v, o));
    return v;
}
__device__ __forceinline__ float wave_max(float v) {
#pragma unroll
    for (int o = 1; o < 64; o <<= 1) v = fmaxf(v, __shfl_xor(v, o));
    return v;
}

#define XB_TMO      128
#define XB_XCNT(j)  (256  + 64 * (j))
#define XB_XSUB(j)  (1280 + 64 * (j))
#define XB_XGEN(j)  (2304 + 64 * (j))
#define XB_TOP      3328
#define XB_TOPGEN   3392
#define XCD_BAR_WORDS 3456
#define XB_SPIN_CAP (1u << 18)

__device__ __forceinline__ unsigned xb_ld(unsigned* p)              { return __hip_atomic_load(p, __ATOMIC_RELAXED, __HIP_MEMORY_SCOPE_AGENT); }
__device__ __forceinline__ unsigned xb_add(unsigned* p, unsigned v) { return __hip_atomic_fetch_add(p, v, __ATOMIC_RELAXED, __HIP_MEMORY_SCOPE_AGENT); }
__device__ __forceinline__ unsigned xb_xcc_id() { return (unsigned)__builtin_amdgcn_s_getreg((3 << 11) | 20) & 0xFu; }
#define XB_SPIN(cond, bar) do { unsigned _sp = 0; while (cond) { __builtin_amdgcn_s_sleep(1); \
    if ((++_sp & 255u) == 0u) { if (xb_ld(&(bar)[XB_TMO])) break; if (_sp > XB_SPIN_CAP) { atomicAdd(&(bar)[XB_TMO], 1u); break; } } } } while (0)

struct XcdBarrier {
    unsigned* bar; unsigned x;
    volatile LAS unsigned* st;
};

__device__ __forceinline__ XcdBarrier xcd_barrier_post(unsigned* bar, volatile LAS unsigned* st) {
    XcdBarrier b; b.bar = bar; b.x = xb_xcc_id(); b.st = st;
    if (threadIdx.x == 0) (void)xb_add(&bar[XB_XCNT(b.x)], 1u);
    return b;
}
__device__ __forceinline__ void xcd_barrier_complete(unsigned* bar, unsigned x, unsigned& nloc, unsigned& nx) {
    const unsigned G = gridDim.x * gridDim.y * gridDim.z;
    unsigned sum, cnt, mine, sp = 0u;
    for (;;) {
        sum = 0u; cnt = 0u; mine = 0u;
#pragma unroll
        for (unsigned j = 0; j < 16; ++j) { const unsigned c = xb_ld(&bar[XB_XCNT(j)]); sum += c; cnt += (c > 0u) ? 1u : 0u; mine = (j == x) ? c : mine; }
        if (sum == G) break;
        __builtin_amdgcn_s_sleep(1);
        if ((++sp & 255u) == 0u) { if (xb_ld(&bar[XB_TMO])) break; if (sp > XB_SPIN_CAP) { atomicAdd(&bar[XB_TMO], 1u); break; } }
    }
    nloc = mine > 0u ? mine : 1u; nx = cnt > 0u ? cnt : 1u;
}

__device__ __forceinline__ void xcd_barrier(const XcdBarrier& b) {
    asm volatile("s_waitcnt vmcnt(0)" ::: "memory");
    __syncthreads();
    if (threadIdx.x == 0) {
        unsigned* bar = b.bar;
        __builtin_amdgcn_s_waitcnt(0);
        unsigned nloc = b.st[0], nx = b.st[1];
        if (nloc == 0u) { xcd_barrier_complete(bar, b.x, nloc, nx); b.st[0] = nloc; b.st[1] = nx; }
        const unsigned old = xb_add(&bar[XB_XSUB(b.x)], 1u);
        const unsigned gen = old / nloc;
        if (old + 1u == (gen + 1u) * nloc) {
            __builtin_amdgcn_fence(__ATOMIC_RELEASE, "agent");
            asm volatile("s_waitcnt vmcnt(0)" ::: "memory");
            const unsigned og = xb_add(&bar[XB_TOP], 1u);
            const unsigned tg = og / nx;
            if (og + 1u == (tg + 1u) * nx) xb_add(&bar[XB_TOPGEN], 1u);
            else XB_SPIN(xb_ld(&bar[XB_TOPGEN]) == tg, bar);
            __builtin_amdgcn_fence(__ATOMIC_ACQUIRE, "agent");
            xb_add(&bar[XB_XGEN(b.x)], 1u);
            asm volatile("s_waitcnt vmcnt(0)" ::: "memory");
        } else {
            XB_SPIN(xb_ld(&bar[XB_XGEN(b.x)]) == gen, bar);
            __builtin_amdgcn_fence(__ATOMIC_ACQUIRE, "agent");
            asm volatile("s_waitcnt vmcnt(0)" ::: "memory");
        }
    }
    __syncthreads();
}

struct Frame {
    LAS unsigned char* lds;
    volatile LAS unsigned* MISC;
    gu32* ctl;
    int tid, lane, wave, vcu, G;
    unsigned char* ws;
};

__device__ __forceinline__ int dmap64(int s) { if (s >= 32) return s; const int nn = s >> 4, fq = (s >> 2) & 3, j = s & 3; return fq < 2 ? 8 * nn + 4 * fq + j : 16 + 8 * nn + 4 * (fq - 2) + j; }
__device__ __forceinline__ int src_col(int kind, int n) {
    if (kind == 0) return n;
    const int pn = n >> 8, p = n & 255;
    if (kind == 1) {
        if (pn < 12) return n;
        if (pn < 16) return 3072 + (pn - 12) * 256 + (p >> 6) * 64 + dmap64(p & 63);
        if (p < 64) return 4096 + dmap64(p);
        if (p < 80) return 4160 + (p - 64);
        return -1;
    }
    if (pn < 8) return n;
    const int i = pn - 8; return p < 128 ? 2048 + 128 * i + p : 4096 + 128 * i + (p - 128);
}
struct P0Desc { const float* src; const float* g; bf16* dst; int Nsrc, K; };
__device__ __forceinline__ void p0_desc(const float* W, const float* g, int K, int Nsrc, int Npad, int kind, bf16* WT, int item, int lane, P0Desc& d) {
    const int nblk = Npad / 32, kb = item / nblk, nb = item % nblk, kg = lane >> 3, ng = lane & 7, k0 = 64 * kb + 8 * kg, n0 = 32 * nb + 4 * ng;
    const int col = src_col(kind, n0);
    d.src = col >= 0 ? W + (size_t)k0 * Nsrc + col : nullptr; d.g = g ? g + k0 : nullptr; d.dst = WT + (size_t)n0 * K + k0; d.Nsrc = Nsrc; d.K = K;
}
__device__ __forceinline__ void p0_load(const P0Desc& d, f32x4 (&v)[8], f32x4& ga, f32x4& gb) {
#pragma unroll
    for (int i = 0; i < 8; ++i) v[i] = d.src ? __builtin_nontemporal_load((const f32x4*)(d.src + (size_t)i * d.Nsrc)) : (f32x4){0.f, 0.f, 0.f, 0.f};
    if (d.g) { ga = *(const f32x4*)d.g; gb = *(const f32x4*)(d.g + 4); } else { ga = (f32x4){1.f, 1.f, 1.f, 1.f}; gb = ga; }
}
__device__ __forceinline__ void p0_store(const P0Desc& d, const f32x4 (&v)[8], const f32x4& ga, const f32x4& gb) {
#pragma unroll
    for (int q = 0; q < 4; ++q) { v4u o; o.x = pk2(v[0][q] * ga[0], v[1][q] * ga[1]); o.y = pk2(v[2][q] * ga[2], v[3][q] * ga[3]); o.z = pk2(v[4][q] * gb[0], v[5][q] * gb[1]); o.w = pk2(v[6][q] * gb[2], v[7][q] * gb[3]);
        *(GAS v4u*)(d.dst + (size_t)q * d.K) = o; }
}
struct Inputs { const float* x; const int* pos; const float *attn_norm_g, *attn_w_in, *attn_q_g, *attn_k_g, *attn_w_out, *conv_norm_g, *conv_w_in, *conv_w, *conv_w_out, *mlp_norm_g, *mlp_w1, *mlp_w2; };
__device__ __forceinline__ void p0_item_desc(Frame& F, const Inputs& I, int it, P0Desc& d) {
    constexpr int I_A1 = (DM / 64) * (NA1 / 32), I_SQ = (DM / 64) * (DM / 32), I_C1 = (DM / 64) * (NC1 / 32), I_M1 = (DM / 64) * (DFF / 32), I_M2 = (DFF / 64) * (DM / 32);
    constexpr int PER_J = I_A1 + I_SQ + I_C1 + I_SQ, PER_I = I_M1 + I_M2;
    int r = it;
    if (r < 2 * PER_J) { const int j = r / PER_J; r -= j * PER_J;
        if (r < I_A1) { p0_desc(I.attn_w_in + (size_t)j * DM * NA1_SRC, I.attn_norm_g + j * DM, DM, NA1_SRC, NA1, 1, (bf16*)(F.ws + WS_WA1 + j * SZ_WA1), r, F.lane, d); return; } r -= I_A1;
        if (r < I_SQ) { p0_desc(I.attn_w_out + (size_t)j * DM * DM, nullptr, DM, DM, DM, 0, (bf16*)(F.ws + WS_WA4 + j * SZ_WSQ), r, F.lane, d); return; } r -= I_SQ;
        if (r < I_C1) { p0_desc(I.conv_w_in + (size_t)j * DM * NC1, I.conv_norm_g + j * DM, DM, NC1, NC1, 2, (bf16*)(F.ws + WS_WC1 + j * SZ_WC1), r, F.lane, d); return; } r -= I_C1;
        p0_desc(I.conv_w_out + (size_t)j * DM * DM, nullptr, DM, DM, DM, 0, (bf16*)(F.ws + WS_WC2 + j * SZ_WSQ), r, F.lane, d); return; }
    r -= 2 * PER_J; const int i = r / PER_I; r -= i * PER_I;
    if (r < I_M1) { p0_desc(I.mlp_w1 + (size_t)i * DM * DFF, I.mlp_norm_g + i * DM, DM, DFF, DFF, 0, (bf16*)(F.ws + WS_WM1 + i * SZ_WM), r, F.lane, d); return; } r -= I_M1;
    p0_desc(I.mlp_w2 + (size_t)i * DFF * DM, nullptr, DFF, DM, DM, 0, (bf16*)(F.ws + WS_WM2 + i * SZ_WM), r, F.lane, d);
}
__device__ __forceinline__ void p0_prologue(Frame& F, const Inputs& I, float* out) {
    const int gw = F.vcu * NWAVES + F.wave, NGW = F.G * NWAVES;
    constexpr int I_A1 = (DM / 64) * (NA1 / 32), I_SQ = (DM / 64) * (DM / 32), I_C1 = (DM / 64) * (NC1 / 32), I_M1 = (DM / 64) * (DFF / 32), I_M2 = (DFF / 64) * (DM / 32);
    constexpr int NITEMS = 2 * (I_A1 + I_SQ + I_C1 + I_SQ) + 4 * (I_M1 + I_M2);
    {
        f32x4 va[8], vb[8], gaa, gab, gba, gbb; P0Desc da, db;
        int it = gw; bool ha = it < NITEMS;
        if (ha) { p0_item_desc(F, I, it, da); p0_load(da, va, gaa, gab); }
        while (ha) {
            const int itn = it + NGW; const bool hb = itn < NITEMS;
            if (hb) { p0_item_desc(F, I, itn, db); p0_load(db, vb, gba, gbb); }
            p0_store(da, va, gaa, gab);
            it = itn; ha = hb; da = db; gaa = gba; gab = gbb;
#pragma unroll
            for (int i = 0; i < 8; ++i) va[i] = vb[i];
        }
    }
    bf16* xb = (bf16*)(F.ws + WS_XB); pg8::ssq_t* ssq0 = (pg8::ssq_t*)(F.ws + WS_SSQ);
    for (int m = gw; m < M; m += NGW) {
        const GAS f32x4* xr = (const GAS f32x4*)(I.x + (size_t)m * DM) + F.lane; GAS unsigned long long* o8 = (GAS unsigned long long*)(xb + (size_t)m * DM) + F.lane;
        float s = 0.f;
#pragma unroll
        for (int j = 0; j < 8; ++j) { const f32x4 v = xr[64 * j]; s += (v.x * v.x + v.y * v.y) + (v.z * v.z + v.w * v.w);
            o8[64 * j] = (unsigned long long)pk2(v.x, v.y) | ((unsigned long long)pk2(v.z, v.w) << 32); }
        s = wave_sum(s); if (F.lane == 0) ssq0[m] = pg8::ssq_fix(s);
    }
    float* ropeM = (float*)(F.ws + WS_ROPEM); float* ropeI = (float*)(F.ws + WS_ROPEI);
    for (int e = F.vcu * 512 + F.tid; e < M * 24; e += F.G * 512) {
        const int row = e / 24, d = e % 24; const float p = (float)I.pos[row];
        const float ex = d < 16 ? -(float)d * (1.0f / 16.0f) : -(float)(d - 16) * (1.0f / 8.0f);
        const float inv = __builtin_amdgcn_exp2f(ex * 18.931568569324174f);
        const float ang = p * inv;
        double rev = (double)ang * 0.15915494309189535; rev -= __builtin_floor(rev); const float rf = (float)rev;
        const float c = __builtin_amdgcn_cosf(rf), s = __builtin_amdgcn_sinf(rf);
        if (d < 16) { ropeM[(size_t)row * 32 + d] = c; ropeM[(size_t)row * 32 + 16 + d] = s; } else { ropeI[(size_t)row * 16 + (d - 16)] = c; ropeI[(size_t)row * 16 + 8 + (d - 16)] = s; }
    }
    (void)out;
}

struct IdxTensors { const bf16* QI; const bf16* KI; const float* WI; unsigned long long* MASK; float* dbg; };
#define DBG_OUT T.dbg
__device__ __forceinline__ void idx_phase(Frame& F, const IdxTensors& T) {
    typedef float f32x2 __attribute__((ext_vector_type(2)));
    LAS float* scores = (LAS float*)(F.lds + RING_OFF);
    LAS unsigned* hist = (LAS unsigned*)(F.lds + AUX_OFF) + F.wave * 512;
    LAS float* cand = (LAS float*)(F.lds + AUX_OFF + 16384) + F.wave * 64;
    const int lane = F.lane, w = F.wave, c32 = lane & 31, hi = lane >> 5;
    for (int uu = blockIdx.x; uu < 2048; uu += F.G) {
        const int idx = uu & 255, rr = uu >> 8, b = rr >> 1, tb = (rr & 1) ? 511 - idx : idx, t0 = tb * 8;
        {
            const int qsel = (c32 >> 2) & 1, hh = (c32 & 3) + 4 * (c32 >> 3);
            const bf16* qrow = T.QI + ((size_t)(b * SEQ + t0 + qsel) * 16 + hh) * 64 + 8 * hi;
            bf16x8 afr[4][4];
#pragma unroll
            for (int p = 0; p < 4; ++p)
#pragma unroll
                for (int kk = 0; kk < 4; ++kk) afr[p][kk] = *(const bf16x8*)(qrow + (size_t)p * 2 * 1024 + 16 * kk);
            const float* wrow = T.WI + (size_t)(b * SEQ + t0 + hi) * 16;
            f32x2 wq[4][8];
#pragma unroll
            for (int p = 0; p < 4; ++p)
#pragma unroll
                for (int i = 0; i < 4; ++i) { const f32x4 t4 = *(const f32x4*)(wrow + p * 32 + 4 * i); wq[p][2 * i] = (f32x2){t4[0], t4[1]}; wq[p][2 * i + 1] = (f32x2){t4[2], t4[3]}; }
            const int ntile = (t0 + 7) / 32 + 1;
            const bf16* kbase = T.KI + (size_t)b * SEQ * 64 + (size_t)c32 * 64 + 8 * hi;
            LAS float* srow = scores + hi * 4096 + c32;
            bf16x8 bcur[4], bnxt[4];
            if (w < ntile) {
#pragma unroll
                for (int kk = 0; kk < 4; ++kk) bcur[kk] = *(const bf16x8*)(kbase + (size_t)w * 32 * 64 + 16 * kk);
            }
            for (int jt = w; jt < ntile; jt += 8) {
                const int jn = jt + 8 < ntile ? jt + 8 : jt;
#pragma unroll
                for (int kk = 0; kk < 4; ++kk) bnxt[kk] = *(const bf16x8*)(kbase + (size_t)jn * 32 * 64 + 16 * kk);
#pragma unroll
                for (int p = 0; p < 4; ++p) {
                    f32x16 acc = {};
#pragma unroll
                    for (int kk = 0; kk < 4; ++kk) acc = __builtin_amdgcn_mfma_f32_32x32x16_bf16(afr[p][kk], bcur[kk], acc, 0, 0, 0);
                    f32x2 s2 = {0.f, 0.f};
#pragma unroll
                    for (int r = 0; r < 8; ++r) { f32x2 a2 = {fmaxf(acc[2 * r], 0.f), fmaxf(acc[2 * r + 1], 0.f)}; s2 = __builtin_elementwise_fma(wq[p][r], a2, s2); }
                    srow[p * 2 * 4096 + jt * 32] = s2[0] + s2[1];
                }
#pragma unroll
                for (int kk = 0; kk < 4; ++kk) bcur[kk] = bnxt[kk];
            }
        }
        LDS_WAIT(); __syncthreads();
        {
            const int t = t0 + w, n = t + 1;
            const LAS float* sc = scores + w * 4096;
            const float INF = __builtin_inff();
#if defined(DBG_DUMP2)
            for (int i = lane; i < 2048; i += 64) DBG_OUT[(size_t)(b * SEQ + t) * 2048 + i] = (i + DBG_DUMP2 < n) ? sc[i + DBG_DUMP2] : 0.f;
#endif
            float tau = -INF;
            const int nch = (n + 63) >> 6;
            if (n > TOPK) {
                float lo = INF, hv = -INF;
#pragma unroll 4
                for (int j = 0; j < nch; ++j) { const int i = 64 * j + lane; const float v = sc[i]; if (i < n) { lo = fminf(lo, v); hv = fmaxf(hv, v); } }
                lo = wave_min(lo); hv = wave_max(hv);
                int need = TOPK; bool done = false;
                for (int level = 0; level < 6 && !done; ++level) {
                    if (!(hv > lo)) { tau = lo; done = true; break; }
                    const float scale = fminf(512.0f / (hv - lo), 3.0e37f);
#pragma unroll
                    for (int k = 0; k < 8; ++k) hist[k * 64 + lane] = 0u;
                    LDS_WAIT();
#pragma unroll 4
                    for (int j = 0; j < nch; ++j) { const int i = 64 * j + lane; const float v = sc[i];
                        if (i < n && v >= lo && v <= hv) { int bin = (int)((v - lo) * scale); bin = bin > 511 ? 511 : bin; __hip_atomic_fetch_add(hist + bin, 1u, __ATOMIC_RELAXED, __HIP_MEMORY_SCOPE_WORKGROUP); } }
                    LDS_WAIT();
                    unsigned h[8]; unsigned ssum = 0;
                    { const v4u a = *(const LAS v4u*)(hist + 8 * lane), bq = *(const LAS v4u*)(hist + 8 * lane + 4); h[0] = a.x; h[1] = a.y; h[2] = a.z; h[3] = a.w; h[4] = bq.x; h[5] = bq.y; h[6] = bq.z; h[7] = bq.w; }
#pragma unroll
                    for (int k = 0; k < 8; ++k) ssum += h[k];
                    unsigned S = ssum;
#pragma unroll
                    for (int o = 1; o < 64; o <<= 1) { const unsigned tt = __shfl_down(S, o); if (lane + o < 64) S += tt; }
                    const unsigned long long bal = __ballot(S >= (unsigned)need);
                    const int L = __popcll(bal) - 1;
                    const int Lc = L < 0 ? 0 : L;
                    unsigned cum = (Lc < 63) ? (unsigned)__shfl(S, Lc + 1) : 0u; if (Lc >= 63) cum = 0u;
                    int bstar = 8 * Lc; unsigned cstar = 0, abv = cum; bool found = false;
#pragma unroll
                    for (int k = 7; k >= 0; --k) { const unsigned hk = (unsigned)__shfl(h[k], Lc);
                        if (!found && cum + hk >= (unsigned)need) { bstar = 8 * Lc + k; cstar = hk; abv = cum; found = true; }
                        cum += hk; }
                    need -= (int)abv;
                    float nlo = INF, nhv = -INF; int base = 0; const bool few = cstar <= 64u;
#pragma unroll 4
                    for (int j = 0; j < nch; ++j) { const int i = 64 * j + lane; bool inb = false; const float v = sc[i];
                        if (i < n && v >= lo && v <= hv) { int bin = (int)((v - lo) * scale); bin = bin > 511 ? 511 : bin; inb = bin == bstar; }
                        if (inb) { nlo = fminf(nlo, v); nhv = fmaxf(nhv, v); }
                        if (few) { const unsigned long long mk = __ballot(inb);
                            if (inb) { const int pos = base + __popcll(mk & ((1ull << lane) - 1ull)); if (pos < 64) cand[pos] = v; }
                            base += __popcll(mk); } }
                    lo = wave_min(nlo); hv = wave_max(nhv);
                    if (few) {
                        LDS_WAIT();
                        const int nc = base < 64 ? base : 64;
                        const float myv = lane < nc ? cand[lane] : -INF; int cnt = 0;
                        for (int i = 0; i < nc; ++i) cnt += (cand[i] > myv) ? 1 : 0;
                        const bool sel = lane < nc && cnt < need;
                        tau = wave_min(sel ? myv : INF); done = true;
                    }
                }
                if (!done) tau = lo;
            }
            unsigned long long myword = 0ull;
#pragma unroll 4
            for (int j = 0; j < nch; ++j) { const int i = 64 * j + lane; const float v = sc[i];
#if defined(DBG_TRIV_MASK)
            const bool bit = (i < n);
#elif defined(DBG_SCORE_MASK)
            const bool bit = (i < n) && ((v > 0.f) || i == t);
#else
            const bool bit = (i < n) && (v >= tau);
#endif
                const unsigned long long mk = __ballot(bit); if (lane == j) myword = mk; }
            const int nwords = ((t | 255) + 1) >> 6;
            if (lane < nwords) T.MASK[((size_t)b * 64 + lane) * SEQ + t] = myword;
        }
        LDS_WAIT(); __syncthreads();
    }
}

__device__ __forceinline__ void conv_phase(Frame& F, const bf16* Bg, const bf16* Z, const float* cw, bf16* Gout) {
    const int nunit = (M / 32) * 4;
    for (int uu = (blockIdx.x * NWAVES + F.wave); uu < nunit; uu += F.G * NWAVES) {
        const int run = uu >> 2, cb = (uu & 3) * 512 + F.lane * 8, r0 = run * 32;
        float w0[8], w1[8], w2[8];
#pragma unroll
        for (int j = 0; j < 8; ++j) { w0[j] = cw[cb + j]; w1[j] = cw[DM + cb + j]; w2[j] = cw[2 * DM + cb + j]; }
        float zm2[8], zm1[8];
        const bool first = (r0 % SEQ) == 0;
        { v4u a = {0, 0, 0, 0}, bq = {0, 0, 0, 0};
          if (!first) { a = *(const v4u*)(Z + (size_t)(r0 - 2) * DM + cb); bq = *(const v4u*)(Z + (size_t)(r0 - 1) * DM + cb); }
          const unsigned aw[4] = {a.x, a.y, a.z, a.w}, bw[4] = {bq.x, bq.y, bq.z, bq.w};
#pragma unroll
          for (int j = 0; j < 4; ++j) { zm2[2 * j] = __uint_as_float(aw[j] << 16); zm2[2 * j + 1] = __uint_as_float(aw[j] & 0xffff0000u); zm1[2 * j] = __uint_as_float(bw[j] << 16); zm1[2 * j + 1] = __uint_as_float(bw[j] & 0xffff0000u); } }
#pragma unroll 4
        for (int r = 0; r < 32; ++r) {
            const v4u zz = *(const v4u*)(Z + (size_t)(r0 + r) * DM + cb), bb = *(const v4u*)(Bg + (size_t)(r0 + r) * DM + cb);
            const unsigned zw[4] = {zz.x, zz.y, zz.z, zz.w}, bw[4] = {bb.x, bb.y, bb.z, bb.w};
            float z0[8], o[8];
#pragma unroll
            for (int j = 0; j < 4; ++j) { z0[2 * j] = __uint_as_float(zw[j] << 16); z0[2 * j + 1] = __uint_as_float(zw[j] & 0xffff0000u); }
#pragma unroll
            for (int j = 0; j < 8; ++j) { const float bv = (j & 1) ? __uint_as_float(bw[j >> 1] & 0xffff0000u) : __uint_as_float(bw[j >> 1] << 16);
                o[j] = bv * (w0[j] * zm2[j] + w1[j] * zm1[j] + w2[j] * z0[j]); zm2[j] = zm1[j]; zm1[j] = z0[j]; }
            v4u ov; ov.x = pk2(o[0], o[1]); ov.y = pk2(o[2], o[3]); ov.z = pk2(o[4], o[5]); ov.w = pk2(o[6], o[7]);
            *(v4u*)(Gout + (size_t)(r0 + r) * DM + cb) = ov;
        }
    }
}

#ifndef PH_P0
#define PH_P0 1
#endif
#ifndef PH_A1
#define PH_A1 1
#endif
#ifndef PH_A2
#define PH_A2 1
#endif
#ifndef PH_A3
#define PH_A3 1
#endif
#ifndef PH_A4
#define PH_A4 1
#endif
#ifndef PH_C1
#define PH_C1 1
#endif
#ifndef PH_C1B
#define PH_C1B 1
#endif
#ifndef PH_C2
#define PH_C2 1
#endif
#ifndef PH_M1
#define PH_M1 1
#endif
#ifndef PH_M2
#define PH_M2 1
#endif
struct Args { Inputs in; float* out; unsigned char* ws; int ph_lo, ph_hi; };
#ifndef DBG_REP_LAYER
#define DBG_REP_LAYER -1
#endif
#ifndef DBG_REP_P0
#define DBG_REP_P0 0
#endif
#ifndef DBG_REP_A1
#define DBG_REP_A1 0
#endif
#ifndef DBG_REP_A2
#define DBG_REP_A2 0
#endif
#ifndef DBG_REP_A3
#define DBG_REP_A3 0
#endif
#ifndef DBG_REP_A4
#define DBG_REP_A4 0
#endif
#ifndef DBG_REP_C1
#define DBG_REP_C1 0
#endif
#ifndef DBG_REP_C1B
#define DBG_REP_C1B 0
#endif
#ifndef DBG_REP_C2
#define DBG_REP_C2 0
#endif
#ifndef DBG_REP_M1
#define DBG_REP_M1 0
#endif
#ifndef DBG_REP_M2
#define DBG_REP_M2 0
#endif
constexpr size_t WS_DUMMY_OUT = WS_END, WS_DUMMY_XB = WS_END + 128 * MiB, WS_DUMMY_SSQ = WS_END + 192 * MiB;
#define REPEAT(n) _Pragma("unroll") for (int rep = 0, nrep = ((li == DBG_REP_LAYER) ? 1 + (n) : 1); rep < nrep; ++rep)
#define REPBAR do { if (rep) { if (!MK_PER_PHASE) xcd_barrier(bar); } } while (0)
#define IN(k) (lo <= (k) && (k) < hi)
#define SEAM(k) do { if (IN(k) && IN((k) + 1)) { if (!MK_PER_PHASE) xcd_barrier(bar); } } while (0)
template <int li> __device__ __forceinline__ void layer_body(Frame& F, const Args& args, const XcdBarrier& bar, const int lo, const int hi, unsigned char* lds) {
    const Inputs& I = args.in; unsigned char* ws = args.ws;
    bf16* const XB = (bf16*)(ws + WS_XB); pg8::ssq_t* const SSQ = (pg8::ssq_t*)(ws + WS_SSQ);
    const float* const ropeM = (const float*)(ws + WS_ROPEM); const float* const ropeI = (const float*)(ws + WS_ROPEI);

        const int j = li >> 1, pb = 1 + 6 * li;
        if ((li & 1) == 0) {
            if (PH_A1 && IN(pb + 0)) REPEAT(DBG_REP_A1) { REPBAR;
                pg8::Gemm g{XB, (const bf16*)(ws + WS_WA1 + j * SZ_WA1), M, NA1, DM}; pg8::StaticOrder S; S.init(M, NA1, F.G, (int)blockIdx.x);
                pg8::EpiA1 E{SSQ + (size_t)(2 * li) * M, (bf16*)(ws + WS_Q), (bf16*)(ws + WS_K), (bf16*)(ws + WS_V), (bf16*)(ws + WS_QI), (bf16*)(ws + WS_KI), (float*)(ws + WS_WI),
                             I.attn_q_g + j * 128, I.attn_k_g + j * 128, ropeM, ropeI, (PG8_LAS float*)(F.lds + AUX_OFF)};
                pg8::gemm_phase<pg8::EpiA1, pg8::StaticOrder, true, true>(F.lds + RING_OFF, g, S, E);
            } SEAM(pb + 0);
            if (PH_A2 && IN(pb + 1)) REPEAT(DBG_REP_A2) { REPBAR; IdxTensors T{(const bf16*)(ws + WS_QI), (const bf16*)(ws + WS_KI), (const float*)(ws + WS_WI), (unsigned long long*)(ws + WS_MASK), args.out};
#if defined(DBG_DUMP)
                for (size_t e = (size_t)blockIdx.x * 512 + F.tid; e < (size_t)M * DM; e += (size_t)F.G * 512) { const int row = (int)(e / DM), c = (int)(e % DM); float v = 0.f;
                    if (c < 1024) v = bf2f(T.QI[(size_t)row * 1024 + c]); else if (c < 1088) v = bf2f(T.KI[(size_t)row * 64 + c - 1024]); else if (c < 1104) v = T.WI[(size_t)row * 16 + c - 1088];
                    args.out[e] = v; }
#else
                idx_phase(F, T);
#endif
                } SEAM(pb + 1);
            if (PH_A3 && IN(pb + 2)) REPEAT(DBG_REP_A3) { REPBAR; const att::Tensors T{(const att::bf16*)(ws + WS_Q), (const att::bf16*)(ws + WS_K), (const att::bf16*)(ws + WS_V), (att::bf16*)(ws + WS_O), (const att::u64*)(ws + WS_MASK)};
                att::attn_phase((char*)lds + RING_OFF, T, (int)blockIdx.x, F.G); } SEAM(pb + 2);
            if (PH_A4 && IN(pb + 3)) REPEAT(DBG_REP_A4) { REPBAR; const bool dummy = rep + 1 < nrep;
                pg8::Gemm g{(const bf16*)(ws + DBG_A4_SRC), (const bf16*)(ws + WS_WA4 + j * SZ_WSQ), M, DM, DM}; pg8::StaticOrder S; S.init(M, DM, F.G, (int)blockIdx.x);
                pg8::EpiRes<false> E{XB, dummy ? (bf16*)(ws + WS_DUMMY_XB) : XB, nullptr, dummy ? (pg8::ssq_t*)(ws + WS_DUMMY_SSQ) : SSQ + (size_t)(2 * li + 1) * M};
                pg8::gemm_phase<pg8::EpiRes<false>, pg8::StaticOrder, true, true>(F.lds + RING_OFF, g, S, E);
            } SEAM(pb + 3);
        } else {
            if (PH_C1 && IN(pb + 0)) REPEAT(DBG_REP_C1) { REPBAR;
                pg8::Gemm g{XB, (const bf16*)(ws + WS_WC1 + j * SZ_WC1), M, NC1, DM}; pg8::StaticOrder S; S.init(M, NC1, F.G, (int)blockIdx.x);
                pg8::EpiC1 E{(bf16*)(ws + WS_BG), (bf16*)(ws + WS_Z), SSQ + (size_t)(2 * li) * M};
                pg8::gemm_phase<pg8::EpiC1, pg8::StaticOrder, true, true>(F.lds + RING_OFF, g, S, E);
            } SEAM(pb + 0);
            if (PH_C1B && IN(pb + 1)) REPEAT(DBG_REP_C1B) { REPBAR; conv_phase(F, (const bf16*)(ws + WS_BG), (const bf16*)(ws + WS_Z), I.conv_w + (size_t)j * 3 * DM, (bf16*)(ws + WS_G)); } SEAM(pb + 1);
            if (PH_C2 && IN(pb + 2)) REPEAT(DBG_REP_C2) { REPBAR; const bool dummy = rep + 1 < nrep;
                pg8::Gemm g{(const bf16*)(ws + WS_G), (const bf16*)(ws + WS_WC2 + j * SZ_WSQ), M, DM, DM}; pg8::StaticOrder S; S.init(M, DM, F.G, (int)blockIdx.x);
                pg8::EpiRes<false> E{XB, dummy ? (bf16*)(ws + WS_DUMMY_XB) : XB, nullptr, dummy ? (pg8::ssq_t*)(ws + WS_DUMMY_SSQ) : SSQ + (size_t)(2 * li + 1) * M};
                pg8::gemm_phase<pg8::EpiRes<false>, pg8::StaticOrder, true, true>(F.lds + RING_OFF, g, S, E);
            } SEAM(pb + 2);
            SEAM(pb + 3);
        }
        if (PH_M1 && IN(pb + 4)) REPEAT(DBG_REP_M1) { REPBAR;
            pg8::Gemm g{XB, (const bf16*)(ws + WS_WM1 + li * SZ_WM), M, DFF, DM}; pg8::StaticOrder S; S.init(M, DFF, F.G, (int)blockIdx.x);
            pg8::EpiM1 E{(bf16*)(ws + WS_H), SSQ + (size_t)(2 * li + 1) * M};
            pg8::gemm_phase<pg8::EpiM1, pg8::StaticOrder, true, true>(F.lds + RING_OFF, g, S, E);
        } SEAM(pb + 4);
        if (PH_M2 && IN(pb + 5)) REPEAT(DBG_REP_M2) { REPBAR; const bool dummy = rep + 1 < nrep;
            pg8::Gemm g{(const bf16*)(ws + WS_H), (const bf16*)(ws + WS_WM2 + li * SZ_WM), M, DM, DFF}; pg8::StaticOrder S; S.init(M, DM, F.G, (int)blockIdx.x);
            pg8::EpiRes<li == DEPTH - 1> E{XB, dummy ? (bf16*)(ws + WS_DUMMY_XB) : XB, dummy ? (float*)(ws + WS_DUMMY_OUT) : args.out, dummy ? (pg8::ssq_t*)(ws + WS_DUMMY_SSQ) : SSQ + (size_t)(2 * li + 2) * M};
            pg8::gemm_phase<pg8::EpiRes<li == DEPTH - 1>, pg8::StaticOrder, true, true>(F.lds + RING_OFF, g, S, E);
        } SEAM(pb + 5);
    }
#undef IN
#undef SEAM
__global__ void __launch_bounds__(NWAVES * 64, 2) trunk_fwd(Args args) {
    extern __shared__ __attribute__((aligned(16))) unsigned char lds[];
    Frame F;
    F.lds = (LAS unsigned char*)lds;
    F.MISC = (volatile LAS unsigned*)(F.lds + MISC_OFF);
    F.tid = threadIdx.x; F.lane = F.tid & 63; F.wave = __builtin_amdgcn_readfirstlane(F.tid >> 6);
    F.G = gridDim.x; { const int bx = blockIdx.x; F.vcu = (F.G % 8 == 0) ? (bx % 8) * (F.G / 8) + bx / 8 : bx; }
    F.ws = args.ws; F.ctl = (gu32*)(args.ws + WS_CTL);
    for (int u = F.tid; u < 64; u += NWAVES * 64) ((LAS unsigned*)(F.lds + MISC_OFF))[u] = 0u;
    __syncthreads();
    XcdBarrier bar; bar.bar = (unsigned*)(F.ctl + CW_BAR); bar.x = 0; bar.st = nullptr;
    if (!MK_PER_PHASE) bar = xcd_barrier_post((unsigned*)(F.ctl + CW_BAR), F.MISC + 8);
    const int lo = args.ph_lo, hi = args.ph_hi;
    const Inputs& I = args.in;
    unsigned char* ws = args.ws;
#define IN(k) (lo <= (k) && (k) < hi)
#define SEAM(k) do { if (IN(k) && IN((k) + 1)) { if (!MK_PER_PHASE) xcd_barrier(bar); } } while (0)
    bf16* const XB = (bf16*)(ws + WS_XB);
    pg8::ssq_t* const SSQ = (pg8::ssq_t*)(ws + WS_SSQ);
    const float* const ropeM = (const float*)(ws + WS_ROPEM); const float* const ropeI = (const float*)(ws + WS_ROPEI);

    if (PH_P0 && IN(0)) { for (int rep = 0; rep < 1 + DBG_REP_P0; ++rep) { if (rep) xcd_barrier(bar); p0_prologue(F, I, args.out); } } SEAM(0);

    layer_body<0>(F, args, bar, lo, hi, lds); layer_body<1>(F, args, bar, lo, hi, lds); layer_body<2>(F, args, bar, lo, hi, lds); layer_body<3>(F, args, bar, lo, hi, lds);
#undef IN
#undef SEAM
}

#ifndef DBG_NPH
#define DBG_NPH (1 + 6 * DEPTH)
#endif
constexpr int N_PHASES = DBG_NPH;
extern "C" void kernel_launch(void* const* d_in, const int* in_sizes, int n_in, void* d_out, int out_size, void* d_ws, size_t ws_size, hipStream_t stream) {
    static int grid = 0;
    if (grid == 0) {
        if (n_in != 14 || in_sizes[0] != M * DM || out_size != M * DM || ws_size < WS_END + 200 * MiB) { fprintf(stderr, "kernel_launch: shape/workspace mismatch (n_in %d, in0 %d, out %d, ws %zu, need %zu)\n", n_in, n_in > 0 ? in_sizes[0] : -1, out_size, ws_size, (size_t)WS_END); grid = -1; return; }
        int dev = 0, cus = 0, per_cu = 0;
        if (hipGetDevice(&dev) != hipSuccess || hipDeviceGetAttribute(&cus, hipDeviceAttributeMultiprocessorCount, dev) != hipSuccess) { grid = -1; return; }
        if (hipFuncSetAttribute((const void*)trunk_fwd, hipFuncAttributeMaxDynamicSharedMemorySize, LDS_BYTES) != hipSuccess) { fprintf(stderr, "kernel_launch: hipFuncSetAttribute failed\n"); grid = -1; return; }
        if (hipOccupancyMaxActiveBlocksPerMultiprocessor(&per_cu, (const void*)trunk_fwd, NWAVES * 64, LDS_BYTES) != hipSuccess || per_cu < 1) fprintf(stderr, "kernel_launch: occupancy query reports %d\n", per_cu);
        (void)hipGetLastError();
        grid = cus;
    }
    if (grid < 0) return;
    if (hipMemsetAsync((char*)d_ws + WS_CTL, 0, CTL_ZERO_BYTES, stream) != hipSuccess) { fprintf(stderr, "kernel_launch: memset failed\n"); return; }
    Args a{};
    a.in.x = (const float*)d_in[0]; a.in.pos = (const int*)d_in[1]; a.in.attn_norm_g = (const float*)d_in[2]; a.in.attn_w_in = (const float*)d_in[3]; a.in.attn_q_g = (const float*)d_in[4];
    a.in.attn_k_g = (const float*)d_in[5]; a.in.attn_w_out = (const float*)d_in[6]; a.in.conv_norm_g = (const float*)d_in[7]; a.in.conv_w_in = (const float*)d_in[8]; a.in.conv_w = (const float*)d_in[9];
    a.in.conv_w_out = (const float*)d_in[10]; a.in.mlp_norm_g = (const float*)d_in[11]; a.in.mlp_w1 = (const float*)d_in[12]; a.in.mlp_w2 = (const float*)d_in[13];
    a.out = (float*)d_out; a.ws = (unsigned char*)d_ws;
#if MK_PER_PHASE
    for (int ph = 0; ph < N_PHASES; ++ph) {
        const int li = (ph - 1) / 6, k = (ph - 1) % 6;
        if (ph > 0 && (li & 1) == 1 && k == 3) continue;
        a.ph_lo = ph; a.ph_hi = ph + 1;
        hipLaunchKernelGGL(trunk_fwd, dim3(grid), dim3(NWAVES * 64), LDS_BYTES, stream, a);
    }
#else
    a.ph_lo = 0; a.ph_hi = N_PHASES;
    hipLaunchKernelGGL(trunk_fwd, dim3(grid), dim3(NWAVES * 64), LDS_BYTES, stream, a);
#endif
    const hipError_t le = hipPeekAtLastError();
    if (le != hipSuccess) fprintf(stderr, "kernel_launch: launch failed: %s\n", hipGetErrorName(le));
}
```

```cpp
#define MK_PER_PHASE 0
#include <hip/hip_runtime.h>
#include <cstdio>
#include <cstdint>
#ifndef PG8_WGM
#define PG8_WGM 4
#endif
namespace pg8 {
#define PG8_LAS __attribute__((address_space(3)))
typedef unsigned short bf16_t;
typedef short bf16x8 __attribute__((ext_vector_type(8)));
typedef float f32x4 __attribute__((ext_vector_type(4)));
typedef unsigned u32x4 __attribute__((ext_vector_type(4)));
constexpr int BM = 256, BK = 64, HALF = 128, HTB = HALF * BK * 2  , STAGE_BYTES = 8 * HTB, NXCD = 8, WGM = PG8_WGM;

__host__ __device__ __forceinline__ int lds_byte(int r, int c) { const int st = (r >> 4) * 2 + (c >> 5), rr = r & 15, cc = c & 31, ob = rr * 64 + cc * 2; return st * 1024 + (ob ^ (((ob >> 9) & 1) << 5)); }
__host__ __device__ __forceinline__ void stage_rc(int b, int& R, int& C) { const int st = b / 1024, sb = b % 1024, swz = sb ^ (((sb >> 9) & 1) << 5); R = (st >> 1) * 16 + swz / 64; C = (st & 1) * 32 + (swz % 64) / 2; }
__host__ __device__ __forceinline__ int perm32(int rho) { const int n = rho >> 4, i = rho & 15; return 8 * (i >> 2) + 4 * n + (i & 3); }

typedef int v8i_t __attribute__((ext_vector_type(8)));
typedef int v4i_t __attribute__((ext_vector_type(4)));
__device__ __forceinline__ v8i_t cat8(bf16x8 a, bf16x8 b) { const v4i_t x = __builtin_bit_cast(v4i_t, a), y = __builtin_bit_cast(v4i_t, b); return __builtin_shufflevector(x, y, 0, 1, 2, 3, 4, 5, 6, 7); }
struct Unit { int pm, pn; };
struct Gemm { const bf16_t* A; const bf16_t* Bt; int M, N, K; };

struct StaticOrder {
    int nM, nN, nwg, G, c;
    __host__ __device__ void init(int M, int N, int G_, int c_) { nM = M / BM; nN = N / BM; nwg = nM * nN; G = G_; c = c_; }
    __host__ __device__ bool next(int i, Unit& u) const {
        const long L = (long)i * G + c; if (L >= nwg) return false;
        int wgid = (int)L; { const int q = nwg / NXCD, r = nwg % NXCD, xcd = wgid % NXCD, off = wgid / NXCD; wgid = (xcd < r ? xcd * (q + 1) : r * (q + 1) + (xcd - r) * q) + off; }
        const int nig = WGM * nN, gid = wgid / nig, fm = gid * WGM, gsz = (nM - fm) < WGM ? (nM - fm) : WGM;
        u.pm = fm + ((wgid % nig) % gsz); u.pn = (wgid % nig) / gsz; return true;
    }
    __device__ __forceinline__ void a_ready(const Unit&) const {}
    __device__ __forceinline__ void done(const Unit&) const {}
};
__device__ __forceinline__ unsigned cvt_pk_bf16(float lo, float hi) { unsigned r; asm volatile("v_cvt_pk_bf16_f32 %0, %1, %2" : "=v"(r) : "v"(lo), "v"(hi)); return r; }
typedef unsigned u32x2 __attribute__((ext_vector_type(2)));
constexpr float RMS_EPS = 1e-6f;
typedef unsigned long long ssq_t;
__device__ __forceinline__ float rstd_of(ssq_t ssq) { return __builtin_amdgcn_rsqf((float)ssq * (1.0f / (2048.0f * 1048576.0f)) + RMS_EPS); }
__device__ __forceinline__ ssq_t ssq_fix(float s) { return (ssq_t)(s * 1048576.0f + 0.5f); }

constexpr float FP8_SX = 2.0f, FP8_SWI = 1024.0f;
template <bool FINAL, bool XB8 = false> struct EpiRes {
    static constexpr bool PERM = true, AFTER_DRAIN = false;
    const bf16_t* base; bf16_t* xb; float* out; ssq_t* ssq; float scale; unsigned char* xb8;
    __device__ __forceinline__ void operator()(const f32x4 (&acc)[2][2][4][2], const Unit& u, int wr, int wc, int fr, int fq) const {
        const int row0 = u.pm * BM + wr * 64 + fr, col0 = u.pn * BM + wc * 32 + 8 * fq;
        u32x4 bw[2][4][2];
#pragma unroll
        for (int ai = 0; ai < 2; ++ai)
#pragma unroll
            for (int m = 0; m < 4; ++m)
#pragma unroll
                for (int bj = 0; bj < 2; ++bj) bw[ai][m][bj] = *(const u32x4*)(base + (size_t)(row0 + ai * HALF + m * 16) * 2048 + col0 + bj * HALF);
        asm volatile("" ::: "memory");
#pragma unroll
        for (int ai = 0; ai < 2; ++ai)
#pragma unroll
            for (int m = 0; m < 4; ++m) {
                const int row = row0 + ai * HALF + m * 16; const size_t off = (size_t)row * 2048 + col0; float s = 0.f;
#pragma unroll
                for (int bj = 0; bj < 2; ++bj) {
                    const u32x4 b = bw[ai][m][bj];
                    const f32x4 b0 = {__uint_as_float(b.x << 16), __uint_as_float(b.x & 0xffff0000u), __uint_as_float(b.y << 16), __uint_as_float(b.y & 0xffff0000u)};
                    const f32x4 b1 = {__uint_as_float(b.z << 16), __uint_as_float(b.z & 0xffff0000u), __uint_as_float(b.w << 16), __uint_as_float(b.w & 0xffff0000u)};
                    const f32x4 o0 = b0 + acc[ai][bj][m][0] * scale, o1 = b1 + acc[ai][bj][m][1] * scale;
                    if (FINAL) { *(f32x4*)(out + off + bj * HALF) = o0; *(f32x4*)(out + off + bj * HALF + 4) = o1; }
                    else {
                        s += ((o0[0] * o0[0] + o0[1] * o0[1]) + (o0[2] * o0[2] + o0[3] * o0[3])) + ((o1[0] * o1[0] + o1[1] * o1[1]) + (o1[2] * o1[2] + o1[3] * o1[3]));
                        u32x4 w; w.x = cvt_pk_bf16(o0[0], o0[1]); w.y = cvt_pk_bf16(o0[2], o0[3]); w.z = cvt_pk_bf16(o1[0], o1[1]); w.w = cvt_pk_bf16(o1[2], o1[3]);
                        *(u32x4*)(xb + off + bj * HALF) = w;
                        if (XB8) { f32x4 e0 = o0 * FP8_SX, e1 = o1 * FP8_SX;
#pragma unroll
                            for (int j = 0; j < 4; ++j) { e0[j] = fminf(fmaxf(e0[j], -448.f), 448.f); e1[j] = fminf(fmaxf(e1[j], -448.f), 448.f); }
                            int w0 = 0, w1 = 0; w0 = __builtin_amdgcn_cvt_pk_fp8_f32(e0[0], e0[1], w0, false); w0 = __builtin_amdgcn_cvt_pk_fp8_f32(e0[2], e0[3], w0, true);
                            w1 = __builtin_amdgcn_cvt_pk_fp8_f32(e1[0], e1[1], w1, false); w1 = __builtin_amdgcn_cvt_pk_fp8_f32(e1[2], e1[3], w1, true);
                            u32x2 w8; w8.x = (unsigned)w0; w8.y = (unsigned)w1; *(u32x2*)(xb8 + off + bj * HALF) = w8; } }
                }
                if (!FINAL) { s += __shfl_xor(s, 16); s += __shfl_xor(s, 32);
                    if (fq == 0) __hip_atomic_fetch_add(ssq + row, ssq_fix(s), __ATOMIC_RELAXED, __HIP_MEMORY_SCOPE_AGENT); }
            }
    }
};

constexpr float FP8_SG = 16.0f, FP8_SWC = 1024.0f;
constexpr float FP8_SA = 8.0f, FP8_SW = 2048.0f;
template <bool FP8OUT> struct EpiM1 {
    static constexpr bool PERM = true, AFTER_DRAIN = false;
    bf16_t* H; const ssq_t* ssq; float iscale;
    __device__ __forceinline__ void operator()(const f32x4 (&acc)[2][2][4][2], const Unit& u, int wr, int wc, int fr, int fq) const {
        const int row0 = u.pm * BM + wr * 64 + fr, col0 = u.pn * BM + wc * 32 + 8 * fq;
        ssq_t sq[2][4];
#pragma unroll
        for (int ai = 0; ai < 2; ++ai)
#pragma unroll
            for (int m = 0; m < 4; ++m) sq[ai][m] = ssq[row0 + ai * HALF + m * 16];
        asm volatile("" ::: "memory");
#pragma unroll
        for (int ai = 0; ai < 2; ++ai)
#pragma unroll
            for (int m = 0; m < 4; ++m) {
                const int row = row0 + ai * HALF + m * 16; const float r = rstd_of(sq[ai][m]) * iscale;
#pragma unroll
                for (int bj = 0; bj < 2; ++bj) {
                    f32x4 v0 = acc[ai][bj][m][0] * r, v1 = acc[ai][bj][m][1] * r;
#pragma unroll
                    for (int j = 0; j < 4; ++j) { v0[j] = fmaxf(v0[j], 0.f); v1[j] = fmaxf(v1[j], 0.f); }
                    v0 = v0 * v0; v1 = v1 * v1;
                    if (FP8OUT) { v0 = v0 * FP8_SA; v1 = v1 * FP8_SA;
#pragma unroll
                        for (int j = 0; j < 4; ++j) { v0[j] = fminf(v0[j], 448.f); v1[j] = fminf(v1[j], 448.f); }
                        int w0 = 0, w1 = 0; w0 = __builtin_amdgcn_cvt_pk_fp8_f32(v0[0], v0[1], w0, false); w0 = __builtin_amdgcn_cvt_pk_fp8_f32(v0[2], v0[3], w0, true);
                        w1 = __builtin_amdgcn_cvt_pk_fp8_f32(v1[0], v1[1], w1, false); w1 = __builtin_amdgcn_cvt_pk_fp8_f32(v1[2], v1[3], w1, true);
                        u32x2 w; w.x = (unsigned)w0; w.y = (unsigned)w1;
                        *(u32x2*)((unsigned char*)H + (size_t)row * 8192 + col0 + bj * HALF) = w; }
                    else { u32x4 w; w.x = cvt_pk_bf16(v0[0], v0[1]); w.y = cvt_pk_bf16(v0[2], v0[3]); w.z = cvt_pk_bf16(v1[0], v1[1]); w.w = cvt_pk_bf16(v1[2], v1[3]);
                        *(u32x4*)(H + (size_t)row * 8192 + col0 + bj * HALF) = w; } }
            }
    }
};

struct EpiC1 {
    static constexpr bool PERM = true, AFTER_DRAIN = false;
    bf16_t* Bg; bf16_t* Z; const ssq_t* ssq; float iscale;
    __device__ __forceinline__ void operator()(const f32x4 (&acc)[2][2][4][2], const Unit& u, int wr, int wc, int fr, int fq) const {
        const int row0 = u.pm * BM + wr * 64 + fr;
        ssq_t sq[2][4];
#pragma unroll
        for (int ai = 0; ai < 2; ++ai)
#pragma unroll
            for (int m = 0; m < 4; ++m) sq[ai][m] = ssq[row0 + ai * HALF + m * 16];
        asm volatile("" ::: "memory");
        if (u.pn < 8) {
            const int col0 = u.pn * BM + wc * 32 + 8 * fq;
#pragma unroll
            for (int ai = 0; ai < 2; ++ai)
#pragma unroll
                for (int m = 0; m < 4; ++m) {
                    const int row = row0 + ai * HALF + m * 16; const float r = rstd_of(sq[ai][m]) * iscale; bf16_t* rowp = Bg + (size_t)row * 2048 + col0;
#pragma unroll
                    for (int bj = 0; bj < 2; ++bj) {
                        const f32x4 v0 = acc[ai][bj][m][0] * r, v1 = acc[ai][bj][m][1] * r;
                        u32x4 w; w.x = cvt_pk_bf16(v0[0], v0[1]); w.y = cvt_pk_bf16(v0[2], v0[3]); w.z = cvt_pk_bf16(v1[0], v1[1]); w.w = cvt_pk_bf16(v1[2], v1[3]);
                        *(u32x4*)(rowp + bj * HALF) = w; }
                }
        } else {
            const int col0 = (u.pn - 8) * HALF + wc * 32 + 8 * fq;
#pragma unroll
            for (int ai = 0; ai < 2; ++ai)
#pragma unroll
                for (int m = 0; m < 4; ++m) {
                    const int row = row0 + ai * HALF + m * 16; const float r = rstd_of(sq[ai][m]) * iscale; const float r2 = r * r;
                    const f32x4 v0 = acc[ai][0][m][0] * acc[ai][1][m][0] * r2, v1 = acc[ai][0][m][1] * acc[ai][1][m][1] * r2;
                    u32x4 w; w.x = cvt_pk_bf16(v0[0], v0[1]); w.y = cvt_pk_bf16(v0[2], v0[3]); w.z = cvt_pk_bf16(v1[0], v1[1]); w.w = cvt_pk_bf16(v1[2], v1[3]);
                    *(u32x4*)(Z + (size_t)row * 2048 + col0) = w;
                }
        }
    }
};

__device__ __forceinline__ float h2f_lo(unsigned w) { return (float)__builtin_bit_cast(_Float16, (unsigned short)(w & 0xffffu)); }
__device__ __forceinline__ float h2f_hi(unsigned w) { return (float)__builtin_bit_cast(_Float16, (unsigned short)(w >> 16)); }
__device__ __forceinline__ f32x4 cos4(u32x4 w) { return (f32x4){h2f_lo(w.x), h2f_lo(w.y), h2f_lo(w.z), h2f_lo(w.w)}; }
__device__ __forceinline__ f32x4 sin4(u32x4 w) { return (f32x4){h2f_hi(w.x), h2f_hi(w.y), h2f_hi(w.z), h2f_hi(w.w)}; }
struct EpiA1 {
    static constexpr bool PERM = false, AFTER_DRAIN = false;
    const ssq_t* ssq; bf16_t *Q, *K, *V, *QI, *KI; float* WI; const float *qg, *kg; const unsigned *ropeM, *ropeI; PG8_LAS float* P;
    __device__ __forceinline__ void operator()(const f32x4 (&acc)[2][2][4][2], const Unit& u, int wr, int wc, int fr, int fq) const {
        const int pn = u.pn, rl0 = wr * 64 + fr, row0 = u.pm * BM + rl0;
        ssq_t sq[2][4];
#pragma unroll
        for (int ai = 0; ai < 2; ++ai)
#pragma unroll
            for (int m = 0; m < 4; ++m) sq[ai][m] = ssq[row0 + ai * HALF + m * 16];
        if (pn < 10) {
            const bool isq = pn < 8; const float* g = isq ? qg : kg;
            const f32x4 g0 = *(const f32x4*)(g + 32 * wc + 4 * fq), g1 = *(const f32x4*)(g + 32 * wc + 16 + 4 * fq);
            u32x4 cw[2][4];
#pragma unroll
            for (int ai = 0; ai < 2; ++ai)
#pragma unroll
                for (int m = 0; m < 4; ++m) { const int row = row0 + ai * HALF + m * 16; cw[ai][m] = (u32x4){0x3c00u, 0x3c00u, 0x3c00u, 0x3c00u};
                    if (wc == 0) cw[ai][m] = *(const u32x4*)(ropeM + (size_t)row * 16 + 4 * fq); }
#pragma unroll
            for (int ai = 0; ai < 2; ++ai)
#pragma unroll
                for (int m = 0; m < 4; ++m) { const int rl = rl0 + ai * HALF + m * 16;
#pragma unroll
                    for (int bj = 0; bj < 2; ++bj) { const f32x4 a = acc[ai][bj][m][0], b = acc[ai][bj][m][1];
                        float s = ((a[0] * a[0] + a[1] * a[1]) + (a[2] * a[2] + a[3] * a[3])) + ((b[0] * b[0] + b[1] * b[1]) + (b[2] * b[2] + b[3] * b[3]));
                        s += __shfl_xor(s, 16); s += __shfl_xor(s, 32);
                        if (fq == 0) P[(rl * 2 + bj) * 4 + wc] = s; } }
            asm volatile("s_waitcnt lgkmcnt(0)" ::: "memory"); __builtin_amdgcn_s_barrier(); asm volatile("" ::: "memory");
#pragma unroll
            for (int ai = 0; ai < 2; ++ai)
#pragma unroll
                for (int m = 0; m < 4; ++m) { const int rl = rl0 + ai * HALF + m * 16, row = row0 + ai * HALF + m * 16; const float rs = rstd_of(sq[ai][m]);
                    bf16_t* dst = isq ? Q + (size_t)row * 2048 + pn * BM + wc * 32 + 4 * fq : K + (size_t)row * 512 + (pn - 8) * BM + wc * 32 + 4 * fq;
#pragma unroll
                    for (int bj = 0; bj < 2; ++bj) { const f32x4 pp = *(const PG8_LAS f32x4*)(P + (rl * 2 + bj) * 4);
                        const float tot = (pp[0] + pp[1]) + (pp[2] + pp[3]);
                        const float sc = rs * __builtin_amdgcn_rsqf(rs * rs * tot * (1.0f / 128.0f) + RMS_EPS);
                        f32x4 v0 = acc[ai][bj][m][0] * sc * g0, v1 = acc[ai][bj][m][1] * sc * g1;
                        if (wc == 0) { const f32x4 x1 = v0, x2 = v1, cs = cos4(cw[ai][m]), sn = sin4(cw[ai][m]); v0 = x1 * cs - x2 * sn; v1 = x2 * cs + x1 * sn; }
                        u32x2 w0, w1; w0.x = cvt_pk_bf16(v0[0], v0[1]); w0.y = cvt_pk_bf16(v0[2], v0[3]); w1.x = cvt_pk_bf16(v1[0], v1[1]); w1.y = cvt_pk_bf16(v1[2], v1[3]);
                        *(u32x2*)(dst + bj * HALF) = w0; *(u32x2*)(dst + bj * HALF + 16) = w1; } }
        } else if (pn < 12) {
            asm volatile("" ::: "memory");
#pragma unroll
            for (int ai = 0; ai < 2; ++ai)
#pragma unroll
                for (int m = 0; m < 4; ++m) { const int row = row0 + ai * HALF + m * 16; const float rs = rstd_of(sq[ai][m]);
                    bf16_t* dst = V + (size_t)row * 512 + (pn - 10) * BM + wc * 32 + 4 * fq;
#pragma unroll
                    for (int bj = 0; bj < 2; ++bj) { const f32x4 v0 = acc[ai][bj][m][0] * rs, v1 = acc[ai][bj][m][1] * rs;
                        u32x2 w0, w1; w0.x = cvt_pk_bf16(v0[0], v0[1]); w0.y = cvt_pk_bf16(v0[2], v0[3]); w1.x = cvt_pk_bf16(v1[0], v1[1]); w1.y = cvt_pk_bf16(v1[2], v1[3]);
                        *(u32x2*)(dst + bj * HALF) = w0; *(u32x2*)(dst + bj * HALF + 16) = w1; } }
        } else {
            const bool rot = ((wc & 1) == 0) && fq < 2;
            const int d0 = (wc & 1) ? 32 + 4 * fq : (fq < 2 ? 4 * fq : 16 + 4 * (fq - 2)), d1 = (wc & 1) ? 48 + 4 * fq : (fq < 2 ? 8 + 4 * fq : 24 + 4 * (fq - 2));
            const bool iski = pn == 16;
            u32x4 cw[2][4];
#pragma unroll
            for (int ai = 0; ai < 2; ++ai)
#pragma unroll
                for (int m = 0; m < 4; ++m) { const int row = row0 + ai * HALF + m * 16; cw[ai][m] = (u32x4){0x3c00u, 0x3c00u, 0x3c00u, 0x3c00u};
                    if (rot) cw[ai][m] = *(const u32x4*)(ropeI + (size_t)row * 8 + 4 * fq); }
            asm volatile("" ::: "memory");
#pragma unroll
            for (int ai = 0; ai < 2; ++ai)
#pragma unroll
                for (int m = 0; m < 4; ++m) { const int row = row0 + ai * HALF + m * 16; const float rs = rstd_of(sq[ai][m]);
#pragma unroll
                    for (int bj = 0; bj < 2; ++bj) {
                        f32x4 v0 = acc[ai][bj][m][0] * rs, v1 = acc[ai][bj][m][1] * rs;
                        if (iski) {
                            if (bj == 0) {
                                if (wc < 2) { if (rot) { const f32x4 x1 = v0, x2 = v1, cs = cos4(cw[ai][m]), sn = sin4(cw[ai][m]); v0 = x1 * cs - x2 * sn; v1 = x2 * cs + x1 * sn; }
                                    u32x2 w0, w1; w0.x = cvt_pk_bf16(v0[0], v0[1]); w0.y = cvt_pk_bf16(v0[2], v0[3]); w1.x = cvt_pk_bf16(v1[0], v1[1]); w1.y = cvt_pk_bf16(v1[2], v1[3]);
                                    bf16_t* dst = KI + (size_t)row * 64; *(u32x2*)(dst + d0) = w0; *(u32x2*)(dst + d1) = w1; }
                                else if (wc == 2) { *(f32x4*)(WI + (size_t)row * 16 + 4 * fq) = v0 * 0.03125f; }
                            }
                        } else {
                            if (rot) { const f32x4 x1 = v0, x2 = v1, cs = cos4(cw[ai][m]), sn = sin4(cw[ai][m]); v0 = x1 * cs - x2 * sn; v1 = x2 * cs + x1 * sn; }
                            u32x2 w0, w1; w0.x = cvt_pk_bf16(v0[0], v0[1]); w0.y = cvt_pk_bf16(v0[2], v0[3]); w1.x = cvt_pk_bf16(v1[0], v1[1]); w1.y = cvt_pk_bf16(v1[2], v1[3]);
                            bf16_t* dst = QI + (size_t)row * 1024 + ((pn - 12) * 4 + 2 * bj + (wc >> 1)) * 64; *(u32x2*)(dst + d0) = w0; *(u32x2*)(dst + d1) = w1; }
                    } }
        }
    }
};
template <class T> struct EpiTag { static constexpr int id = 0; };
template <> struct EpiTag<EpiA1> { static constexpr int id = 1; };
template <> struct EpiTag<EpiC1> { static constexpr int id = 2; };
template <> struct EpiTag<EpiM1<false>> { static constexpr int id = 3; };
template <> struct EpiTag<EpiM1<true>> { static constexpr int id = 4; };
template <class Epi, class Sched, bool ALIGN_EPI = false, bool SP2 = false, bool FP8 = false>
__device__ __forceinline__ void gemm_phase(PG8_LAS unsigned char* lds, const Gemm g, const Sched& S, const Epi& E) {
    int tid = threadIdx.x; asm volatile("" : "+v"(tid));
    const int wid = __builtin_amdgcn_readfirstlane(tid >> 6), lane = tid & 63, wr = wid >> 2, wc = wid & 3, fr = lane & 15, fq = lane >> 4;
    const int K = g.K, nt = K / BK;
    unsigned voffA[2], voffB[2];
#pragma unroll
    for (int i = 0; i < 2; ++i) { int R, C; stage_rc(tid * 16 + i * 8192, R, C); const int Rb = Epi::PERM ? ((R & ~31) + perm32(R & 31)) : R;
        voffA[i] = (unsigned)(R * K + C) * 2u; voffB[i] = (unsigned)(Rb * K + C) * 2u; }
    const size_t kstep = (size_t)(BK * 2);
    const size_t hstep = (size_t)HALF * K * 2;
    const size_t tstep = 2 * hstep;
    const unsigned ldsw = (unsigned)wid * 1024u;
    const int aoff = FP8 ? lds_byte(wr * 64 + fr, 16 * (fq & 1)) + (fq >> 1) * 1024 : lds_byte(wr * 64 + fr, fq * 8), boff = FP8 ? lds_byte(wc * 32 + fr, 16 * (fq & 1)) + (fq >> 1) * 1024 : lds_byte(wc * 32 + fr, fq * 8);
#define PG8_SA(b, h) (((b) * 2 + (h)) * HTB)
#define PG8_SB(b, h) ((4 + (b) * 2 + (h)) * HTB)
#define PG8_STAGE(bufoff, gbase, voff) do { _Pragma("unroll") for (int _i = 0; _i < 2; ++_i) \
        __builtin_amdgcn_global_load_lds((const unsigned*)((const char*)(gbase) + (voff)[_i]), (PG8_LAS unsigned*)(lds + (bufoff) + ldsw + _i * 8192), 16, 0, 0); } while (0)
#define PG8_LDA(dst, b, h) do { if constexpr (FP8) { _Pragma("unroll") for (int m = 0; m < 4; ++m) dst##8[m] = cat8(*(const PG8_LAS bf16x8*)(lds + PG8_SA(b, h) + aoff + m * 2048), *(const PG8_LAS bf16x8*)(lds + PG8_SA(b, h) + aoff + m * 2048 + 16)); } \
    else { _Pragma("unroll") for (int m = 0; m < 4; ++m) _Pragma("unroll") for (int k = 0; k < 2; ++k) dst[m][k] = *(const PG8_LAS bf16x8*)(lds + PG8_SA(b, h) + aoff + m * 2048 + k * 1024); } } while (0)
#define PG8_LDB(dst, b, h) do { if constexpr (FP8) { _Pragma("unroll") for (int n = 0; n < 2; ++n) dst##8[n] = cat8(*(const PG8_LAS bf16x8*)(lds + PG8_SB(b, h) + boff + n * 2048), *(const PG8_LAS bf16x8*)(lds + PG8_SB(b, h) + boff + n * 2048 + 16)); } \
    else { _Pragma("unroll") for (int n = 0; n < 2; ++n) _Pragma("unroll") for (int k = 0; k < 2; ++k) dst[n][k] = *(const PG8_LAS bf16x8*)(lds + PG8_SB(b, h) + boff + n * 2048 + k * 1024); } } while (0)
#define PG8_MMA(ai, bj, At, Bt) do { __builtin_amdgcn_s_setprio(1); if constexpr (FP8) { _Pragma("unroll") for (int m = 0; m < 4; ++m) _Pragma("unroll") for (int n = 0; n < 2; ++n) \
        asm volatile("v_mfma_scale_f32_16x16x128_f8f6f4 %0, %1, %2, %0, %3, %3 op_sel_hi:[0,0,0]" : "+v"(acc[ai][bj][m][n]) : "v"(Bt##8[n]), "v"(At##8[m]), "v"(sc1)); } \
    else { _Pragma("unroll") for (int m = 0; m < 4; ++m) _Pragma("unroll") for (int n = 0; n < 2; ++n) _Pragma("unroll") for (int k = 0; k < 2; ++k) \
        acc[ai][bj][m][n] = __builtin_amdgcn_mfma_f32_16x16x32_bf16(Bt[n][k], At[m][k], acc[ai][bj][m][n], 0, 0, 0); } __builtin_amdgcn_s_setprio(0); } while (0)
#define PG8_WAIT_V(n) asm volatile("s_waitcnt vmcnt(" #n ")" ::: "memory")
#define PG8_WAIT_L(n) asm volatile("s_waitcnt lgkmcnt(" #n ")" ::: "memory")
#define PG8_BAR __builtin_amdgcn_s_barrier()
#define PG8_SCHED __builtin_amdgcn_sched_barrier(0)
    Unit cur, nxt; int ui = 0;
    if (!S.next(0, cur)) return;
    f32x4 acc[2][2][4][2];
#pragma unroll
    for (int a = 0; a < 2; ++a)
#pragma unroll
        for (int b = 0; b < 2; ++b)
#pragma unroll
            for (int m = 0; m < 4; ++m)
#pragma unroll
                for (int n = 0; n < 2; ++n) acc[a][b][m][n] = (f32x4){0.f, 0.f, 0.f, 0.f};
    const int sc1 = 0x7f7f7f7f;
    bf16x8 At[4][2], B0[2][2], B1[2][2]; v8i_t At8[4], B08[2], B18[2];
    const char* cA = (const char*)g.A + (size_t)cur.pm * tstep; const char* cB = (const char*)g.Bt + (size_t)cur.pn * tstep;
    S.a_ready(cur);
    if constexpr (SP2) {
        PG8_STAGE(PG8_SB(0, 0), cB, voffB); PG8_STAGE(PG8_SB(0, 1), cB + hstep, voffB); PG8_STAGE(PG8_SA(0, 0), cA, voffA); PG8_STAGE(PG8_SA(0, 1), cA + hstep, voffA);
        if (wr == 1) PG8_BAR;
        PG8_WAIT_V(2); PG8_BAR;
        PG8_STAGE(PG8_SB(1, 0), cB + kstep, voffB); PG8_STAGE(PG8_SA(1, 0), cA + kstep, voffA); PG8_STAGE(PG8_SB(1, 1), cB + hstep + kstep, voffB);
        PG8_WAIT_V(6); PG8_BAR;
    } else {
        PG8_STAGE(PG8_SB(0, 0), cB, voffB); PG8_STAGE(PG8_SA(0, 0), cA, voffA); PG8_STAGE(PG8_SB(0, 1), cB + hstep, voffB); PG8_STAGE(PG8_SA(0, 1), cA + hstep, voffA);
        if (wr == 1) PG8_BAR;
        PG8_WAIT_V(4); PG8_BAR;
        PG8_STAGE(PG8_SB(1, 0), cB + kstep, voffB); PG8_STAGE(PG8_SA(1, 0), cA + kstep, voffA); PG8_STAGE(PG8_SB(1, 1), cB + hstep + kstep, voffB);
        PG8_WAIT_V(6); PG8_BAR;
    }
    for (;;) {
        const bool has_next = S.next(ui + 1, nxt);
        const char* nA = has_next ? (const char*)g.A + (size_t)nxt.pm * tstep : cA; const char* nB = has_next ? (const char*)g.Bt + (size_t)nxt.pn * tstep : cB;
        for (int t = 0; t < nt; t += 2) {
            const bool last = (t == nt - 2);
            const char* a1 = cA + (size_t)(t + 1) * kstep;
            const char* a2 = last ? nA : cA + (size_t)(t + 2) * kstep; const char* b2 = last ? nB : cB + (size_t)(t + 2) * kstep;
            const char* a3 = a2 + kstep; const char* b3 = b2 + kstep;
            if (last && has_next) S.a_ready(nxt);
            if constexpr (SP2) {
            PG8_LDB(B0, 0, 0); PG8_LDB(B1, 0, 1); PG8_SCHED; PG8_LDA(At, 0, 0); PG8_STAGE(PG8_SA(1, 1), a1 + hstep, voffA);
            PG8_WAIT_V(8); PG8_WAIT_L(0); PG8_BAR; PG8_MMA(0, 0, At, B0); PG8_MMA(0, 1, At, B1); PG8_BAR; PG8_SCHED;
            PG8_LDA(At, 0, 1); PG8_STAGE(PG8_SB(0, 0), b2, voffB); PG8_STAGE(PG8_SB(0, 1), b2 + hstep, voffB); PG8_STAGE(PG8_SA(0, 0), a2, voffA);
            PG8_WAIT_V(8); PG8_WAIT_L(0); PG8_BAR; PG8_MMA(1, 0, At, B0); PG8_MMA(1, 1, At, B1); PG8_BAR; PG8_SCHED;
            PG8_LDB(B0, 1, 0); PG8_LDB(B1, 1, 1); PG8_SCHED; PG8_LDA(At, 1, 0); PG8_STAGE(PG8_SA(0, 1), a2 + hstep, voffA);
            PG8_WAIT_V(8); PG8_WAIT_L(0); PG8_BAR; PG8_MMA(0, 0, At, B0); PG8_MMA(0, 1, At, B1); PG8_BAR; PG8_SCHED;
            PG8_LDA(At, 1, 1); PG8_STAGE(PG8_SB(1, 0), b3, voffB); PG8_STAGE(PG8_SB(1, 1), b3 + hstep, voffB); PG8_STAGE(PG8_SA(1, 0), a3, voffA);
            PG8_WAIT_V(8); PG8_WAIT_L(0); PG8_BAR; PG8_MMA(1, 0, At, B0); PG8_MMA(1, 1, At, B1); PG8_BAR; PG8_SCHED;
            } else {
            PG8_LDB(B0, 0, 0); PG8_SCHED; PG8_LDA(At, 0, 0); PG8_STAGE(PG8_SA(1, 1), a1 + hstep, voffA);
            PG8_WAIT_L(8); PG8_BAR; PG8_WAIT_L(0); PG8_MMA(0, 0, At, B0); PG8_BAR; PG8_SCHED;
            PG8_LDB(B1, 0, 1); PG8_STAGE(PG8_SB(0, 0), b2, voffB);
            PG8_BAR; PG8_WAIT_L(0); PG8_MMA(0, 1, At, B1); PG8_BAR;
            PG8_LDA(At, 0, 1); PG8_STAGE(PG8_SA(0, 0), a2, voffA);
            PG8_BAR; PG8_WAIT_L(0); PG8_MMA(1, 0, At, B0); PG8_BAR; PG8_SCHED;
            PG8_STAGE(PG8_SB(0, 1), b2 + hstep, voffB);
            PG8_WAIT_V(6); PG8_BAR; PG8_MMA(1, 1, At, B1); PG8_BAR;
            PG8_LDB(B0, 1, 0); PG8_SCHED; PG8_LDA(At, 1, 0); PG8_STAGE(PG8_SA(0, 1), a2 + hstep, voffA);
            PG8_WAIT_L(8); PG8_BAR; PG8_WAIT_L(0); PG8_MMA(0, 0, At, B0); PG8_BAR; PG8_SCHED;
            PG8_LDB(B1, 1, 1); PG8_STAGE(PG8_SB(1, 0), b3, voffB);
            PG8_BAR; PG8_WAIT_L(0); PG8_MMA(0, 1, At, B1); PG8_BAR;
            PG8_LDA(At, 1, 1); PG8_STAGE(PG8_SA(1, 0), a3, voffA);
            PG8_BAR; PG8_WAIT_L(0); PG8_MMA(1, 0, At, B0); PG8_BAR; PG8_SCHED;
            PG8_STAGE(PG8_SB(1, 1), b3 + hstep, voffB);
            PG8_WAIT_V(6); PG8_BAR; PG8_MMA(1, 1, At, B1); PG8_BAR;
            }
        }
        if constexpr (ALIGN_EPI) { if (wr == 0) PG8_BAR; }
#if defined(DBG_EPI_TYPE)
        unsigned long long et_ = 0; if (EpiTag<Epi>::id == DBG_EPI_TYPE && blockIdx.x == 0 && threadIdx.x == 0) et_ = __builtin_amdgcn_s_memrealtime();
#endif
        if constexpr (!Epi::AFTER_DRAIN) { E(acc, cur, wr, wc, fr, fq); S.done(cur); }
#if defined(DBG_EPI_TYPE)
        if (EpiTag<Epi>::id == DBG_EPI_TYPE && blockIdx.x == 0 && threadIdx.x == 0) { asm volatile("s_waitcnt vmcnt(0)" ::: "memory"); *(volatile PG8_LAS unsigned*)(lds + 150016 + 80) += (unsigned)(__builtin_amdgcn_s_memrealtime() - et_); }
#endif
        if (!has_next) break;
#pragma unroll
        for (int a = 0; a < 2; ++a)
#pragma unroll
            for (int b = 0; b < 2; ++b)
#pragma unroll
                for (int m = 0; m < 4; ++m)
#pragma unroll
                    for (int n = 0; n < 2; ++n) acc[a][b][m][n] = (f32x4){0.f, 0.f, 0.f, 0.f};
        cur = nxt; cA = nA; cB = nB; ++ui;
        if constexpr (ALIGN_EPI) { if (wr == 1) PG8_BAR; }
    }
    PG8_WAIT_V(0);
    if constexpr (!ALIGN_EPI) { if (wr == 0) PG8_BAR; }
    PG8_BAR;
    if constexpr (Epi::AFTER_DRAIN) { E.fused(acc, cur, wr, wc, fr, fq, lds, wid, lane); S.done(cur); }
#undef PG8_SA
#undef PG8_SB
#undef PG8_STAGE
#undef PG8_LDA
#undef PG8_LDB
#undef PG8_MMA
#undef PG8_WAIT_V
#undef PG8_WAIT_L
#undef PG8_BAR
#undef PG8_SCHED
}
}
#ifndef ATT_THR
#define ATT_THR 16.f
#endif
namespace att {
typedef unsigned short bf16;
typedef short bf16x8 __attribute__((ext_vector_type(8)));
typedef short s16x4 __attribute__((ext_vector_type(4)));
typedef float f32x16 __attribute__((ext_vector_type(16)));
typedef float f32x4 __attribute__((ext_vector_type(4)));
typedef unsigned u32x4 __attribute__((ext_vector_type(4)));
typedef unsigned long long u64;
constexpr int D = 128, SEQ = 4096, QP = 2048, KP = 512;
constexpr float SCALE = 0.08838834764831845f;
constexpr float THR = ATT_THR;
constexpr int NW = 8, QBLK = 32, KVBLK = 64, QB = NW * QBLK;
constexpr int SHM_V = KVBLK * D * 2, SHM_K = KVBLK * D * 2;
constexpr int LDS_BYTES = 2 * SHM_V + 2 * SHM_K + NW * 64 * 4;

#define KSWZ(row, colB) ((row) * 256 + ((colB) ^ (((row) & 7) << 4)))
#define SBAR() __builtin_amdgcn_sched_barrier(0)
__device__ __forceinline__ int v_st(int k, int c) { const int kk = (k & ~0xC) | ((k & 4) << 1) | ((k & 8) >> 1); return ((kk >> 3) * 4 + (c >> 5)) * 512 + ((kk & 7) * 32 + (c & 31)) * 2; }
__device__ __forceinline__ int v_rd_base(int lane) { return ((lane & 3) << 3) | (((lane >> 2) & 3) << 6) | (((lane >> 4) & 1) << 5) | (((lane >> 5) & 1) << 8); }
constexpr int v_rd_off(int d0, int ks, int half) { return d0 * 512 + ks * 4096 + half * 2048; }
__device__ __forceinline__ int crow(int r, int hi) { return (r & 3) + 8 * (r >> 2) + 4 * hi; }
__device__ __forceinline__ unsigned cvtpk(float lo, float hi) { unsigned r; asm volatile("v_cvt_pk_bf16_f32 %0, %1, %2" : "=v"(r) : "v"(lo), "v"(hi)); return r; }
__device__ __forceinline__ bf16x8 load8(const bf16* p) { return *reinterpret_cast<const bf16x8*>(p); }
template <bool NOP> __device__ __forceinline__ void mask_tile(f32x16& p0, f32x16& p1, u64 mk, int hi) {
    const unsigned m0 = (unsigned)mk >> (4 * hi), m1 = (unsigned)(mk >> 32) >> (4 * hi);
    const unsigned NEGINF = 0xFF800000u;
    if (NOP) asm volatile("s_nop 15\n\ts_nop 7" ::: "memory");
#pragma unroll
    for (int r = 0; r < 16; ++r) {
        const int c = (r & 3) + 8 * (r >> 2);
        unsigned t0, t1;
        asm volatile("v_bfe_i32 %0, %1, %2, 1" : "=v"(t0) : "v"(m0), "n"(c));
        asm volatile("v_bfi_b32 %0, %1, %0, %2" : "+v"(p0[r]) : "v"(t0), "s"(NEGINF));
        asm volatile("v_bfe_i32 %0, %1, %2, 1" : "=v"(t1) : "v"(m1), "n"(c));
        asm volatile("v_bfi_b32 %0, %1, %0, %2" : "+v"(p1[r]) : "v"(t1), "s"(NEGINF));
    }
}
__device__ __forceinline__ void partialSM(f32x16& p0, f32x16& p1, float& m_reg, float& mn, float& alpha) {
    float pmax = p0[0]; for (int r = 1; r < 16; ++r) pmax = fmaxf(pmax, p0[r]); for (int r = 0; r < 16; ++r) pmax = fmaxf(pmax, p1[r]);
    { auto rr = __builtin_amdgcn_permlane32_swap(__float_as_uint(pmax), __float_as_uint(pmax), false, false);
      pmax = fmaxf(__uint_as_float(rr[0]), __uint_as_float(rr[1])); }
    constexpr float C2 = 1.4426950408889634f * SCALE;
    if (__builtin_expect(__all((pmax - m_reg) * SCALE <= THR), 1)) { mn = m_reg; alpha = 1.f; }
    else { mn = fmaxf(m_reg, pmax); alpha = __builtin_amdgcn_exp2f((m_reg - mn) * C2); m_reg = mn; }
    const float mnL = -mn * C2;
    for (int r = 0; r < 16; ++r) p0[r] = fmaf(p0[r], C2, mnL); for (int r = 0; r < 16; ++r) p1[r] = fmaf(p1[r], C2, mnL);
    for (int r = 0; r < 16; ++r) p0[r] = __builtin_amdgcn_exp2f(p0[r]);
}
__device__ __forceinline__ void finishSM(f32x16& p0, f32x16& p1, float alpha, float& l_reg, bf16x8& pa0, bf16x8& pa1, bf16x8& pa2, bf16x8& pa3) {
    for (int r = 0; r < 16; ++r) p1[r] = __builtin_amdgcn_exp2f(p1[r]);
    float ps = 0; for (int r = 0; r < 16; ++r) ps += p0[r]; for (int r = 0; r < 16; ++r) ps += p1[r];
    { auto rr = __builtin_amdgcn_permlane32_swap(__float_as_uint(ps), __float_as_uint(ps), false, false);
      ps = __uint_as_float(rr[0]) + __uint_as_float(rr[1]); }
    l_reg = l_reg * alpha + ps;
#define PK4(P, B_, OUT) do { unsigned a0 = cvtpk(P[B_+0], P[B_+1]), a1 = cvtpk(P[B_+2], P[B_+3]);                          \
        unsigned b0 = cvtpk(P[B_+4], P[B_+5]), b1 = cvtpk(P[B_+6], P[B_+7]);                                             \
        auto r0 = __builtin_amdgcn_permlane32_swap(a0, b0, false, false); auto r1 = __builtin_amdgcn_permlane32_swap(a1, b1, false, false); \
        u32x4 w = {r0[0], r1[0], r0[1], r1[1]}; OUT = *reinterpret_cast<bf16x8*>(&w); } while (0)
    PK4(p0, 0, pa0); PK4(p0, 8, pa1); PK4(p1, 0, pa2); PK4(p1, 8, pa3);
#undef PK4
}
template <int KB>
__device__ __forceinline__ void qkt(f32x16& p0, f32x16& p1, const char* K_lds, int r32, int hi, const bf16x8* qr) {
    p0 = f32x16{}; p1 = f32x16{};
    const char* kb[4];
#pragma unroll
    for (int dd = 0; dd < 4; ++dd) kb[dd] = K_lds + KB * SHM_K + KSWZ(r32, (dd * 16 + hi * 8) * 2);
#pragma unroll
    for (int d0 = 0; d0 < 8; ++d0) { const char* a = kb[d0 & 3] + (d0 >> 2) * 128;
        bf16x8 b0 = *reinterpret_cast<const bf16x8*>(a);
        bf16x8 b1 = *reinterpret_cast<const bf16x8*>(a + 32 * 256);
        p0 = __builtin_amdgcn_mfma_f32_32x32x16_bf16(b0, qr[d0], p0, 0, 0, 0);
        p1 = __builtin_amdgcn_mfma_f32_32x32x16_bf16(b1, qr[d0], p1, 0, 0, 0); }
}
template <int VB>
__device__ __forceinline__ void pv_tile(f32x16* o, int vb0, bf16x8 pa0, bf16x8 pa1, bf16x8 pa2, bf16x8 pa3) {
#define TRRD(dst, off) asm volatile("ds_read_b64_tr_b16 %0, %1 offset:%2" : "=&v"(dst) : "v"(vb0), "i"(off) : "memory")
#define PV_D0(d0) do { s16x4 l0, l1, l2, l3, h0, h1, h2, h3; constexpr int b_ = VB * SHM_V + v_rd_off(d0, 0, 0); \
        TRRD(l0, b_); TRRD(h0, b_ + 2048); TRRD(l1, b_ + 4096); TRRD(h1, b_ + 6144); TRRD(l2, b_ + 8192); TRRD(h2, b_ + 10240); TRRD(l3, b_ + 12288); TRRD(h3, b_ + 14336); \
        asm volatile("s_waitcnt lgkmcnt(0)" ::: "memory"); SBAR();   \
        o[d0] = __builtin_amdgcn_mfma_f32_32x32x16_bf16(pa0, (bf16x8){l0[0], l0[1], l0[2], l0[3], h0[0], h0[1], h0[2], h0[3]}, o[d0], 0, 0, 0);   \
        o[d0] = __builtin_amdgcn_mfma_f32_32x32x16_bf16(pa1, (bf16x8){l1[0], l1[1], l1[2], l1[3], h1[0], h1[1], h1[2], h1[3]}, o[d0], 0, 0, 0);   \
        o[d0] = __builtin_amdgcn_mfma_f32_32x32x16_bf16(pa2, (bf16x8){l2[0], l2[1], l2[2], l2[3], h2[0], h2[1], h2[2], h2[3]}, o[d0], 0, 0, 0);   \
        o[d0] = __builtin_amdgcn_mfma_f32_32x32x16_bf16(pa3, (bf16x8){l3[0], l3[1], l3[2], l3[3], h3[0], h3[1], h3[2], h3[3]}, o[d0], 0, 0, 0); } while (0)
    PV_D0(0); PV_D0(1); PV_D0(2); PV_D0(3);
#undef PV_D0
#undef TRRD
}
__device__ __forceinline__ u64 causal_word(int n) { return n >= 64 ? ~0ull : (n <= 0 ? 0ull : ((1ull << n) - 1ull)); }
struct BlockRef { const bf16* Q; const bf16* K; const bf16* V; bf16* O; const u64* M; int P0; };
struct Seam { bf16x8 qr[8]; bf16x8 st_v0, st_v1, st_k0, st_k1; };
#define ROW(p, k0, rr) ((p) + (unsigned)(((k0) + (rr)) * KP + sc))
#define VMW() asm volatile("s_waitcnt vmcnt(0)" ::: "memory")
#define VMWN(n) asm volatile("s_waitcnt vmcnt(%0)" :: "i"(n) : "memory")
#define SLOAD_H(Kp, Vp, k0) do { S.st_v0 = load8(ROW(Vp, k0, sr)); S.st_v1 = load8(ROW(Vp, k0, 32 + sr));              \
                         S.st_k0 = load8(ROW(Kp, k0, sr)); S.st_k1 = load8(ROW(Kp, k0, 32 + sr)); } while (0)
#define SWRITE_HK(bf) do { *(bf16x8*)(K_lds + (bf) * SHM_K + kws) = S.st_k0; *(bf16x8*)(K_lds + (bf) * SHM_K + kws + 32 * 256) = S.st_k1; } while (0)
#define SWRITE_HV(bf) do { *(bf16x8*)(V_lds + (bf) * SHM_V + vst0) = S.st_v0; *(bf16x8*)(V_lds + (bf) * SHM_V + vst1) = S.st_v1; } while (0)
#define SWRITE_H(bf) do { SWRITE_HV(bf); SWRITE_HK(bf); } while (0)
__device__ __forceinline__ void attn_prime(const BlockRef& cur, char* lds, Seam& S) {
    int tid = threadIdx.x; asm volatile("" : "+v"(tid));
    const int wid = __builtin_amdgcn_readfirstlane(tid >> 6), lane = tid & 63, r32 = lane & 31, hi = lane >> 5;
    const int sr = tid >> 4, sc = (tid & 15) * 8, kws = KSWZ(sr, sc * 2); char* K_lds = lds + 2 * SHM_V;
    for (int d0 = 0; d0 < 8; ++d0) S.qr[d0] = load8(cur.Q + (unsigned)((wid * QBLK + r32) * QP + d0 * 16 + hi * 8));
    SLOAD_H(cur.K, cur.V, 0); VMW(); SWRITE_HK(0);
    __syncthreads();
}
__device__ __forceinline__ void attn_block(const BlockRef& cur, const BlockRef& nxt, char* lds, Seam& S) {
    int tid = threadIdx.x; asm volatile("" : "+v"(tid));
    const int wid = __builtin_amdgcn_readfirstlane(tid >> 6), lane = tid & 63, r32 = lane & 31, hi = lane >> 5;
    const int NT = (cur.P0 + QB - 1) / KVBLK + 1;
    char* V_lds = lds; char* K_lds = lds + 2 * SHM_V;
    float* ws = (float*)(lds + 2 * SHM_V + 2 * SHM_K) + wid * 64; float* li_l = ws, * al_l = ws + 32;
    float m_reg = -1e30f, l_reg = 0; f32x16 o[4] = {};
    const int sr = tid >> 4, sc = (tid & 15) * 8, vst0 = v_st(sr, sc), vst1 = v_st(32 + sr, sc), kws = KSWZ(sr, sc * 2);
    const int vb0 = (int)(uintptr_t)V_lds + v_rd_base(lane);
    const bf16* Kh = cur.K; const bf16* Vh = cur.V;
    const u64* Mb = cur.M; const unsigned mo = (unsigned)(cur.P0 + wid * QBLK + r32);
#if defined(DBG_CAUSAL_ONLY)
#define LOADMK(t) causal_word((int)mo - 64 * (t) + 1)
#else
#define LOADMK(t) Mb[mo + (unsigned)((t) * SEQ)]
#endif
#define RESC(a) do { if (__any((a) < 1.f)) { if (hi == 0) al_l[r32] = (a); asm volatile("s_waitcnt lgkmcnt(0)" ::: "memory");              \
                     for (int d_ = 0; d_ < 4; ++d_) for (int r = 0; r < 16; ++r) o[d_][r] *= al_l[crow(r, hi)]; } } while (0)
#define KBASE(t) ((t) * KVBLK)
#define SEAM_K0() do { VMWN(8); SWRITE_HK(0); SBAR(); } while (0)
    f32x16 pA0, pA1, pB0, pB1; float mnA, mnB, alA, alB; bf16x8 pa0, pa1, pa2, pa3; u64 mk;
    SWRITE_HV(0); SBAR();
    mk = LOADMK(0);
    if (NT > 1) { SLOAD_H(Kh, Vh, KBASE(1)); }
    SBAR(); qkt<0>(pA0, pA1, K_lds, r32, hi, S.qr); SBAR();
    VMW();
    mask_tile<true>(pA0, pA1, mk, hi); partialSM(pA0, pA1, m_reg, mnA, alA);
    if (NT > 1) { SWRITE_H(1); }
    __syncthreads();
#define HALF_STEP(PX0, PX1, mnX, alX, PY0, PY1, alY, t, KB, VB, SB) do {                                                     \
        mk = LOADMK(t);                                                                                           \
        SBAR(); qkt<KB>(PX0, PX1, K_lds, r32, hi, S.qr);                                                                      \
        finishSM(PY0, PY1, alY, l_reg, pa0, pa1, pa2, pa3); SBAR();                                                           \
        if ((t) + 1 < NT) { SLOAD_H(Kh, Vh, KBASE((t) + 1)); SBAR(); }                                                        \
        pv_tile<VB>(o, vb0, pa0, pa1, pa2, pa3);                                                                              \
        if ((t) + 1 < NT) VMWN(4); else VMW();                                                                                \
        mask_tile<false>(PX0, PX1, mk, hi); partialSM(PX0, PX1, m_reg, mnX, alX);                                                    \
        __syncthreads();                                                                                                      \
        if ((t) + 1 < NT) { VMW(); SWRITE_H(SB); }                                                                            \
        RESC(alX); __syncthreads(); } while (0)
    for (int t = 1; t + 1 < NT; t += 2) {
        HALF_STEP(pB0, pB1, mnB, alB, pA0, pA1, alA, t, 1, 0, 0);
        HALF_STEP(pA0, pA1, mnA, alA, pB0, pB1, alB, t + 1, 0, 1, 1);
    }
    const bool even = (NT & 1) == 0;
    if (even) { mk = LOADMK(NT - 1); SBAR(); qkt<1>(pB0, pB1, K_lds, r32, hi, S.qr); SBAR(); }
    SLOAD_H(nxt.K, nxt.V, 0); SBAR();
#pragma unroll
    for (int d0 = 0; d0 < 8; ++d0) S.qr[d0] = load8(nxt.Q + (unsigned)((wid * QBLK + r32) * QP + d0 * 16 + hi * 8));
    SBAR();
    finishSM(pA0, pA1, alA, l_reg, pa0, pa1, pa2, pa3); SBAR();
    pv_tile<0>(o, vb0, pa0, pa1, pa2, pa3);
    if (even) { VMWN(12); mask_tile<false>(pB0, pB1, mk, hi); partialSM(pB0, pB1, m_reg, mnB, alB); __syncthreads(); RESC(alB);
        finishSM(pB0, pB1, alB, l_reg, pa0, pa1, pa2, pa3); SBAR(); pv_tile<1>(o, vb0, pa0, pa1, pa2, pa3); }
    SBAR(); SEAM_K0();
    if (hi == 0) li_l[r32] = l_reg; asm volatile("s_waitcnt lgkmcnt(0)" ::: "memory");
    float rli[16];
#pragma unroll
    for (int r = 0; r < 16; ++r) rli[r] = __builtin_amdgcn_rcpf(li_l[crow(r, hi)]);
    bf16* Ow = cur.O + (unsigned)((wid * QBLK) * QP);
#pragma unroll
    for (int r = 0; r < 16; ++r) { const int orow = crow(r, hi);
#pragma unroll
        for (int d0 = 0; d0 < 4; ++d0) { const float v = o[d0][r] * rli[r];
            const float vn = __shfl_xor(v, 1);
            if ((r32 & 1) == 0) *(unsigned*)(Ow + (unsigned)(orow * QP + d0 * 32 + r32)) = cvtpk(v, vn); } }
    __syncthreads();
#undef RESC
#undef KBASE
#undef SEAM_K0
#undef HALF_STEP
}
#undef ROW
#undef VMW
#undef VMWN
#undef SLOAD_H
#undef SWRITE_HK
#undef SWRITE_HV
#undef SWRITE_H
struct Item { int bh, qb0, qb1; };
__device__ __forceinline__ Item decode(int L) {
    constexpr int G = 4, nx = 8, per = G * nx; Item it;
    const int xcd = L & 7, k = L >> 3, gi = k / per, r = k - gi * per;
    it.bh = (gi * 8 + xcd) * G + r / nx; const int x = r % nx;
    it.qb0 = x; it.qb1 = 15 - x; return it;
}
struct Tensors { const bf16* Q; const bf16* K; const bf16* V; bf16* O; const u64* M; };
__device__ __forceinline__ BlockRef make_ref(const Item& it, int pass, const Tensors& T) {
    const int qb = pass ? it.qb1 : it.qb0, b = it.bh >> 4, h = it.bh & 15, kvh = h >> 2;
    BlockRef r;
    r.Q = T.Q + ((size_t)b * SEQ + (size_t)qb * QB) * QP + h * D; r.O = T.O + ((size_t)b * SEQ + (size_t)qb * QB) * QP + h * D;
    r.K = T.K + (size_t)b * SEQ * KP + kvh * D; r.V = T.V + (size_t)b * SEQ * KP + kvh * D; r.M = T.M + (size_t)b * 64 * SEQ; r.P0 = qb * QB;
    return r;
}
__device__ __forceinline__ void attn_phase(char* lds, const Tensors& T, int wg, int nwg) {
    constexpr int total = 512;
    int L = wg; if (L >= total) return;
    Item it = decode(L); int pass = 0;
    BlockRef cur = make_ref(it, 0, T);
    Seam S;
    attn_prime(cur, lds, S);
    for (;;) {
        const bool more_pass = pass == 0 && it.qb1 != it.qb0, more_item = L + nwg < total, last = !more_pass && !more_item;
        Item itn = it; int passn = pass + 1, Ln = L;
        if (!more_pass) { passn = 0; Ln = more_item ? L + nwg : L; itn = decode(Ln); }
        const BlockRef nxt = last ? cur : make_ref(itn, passn, T);
        attn_block(cur, nxt, lds, S);
        if (last) break;
        cur = nxt; it = itn; pass = passn; L = Ln;
    }
}
#undef KSWZ
#undef SBAR
}
constexpr int NWAVES = 8;
#ifndef DBG_P0_TIME
#define DBG_P0_TIME 0
#endif
#define P0T_BEGIN(k) unsigned long long p0t##k = 0; if (DBG_P0_TIME == (k) && blockIdx.x == 0 && threadIdx.x == 0) p0t##k = __builtin_amdgcn_s_memrealtime()
#define P0T_END(k) do { if (DBG_P0_TIME == (k) && blockIdx.x == 0 && threadIdx.x == 0) { asm volatile("s_waitcnt vmcnt(0)" ::: "memory"); F.MISC[20] += (unsigned)(__builtin_amdgcn_s_memrealtime() - p0t##k); } } while (0)
#ifndef P0_NT
#define P0_NT 1
#endif
#if P0_NT
#define P0_LOAD(p) __builtin_nontemporal_load(p)
#else
#define P0_LOAD(p) (*(p))
#endif
#ifndef DBG_IDX_TID
#define DBG_IDX_TID 0
#endif
#ifndef DBG_IDX_TIME
#define DBG_IDX_TIME 0
#endif
#define IDXT_BEGIN(k) unsigned long long idxt_ = 0; if (DBG_IDX_TIME == (k) && blockIdx.x == 0 && threadIdx.x == DBG_IDX_TID) idxt_ = __builtin_amdgcn_s_memrealtime()
#define IDXT_END(k) do { if (DBG_IDX_TIME == (k) && blockIdx.x == 0 && threadIdx.x == DBG_IDX_TID) { const unsigned long long d_ = __builtin_amdgcn_s_memrealtime() - idxt_; F.MISC[20] += (unsigned)d_; } } while (0)
#ifndef C2_FP8
#define C2_FP8 0x8
#endif
#ifndef C1_FP8
#define C1_FP8 0x8
#endif
#ifndef M1_FP8
#define M1_FP8 0xC
#endif
#ifndef MLP_FP8
#define MLP_FP8 0xE
#endif
#ifndef DBG_TIME_PHASE
#define DBG_TIME_PHASE -1
#endif
#ifndef DBG_TIME_TO
#define DBG_TIME_TO (DBG_TIME_PHASE + 1)
#endif
#ifndef DBG_CLK_PHASE
#define DBG_CLK_PHASE -1
#endif
#define CLKSTAMP(k) do { if (DBG_CLK_PHASE >= 0 && (DBG_CLK_PHASE == (k) || DBG_CLK_PHASE + 1 == (k)) && blockIdx.x == 0 && threadIdx.x == 0) { const unsigned long long c_ = __builtin_readcyclecounter(), r_ = __builtin_amdgcn_s_memrealtime(); \
    volatile LAS unsigned* m_ = F.MISC + (DBG_CLK_PHASE == (k) ? 32 : 36); m_[0] = (unsigned)c_; m_[1] = (unsigned)(c_ >> 32); m_[2] = (unsigned)r_; m_[3] = (unsigned)(r_ >> 32); } } while (0)
#define STAMP(k) do { CLKSTAMP(k); if (DBG_TIME_PHASE >= 0 && (DBG_TIME_PHASE == (k) || DBG_TIME_TO == (k)) && blockIdx.x == 0 && threadIdx.x == 0) { const unsigned long long ts_ = __builtin_amdgcn_s_memrealtime(); volatile LAS unsigned* m_ = F.MISC + (DBG_TIME_PHASE == (k) ? 16 : 18); m_[0] = (unsigned)ts_; m_[1] = (unsigned)(ts_ >> 32); } } while (0)
#ifndef DBG_IDX_REP_SCORE
#define DBG_IDX_REP_SCORE 0
#endif
#ifndef DBG_IDX_REP_SEL
#define DBG_IDX_REP_SEL 0
#endif
#ifndef PG8_ALIGN_X
#define PG8_ALIGN_X true
#endif
#ifndef PG8_SP2_F8
#define PG8_SP2_F8 true
#endif
#ifndef PG8_SP2_X
#define PG8_SP2_X true
#endif
#ifndef DBG_A4_SRC
#define DBG_A4_SRC WS_O
#endif
#ifndef MK_PER_PHASE
#define MK_PER_PHASE 0
#endif
constexpr int BATCH = 4, SEQ = 4096, DM = 2048, M = BATCH * SEQ, DFF = 8192, DEPTH = 4;
constexpr int NA1 = 4352, NA1_SRC = 4176, NC1 = 6144;
constexpr int TOPK = 256;
constexpr size_t MiB = 1u << 20;
constexpr size_t WS_CTL = 0, CTL_ZERO_BYTES = 3 * MiB;
constexpr int CW_P0Q = 8192;
constexpr int CW_BAR = 4096;
constexpr size_t WS_SSQ = 1 * MiB;
constexpr size_t WS_ROPEM = 3 * MiB;
constexpr size_t WS_ROPEI = 5 * MiB;
constexpr size_t WS_SMALL = WS_ROPEI + 512 * 1024;
constexpr size_t WS_QG = WS_SMALL, WS_KG = WS_SMALL + 1024, WS_CONVW = WS_SMALL + 4096, WS_INPTR = WS_SMALL + 65536;
constexpr size_t WS_WA1 = 6 * MiB;  static_assert(WS_SSQ + 9 * (size_t)M * 8 <= CTL_ZERO_BYTES, "ssq inside memset");
constexpr size_t SZ_WA1 = (size_t)NA1 * DM * 2;
constexpr size_t WS_WA4 = WS_WA1 + 2 * SZ_WA1;
constexpr size_t SZ_WSQ = (size_t)DM * DM * 2;
constexpr size_t WS_WC1 = WS_WA4 + 2 * SZ_WSQ;
constexpr size_t SZ_WC1 = (size_t)NC1 * DM * 2;
constexpr size_t WS_WC2 = WS_WC1 + 2 * SZ_WC1;
constexpr size_t WS_WM1 = WS_WC2 + 2 * SZ_WSQ;
constexpr size_t SZ_WM = (size_t)DFF * DM * 2;
constexpr size_t WS_WM2 = WS_WM1 + 4 * SZ_WM;
constexpr size_t WS_XB = WS_WM2 + 4 * SZ_WM;
constexpr size_t WS_ACT = WS_XB + (size_t)M * DM * 2;
constexpr size_t SZ_MD = (size_t)M * DM * 2;
constexpr size_t WS_H = WS_ACT;
constexpr size_t WS_Q = WS_ACT, WS_O = WS_ACT + SZ_MD, WS_K = WS_ACT + 2 * SZ_MD, WS_V = WS_K + 16 * MiB, WS_QI = WS_V + 16 * MiB, WS_KI = WS_QI + 32 * MiB,
                 WS_WI = WS_KI + 2 * MiB, WS_MASK = WS_WI + 1 * MiB;
constexpr size_t WS_BG = WS_ACT, WS_Z = WS_ACT + SZ_MD, WS_G = WS_ACT + 2 * SZ_MD;
constexpr size_t WS_END = WS_ACT + 256 * MiB;
constexpr size_t WS_XB8 = WS_END;
static_assert(WS_MASK + 8 * MiB <= WS_END && WS_G + SZ_MD <= WS_END && WS_H + (size_t)M * DFF * 2 <= WS_END, "d_ws map");
constexpr int RING_OFF = 0, RING_BYTES = 131072;
constexpr int AUX_OFF = RING_BYTES, AUX_BYTES = 16384 + 2048 + 512;
constexpr int MISC_OFF = AUX_OFF + AUX_BYTES;
constexpr int WQ_OFF = MISC_OFF + 256;
constexpr int LDS_BYTES = WQ_OFF + 512;
static_assert(LDS_BYTES <= 160 * 1024 && MISC_OFF == 150016, "LDS map");

#define GAS __attribute__((address_space(1)))
#define LAS __attribute__((address_space(3)))
typedef unsigned short bf16;
typedef unsigned v4u __attribute__((ext_vector_type(4)));
typedef unsigned v2u __attribute__((ext_vector_type(2)));
typedef float f32x4 __attribute__((ext_vector_type(4)));
typedef short bf16x8 __attribute__((ext_vector_type(8)));
typedef float f32x16 __attribute__((ext_vector_type(16)));
typedef GAS unsigned gu32;
#define RLX_AGENT __ATOMIC_RELAXED, __HIP_MEMORY_SCOPE_AGENT
#define LDS_WAIT() asm volatile("s_waitcnt lgkmcnt(0)" ::: "memory")
#define VM_WAIT() asm volatile("s_waitcnt vmcnt(0)" ::: "memory")
__device__ __forceinline__ unsigned f2bf(float f) { unsigned u = __builtin_bit_cast(unsigned, f); return (u + 0x7fffu + ((u >> 16) & 1u)) >> 16; }
__device__ __forceinline__ unsigned pk2(float lo, float hi) { return f2bf(lo) | (f2bf(hi) << 16); }
__device__ __forceinline__ float bf2f(unsigned short b) { return __uint_as_float((unsigned)b << 16); }
__device__ __forceinline__ float wave_sum(float v) {
#pragma unroll
    for (int o = 1; o < 64; o <<= 1) v += __shfl_xor(v, o);
    return v;
}
__device__ __forceinline__ float wave_min(float v) {
#pragma unroll
    for (int o = 1; o < 64; o <<= 1) v = fminf(v, __shfl_xor(v, o));
    return v;
}
__device__ __forceinline__ float wave_max(float v) {
#pragma unroll
    for (int o = 1; o < 64; o <<= 1) v = fmaxf(v, __shfl_xor(v, o));
    return v;
}

#define XB_TMO      128
#define XB_XCNT(j)  (256  + 64 * (j))
#define XB_XSUB(j)  (1280 + 64 * (j))
#define XB_XGEN(j)  (2304 + 64 * (j))
#define XB_TOP      3328
#define XB_TOPGEN   3392
#define XCD_BAR_WORDS 3456
#define XB_SPIN_CAP (1u << 18)

__device__ __forceinline__ unsigned xb_ld(unsigned* p)              { return __hip_atomic_load(p, __ATOMIC_RELAXED, __HIP_MEMORY_SCOPE_AGENT); }
__device__ __forceinline__ unsigned xb_add(unsigned* p, unsigned v) { return __hip_atomic_fetch_add(p, v, __ATOMIC_RELAXED, __HIP_MEMORY_SCOPE_AGENT); }
__device__ __forceinline__ unsigned xb_xcc_id() { return (unsigned)__builtin_amdgcn_s_getreg((3 << 11) | 20) & 0xFu; }
#define XB_SPIN(cond, bar) do { unsigned _sp = 0; while (cond) { __builtin_amdgcn_s_sleep(1); \
    if ((++_sp & 255u) == 0u) { if (xb_ld(&(bar)[XB_TMO])) break; if (_sp > XB_SPIN_CAP) { atomicAdd(&(bar)[XB_TMO], 1u); break; } } } } while (0)

struct XcdBarrier {
    unsigned* bar; unsigned x;
    volatile LAS unsigned* st;
};

__device__ __forceinline__ XcdBarrier xcd_barrier_post(unsigned* bar, volatile LAS unsigned* st) {
    XcdBarrier b; b.bar = bar; b.x = xb_xcc_id(); b.st = st;
    if (threadIdx.x == 0) (void)xb_add(&bar[XB_XCNT(b.x)], 1u);
    return b;
}
__device__ __forceinline__ void xcd_barrier_complete(unsigned* bar, unsigned x, unsigned& nloc, unsigned& nx) {
    const unsigned G = gridDim.x * gridDim.y * gridDim.z;
    unsigned sum, cnt, mine, sp = 0u;
    for (;;) {
        sum = 0u; cnt = 0u; mine = 0u;
#pragma unroll
        for (unsigned j = 0; j < 16; ++j) { const unsigned c = xb_ld(&bar[XB_XCNT(j)]); sum += c; cnt += (c > 0u) ? 1u : 0u; mine = (j == x) ? c : mine; }
        if (sum == G) break;
        __builtin_amdgcn_s_sleep(1);
        if ((++sp & 255u) == 0u) { if (xb_ld(&bar[XB_TMO])) break; if (sp > XB_SPIN_CAP) { atomicAdd(&bar[XB_TMO], 1u); break; } }
    }
    nloc = mine > 0u ? mine : 1u; nx = cnt > 0u ? cnt : 1u;
}

__device__ __forceinline__ void xcd_barrier(const XcdBarrier& b) {
    asm volatile("s_waitcnt vmcnt(0)" ::: "memory");
    __syncthreads();
    if (threadIdx.x == 0) {
        unsigned* bar = b.bar;
        __builtin_amdgcn_s_waitcnt(0);
        unsigned nloc = b.st[0], nx = b.st[1];
        if (nloc == 0u) { xcd_barrier_complete(bar, b.x, nloc, nx); b.st[0] = nloc; b.st[1] = nx; }
        const unsigned old = xb_add(&bar[XB_XSUB(b.x)], 1u);
        const unsigned gen = old / nloc;
        if (old + 1u == (gen + 1u) * nloc) {
            __builtin_amdgcn_fence(__ATOMIC_RELEASE, "agent");
            asm volatile("s_waitcnt vmcnt(0)" ::: "memory");
            const unsigned og = xb_add(&bar[XB_TOP], 1u);
            const unsigned tg = og / nx;
            if (og + 1u == (tg + 1u) * nx) xb_add(&bar[XB_TOPGEN], 1u);
            else XB_SPIN(xb_ld(&bar[XB_TOPGEN]) == tg, bar);
            __builtin_amdgcn_fence(__ATOMIC_ACQUIRE, "agent");
            xb_add(&bar[XB_XGEN(b.x)], 1u);
            asm volatile("s_waitcnt vmcnt(0)" ::: "memory");
        } else {
            XB_SPIN(xb_ld(&bar[XB_XGEN(b.x)]) == gen, bar);
            __builtin_amdgcn_fence(__ATOMIC_ACQUIRE, "agent");
            asm volatile("s_waitcnt vmcnt(0)" ::: "memory");
        }
    }
    __syncthreads();
}

struct Frame {
    LAS unsigned char* lds;
    volatile LAS unsigned* MISC;
    gu32* ctl;
    int tid, lane, wave, vcu, G;
    unsigned char* ws;
};

__device__ __forceinline__ int dmap64(int s) { if (s >= 32) return s; const int nn = s >> 4, fq = (s >> 2) & 3, j = s & 3; return fq < 2 ? 8 * nn + 4 * fq + j : 16 + 8 * nn + 4 * (fq - 2) + j; }
__device__ __forceinline__ int src_col(int kind, int n) {
    if (kind == 0) return n;
    const int pn = n >> 8, p = n & 255;
    if (kind == 1) {
        if (pn < 12) return n;
        if (pn < 16) return 3072 + (pn - 12) * 256 + (p >> 6) * 64 + dmap64(p & 63);
        if (p < 64) return 4096 + dmap64(p);
        if (p < 80) return 4160 + (p - 64);
        return -1;
    }
    if (pn < 8) return n;
    const int i = pn - 8; return p < 128 ? 2048 + 128 * i + p : 4096 + 128 * i + (p - 128);
}
struct P0Desc { const float* src; const float* g; bf16* dst; int Nsrc, K, fp8, hasg; };
__device__ __forceinline__ void p0_desc(const float* W, const float* g, int K, int Nsrc, int Npad, int kind, bf16* WT, int item, int lane, P0Desc& d, int fp8 = 0) {
    const int nblk = Npad / 32, kb = item / nblk, nb = item % nblk, kg = lane >> 3, ng = lane & 7, k0 = 64 * kb + 8 * kg, n0 = 32 * nb + 4 * ng;
    const int col = src_col(kind, n0);
    d.src = col >= 0 ? W + (size_t)k0 * Nsrc + col : nullptr; d.g = g ? g + k0 : nullptr; d.dst = fp8 ? (bf16*)((unsigned char*)WT + (size_t)n0 * K + k0) : WT + (size_t)n0 * K + k0; d.Nsrc = Nsrc; d.K = K; d.fp8 = fp8; d.hasg = g != nullptr;
}
__device__ __forceinline__ void p0_load(const P0Desc& d, f32x4 (&v)[8], f32x4& ga, f32x4& gb) {
#pragma unroll
    for (int i = 0; i < 8; ++i) v[i] = d.src ? P0_LOAD((const f32x4*)(d.src + (size_t)i * d.Nsrc)) : (f32x4){0.f, 0.f, 0.f, 0.f};
    if (d.g) { ga = *(const f32x4*)d.g; gb = *(const f32x4*)(d.g + 4); } else { ga = (f32x4){1.f, 1.f, 1.f, 1.f}; gb = ga; }
}
#ifndef P0_HWPK
#define P0_HWPK 1
#endif
#if P0_HWPK
#define P0_PK(a, b) pg8::cvt_pk_bf16(a, b)
#else
#define P0_PK(a, b) pk2(a, b)
#endif
__device__ __forceinline__ void p0_load_nn(const P0Desc& d, f32x4 (&v)[8], f32x4& ga, f32x4& gb) {
    const GAS float* sp = (const GAS float*)d.src;
#pragma unroll
    for (int i = 0; i < 8; ++i) v[i] = P0_LOAD((const GAS f32x4*)(sp + (size_t)i * d.Nsrc));
    if (d.hasg) { const GAS float* gp = (const GAS float*)d.g; ga = *(const GAS f32x4*)gp; gb = *(const GAS f32x4*)(gp + 4); } else { ga = (f32x4){1.f, 1.f, 1.f, 1.f}; gb = ga; }
}
template <bool NT = false> __device__ __forceinline__ void p0_store(const P0Desc& d, const f32x4 (&v)[8], const f32x4& ga, const f32x4& gb) {
    if (d.fp8) {
        const float s = d.fp8 == 2 ? pg8::FP8_SWC : pg8::FP8_SW; float gs[8];
#pragma unroll
        for (int i = 0; i < 8; ++i) gs[i] = (i < 4 ? ga[i & 3] : gb[i & 3]) * s;
#pragma unroll
        for (int q = 0; q < 4; ++q) { int w0 = 0, w1 = 0;
            float e[8];
#pragma unroll
            for (int i = 0; i < 8; ++i) e[i] = __builtin_amdgcn_fmed3f(v[i][q] * gs[i], -448.f, 448.f);
            w0 = __builtin_amdgcn_cvt_pk_fp8_f32(e[0], e[1], w0, false); w0 = __builtin_amdgcn_cvt_pk_fp8_f32(e[2], e[3], w0, true);
            w1 = __builtin_amdgcn_cvt_pk_fp8_f32(e[4], e[5], w1, false); w1 = __builtin_amdgcn_cvt_pk_fp8_f32(e[6], e[7], w1, true);
            v2u o; o.x = (unsigned)w0; o.y = (unsigned)w1; if (NT) __builtin_nontemporal_store(o, (GAS v2u*)((unsigned char*)d.dst + (size_t)q * d.K)); else *(GAS v2u*)((unsigned char*)d.dst + (size_t)q * d.K) = o; }
        return; }
    if (!d.hasg) {
#pragma unroll
        for (int q = 0; q < 4; ++q) { v4u o; o.x = P0_PK(v[0][q], v[1][q]); o.y = P0_PK(v[2][q], v[3][q]); o.z = P0_PK(v[4][q], v[5][q]); o.w = P0_PK(v[6][q], v[7][q]);
            if (NT) __builtin_nontemporal_store(o, (GAS v4u*)(d.dst + (size_t)q * d.K)); else *(GAS v4u*)(d.dst + (size_t)q * d.K) = o; }
        return; }
#pragma unroll
    for (int q = 0; q < 4; ++q) { v4u o; o.x = P0_PK(v[0][q] * ga[0], v[1][q] * ga[1]); o.y = P0_PK(v[2][q] * ga[2], v[3][q] * ga[3]); o.z = P0_PK(v[4][q] * gb[0], v[5][q] * gb[1]); o.w = P0_PK(v[6][q] * gb[2], v[7][q] * gb[3]);
        if (NT) __builtin_nontemporal_store(o, (GAS v4u*)(d.dst + (size_t)q * d.K)); else *(GAS v4u*)(d.dst + (size_t)q * d.K) = o; }
}
struct Inputs { const float* x; const int* pos; const float *attn_norm_g, *attn_w_in, *attn_q_g, *attn_k_g, *attn_w_out, *conv_norm_g, *conv_w_in, *conv_w, *conv_w_out, *mlp_norm_g, *mlp_w1, *mlp_w2; };
constexpr int I_A1 = (DM / 64) * (NA1 / 32), I_SQ = (DM / 64) * (DM / 32), I_C1 = (DM / 64) * (NC1 / 32), I_M1 = (DM / 64) * (DFF / 32), I_M2 = (DFF / 64) * (DM / 32);
constexpr int PER_J = I_A1 + I_SQ + I_C1 + I_SQ, PER_I = I_M1 + I_M2, NITEMS = 2 * PER_J + 4 * PER_I;
__device__ __forceinline__ void p0_item_desc(Frame& F, const Inputs& I, int it, P0Desc& d, int lane_ = -1) {
    int r = it; const int ln_ = lane_ >= 0 ? lane_ : F.lane;
    if (r < 2 * PER_J) { const int j = r / PER_J; r -= j * PER_J;
        if (r < I_A1) { p0_desc(I.attn_w_in + (size_t)j * DM * NA1_SRC, I.attn_norm_g + j * DM, DM, NA1_SRC, NA1, 1, (bf16*)(F.ws + WS_WA1 + j * SZ_WA1), r, ln_, d); return; } r -= I_A1;
        if (r < I_SQ) { p0_desc(I.attn_w_out + (size_t)j * DM * DM, nullptr, DM, DM, DM, 0, (bf16*)(F.ws + WS_WA4 + j * SZ_WSQ), r, ln_, d); return; } r -= I_SQ;
        if (r < I_C1) { p0_desc(I.conv_w_in + (size_t)j * DM * NC1, I.conv_norm_g + j * DM, DM, NC1, NC1, 2, (bf16*)(F.ws + WS_WC1 + j * SZ_WC1), r, ln_, d, ((C1_FP8 >> (2 * j + 1)) & 1) ? 2 : 0); return; } r -= I_C1;
        p0_desc(I.conv_w_out + (size_t)j * DM * DM, nullptr, DM, DM, DM, 0, (bf16*)(F.ws + WS_WC2 + j * SZ_WSQ), r, ln_, d, ((C2_FP8 >> (2 * j + 1)) & 1) ? 2 : 0); return; }
    r -= 2 * PER_J; const int i = r / PER_I; r -= i * PER_I;
    if (r < I_M1) { p0_desc(I.mlp_w1 + (size_t)i * DM * DFF, I.mlp_norm_g + i * DM, DM, DFF, DFF, 0, (bf16*)(F.ws + WS_WM1 + i * SZ_WM), r, ln_, d, ((M1_FP8 >> i) & 1) ? 2 : 0); return; } r -= I_M1;
    p0_desc(I.mlp_w2 + (size_t)i * DFF * DM, nullptr, DFF, DM, DM, 0, (bf16*)(F.ws + WS_WM2 + i * SZ_WM), r, ln_, d, (MLP_FP8 >> i) & 1);
}
struct ItemRanges { int lo[4], hi[4]; };
__device__ __forceinline__ int range_item(const ItemRanges& R, int c) {
#pragma unroll
    for (int k = 0; k < 4; ++k) { const int len = R.hi[k] - R.lo[k]; if (c < len) return R.lo[k] + c; c -= len; }
    return -1;
}
__device__ __forceinline__ void convert_ranges(Frame& F, const Inputs& I, const ItemRanges& R, int gw, int nw) {
    const int total = (R.hi[0] - R.lo[0]) + (R.hi[1] - R.lo[1]) + (R.hi[2] - R.lo[2]) + (R.hi[3] - R.lo[3]);
    f32x4 va[8], vb[8], gaa, gab, gba, gbb; P0Desc da, db;
    int c = gw; bool ha = c < total;
    if (ha) { p0_item_desc(F, I, range_item(R, c), da); p0_load(da, va, gaa, gab); }
    while (ha) {
        const int cn = c + nw; const bool hb = cn < total;
        if (hb) { p0_item_desc(F, I, range_item(R, cn), db); p0_load(db, vb, gba, gbb); }
        p0_store(da, va, gaa, gab);
        c = cn; ha = hb; da = db; gaa = gba; gab = gbb;
#pragma unroll
        for (int i = 0; i < 8; ++i) va[i] = vb[i];
    }
}
#ifndef DEFER_CONV
#define DEFER_CONV 2
#endif
#ifndef A2_EARLY
#define A2_EARLY 1
#endif
#ifndef A2_NT_STORE
#define A2_NT_STORE 0
#endif
#ifndef A2_STORE_MID
#define A2_STORE_MID 0
#endif
#ifndef A2_NOASSERT
#define A2_NOASSERT 0
#endif
#ifndef A2_NCV
#define A2_NCV 2
#endif
#ifndef A2_SPLIT
#define A2_SPLIT 4096
#endif
__device__ __forceinline__ const float* in_ptr(const unsigned char* ws, const int field) {
    unsigned long long p_; asm volatile("s_load_dwordx2 %0, %1, %2\n\ts_waitcnt lgkmcnt(0)" : "=s"(p_) : "s"(ws + WS_INPTR), "n"(field * 8) : "memory"); return (const float*)p_; }
__device__ __forceinline__ void a2_item_desc(Frame& F, int j, int c, int lane, P0Desc& d) {
    if (c < I_SQ) { p0_desc(in_ptr(F.ws, 6) + (size_t)j * DM * DM, nullptr, DM, DM, DM, 0, (bf16*)(F.ws + WS_WA4 + j * SZ_WSQ), c, lane, d); return; }
    c -= I_SQ; int i = 2 * j;
    if (c >= PER_I) { c += A2_SPLIT - PER_I; i += 1; }
    if (c < I_M1) { p0_desc(in_ptr(F.ws, 12) + (size_t)i * DM * DFF, in_ptr(F.ws, 11) + i * DM, DM, DFF, DFF, 0, (bf16*)(F.ws + WS_WM1 + (size_t)i * SZ_WM), c, lane, d, ((M1_FP8 >> i) & 1) ? 2 : 0); return; }
    c -= I_M1;
    p0_desc(in_ptr(F.ws, 13) + (size_t)i * DFF * DM, nullptr, DFF, DM, DM, 0, (bf16*)(F.ws + WS_WM2 + (size_t)i * SZ_WM), c, lane, d, (MLP_FP8 >> i) & 1);
}
__device__ __forceinline__ ItemRanges ranges_a2(int j) {
    return ItemRanges{{j * PER_J + I_A1, 2 * PER_J + 2 * j * PER_I, 2 * PER_J + (2 * j + 1) * PER_I + A2_SPLIT, 0}, {j * PER_J + I_A1 + I_SQ, 2 * PER_J + (2 * j + 1) * PER_I, 2 * PER_J + (2 * j + 2) * PER_I, 0}}; }
constexpr int A2_ITEMS = I_SQ + PER_I + (PER_I - A2_SPLIT);
__device__ __forceinline__ ItemRanges ranges_p0() { if (DEFER_CONV == 2) return ItemRanges{{0, PER_J, 0, 0}, {I_A1, PER_J + I_A1, 0, 0}};
    if (DEFER_CONV) return ItemRanges{{0, PER_J, 2 * PER_J, 2 * PER_J + 2 * PER_I}, {I_A1 + I_SQ, PER_J + I_A1 + I_SQ, 2 * PER_J + PER_I, 2 * PER_J + 3 * PER_I}}; return ItemRanges{{0, 0, 0, 0}, {NITEMS, 0, 0, 0}}; }
__device__ __forceinline__ ItemRanges ranges_deferred(int j) {
    if (DEFER_CONV == 2) return ItemRanges{{j * PER_J + I_A1 + I_SQ, 2 * PER_J + (2 * j + 1) * PER_I, 0, 0}, {(j + 1) * PER_J, 2 * PER_J + (2 * j + 1) * PER_I + A2_SPLIT, 0, 0}};
    return ItemRanges{{j * PER_J + I_A1 + I_SQ, 2 * PER_J + (2 * j + 1) * PER_I, 0, 0}, {(j + 1) * PER_J, 2 * PER_J + (2 * j + 2) * PER_I, 0, 0}}; }
__device__ __forceinline__ void p0_prologue(Frame& F, const Inputs& I, float* out) {
    const int gw = F.vcu * NWAVES + F.wave, NGW = F.G * NWAVES;
    if (blockIdx.x == 0 && F.tid == 0) {
        Inputs* d_ = (Inputs*)(F.ws + WS_INPTR);
        d_->x = I.x; d_->pos = I.pos; d_->attn_norm_g = I.attn_norm_g; d_->attn_w_in = I.attn_w_in; d_->attn_q_g = I.attn_q_g; d_->attn_k_g = I.attn_k_g; d_->attn_w_out = I.attn_w_out;
        d_->conv_norm_g = I.conv_norm_g; d_->conv_w_in = I.conv_w_in; d_->conv_w = I.conv_w; d_->conv_w_out = I.conv_w_out; d_->mlp_norm_g = I.mlp_norm_g; d_->mlp_w1 = I.mlp_w1; d_->mlp_w2 = I.mlp_w2; }
    P0T_BEGIN(2);
    bf16* xb = (bf16*)(F.ws + WS_XB); pg8::ssq_t* ssq0 = (pg8::ssq_t*)(F.ws + WS_SSQ);
    {
        f32x4 va[8], vb[8]; int m = gw; bool ha = m < M;
        if (ha) { const GAS f32x4* xr = (const GAS f32x4*)(I.x + (size_t)m * DM) + F.lane;
#pragma unroll
            for (int j = 0; j < 8; ++j) va[j] = __builtin_nontemporal_load(xr + 64 * j); }
        while (ha) {
            const int mn = m + NGW; const bool hb = mn < M;
            if (hb) { const GAS f32x4* xr = (const GAS f32x4*)(I.x + (size_t)mn * DM) + F.lane;
#pragma unroll
                for (int j = 0; j < 8; ++j) vb[j] = __builtin_nontemporal_load(xr + 64 * j); }
            GAS unsigned long long* o8 = (GAS unsigned long long*)(xb + (size_t)m * DM) + F.lane; float s = 0.f;
#pragma unroll
            for (int j = 0; j < 8; ++j) { const f32x4 v = va[j]; s += (v.x * v.x + v.y * v.y) + (v.z * v.z + v.w * v.w);
                o8[64 * j] = (unsigned long long)pk2(v.x, v.y) | ((unsigned long long)pk2(v.z, v.w) << 32); }
            s = wave_sum(s); if (F.lane == 0) ssq0[m] = pg8::ssq_fix(s);
            m = mn; ha = hb;
#pragma unroll
            for (int j = 0; j < 8; ++j) va[j] = vb[j];
        }
    }
    P0T_END(2); P0T_BEGIN(3);
    unsigned* ropeM = (unsigned*)(F.ws + WS_ROPEM); unsigned* ropeI = (unsigned*)(F.ws + WS_ROPEI);
    for (int e = F.vcu * 512 + F.tid; e < M * 24; e += F.G * 512) {
        const int row = e / 24, d = e % 24; const float p = (float)I.pos[row];
        const float ex = d < 16 ? -(float)d * (1.0f / 16.0f) : -(float)(d - 16) * (1.0f / 8.0f);
        const float inv = __builtin_amdgcn_exp2f(ex * 18.931568569324174f);
        const float ang = p * inv;
        double rev = (double)ang * 0.15915494309189535; rev -= __builtin_floor(rev); const float rf = (float)rev;
        const float c = __builtin_amdgcn_cosf(rf), s = __builtin_amdgcn_sinf(rf);
        const unsigned pk = (unsigned)__builtin_bit_cast(unsigned short, (_Float16)c) | ((unsigned)__builtin_bit_cast(unsigned short, (_Float16)s) << 16);
        if (d < 16) ropeM[(size_t)row * 16 + d] = pk; else ropeI[(size_t)row * 8 + (d - 16)] = pk;
    }
    { float* qg = (float*)(F.ws + WS_QG); float* kg = (float*)(F.ws + WS_KG); float* cw = (float*)(F.ws + WS_CONVW);
      for (int e = F.vcu * 512 + F.tid; e < 2 * 3 * DM; e += F.G * 512) { cw[e] = I.conv_w[e]; if (e < 256) { qg[e] = I.attn_q_g[e]; kg[e] = I.attn_k_g[e]; } } }
    P0T_END(3); P0T_BEGIN(1);
    convert_ranges(F, I, ranges_p0(), gw, NGW);
    P0T_END(1);
    (void)out;
}

__device__ __forceinline__ float relu_i(float x) { const int i = __float_as_int(x); return __int_as_float(i > 0 ? i : 0); }
struct IdxTensors { const bf16* QI; const bf16* KI; const float* WI; unsigned long long* MASK; float* dbg; };
#define DBG_OUT T.dbg
__device__ __forceinline__ void idx_phase(Frame& F, const IdxTensors& T, const int cj) {
    static_assert(DEFER_CONV != 2 || A2_NOASSERT || A2_ITEMS <= A2_NCV * 2048 * NWAVES, "the indexer's conversion slots do not cover its items");
    typedef float f32x2 __attribute__((ext_vector_type(2)));
    LAS float* scores = (LAS float*)(F.lds + RING_OFF);
    LAS unsigned* hist = (LAS unsigned*)(F.lds + AUX_OFF) + F.wave * 512;
    LAS float* cand = (LAS float*)(F.lds + AUX_OFF + 16384) + F.wave * 64;
    LAS float* mm = (LAS float*)(F.lds + AUX_OFF + 16384 + 2048);
    int tid_ = threadIdx.x; asm volatile("" : "+v"(tid_));
    const int lane = tid_ & 63, w = F.wave, c32 = lane & 31, hi = lane >> 5;
    const float INF = __builtin_inff();
    const int qsel = (c32 >> 2) & 1, hh = (c32 & 3) + 4 * (c32 >> 3);
    bf16x8 afr[4][4]; bf16x8 bcur[4];
#define IDX_DECODE(uu_, b_, t0_) const int idx_ = (uu_) & 255, rr_ = (uu_) >> 8; b_ = rr_ >> 1; t0_ = ((rr_ & 1) ? 511 - idx_ : idx_) * 8
#define IDX_LOAD(b_, t0_) do { \
        const bf16* qrow_ = T.QI + ((size_t)((b_) * SEQ + (t0_) + qsel) * 16 + hh) * 64 + 8 * hi; \
        _Pragma("unroll") for (int p = 0; p < 4; ++p) _Pragma("unroll") for (int kk = 0; kk < 4; ++kk) afr[p][kk] = *(const bf16x8*)(qrow_ + (size_t)p * 2 * 1024 + 16 * kk); \
        const int nt_ = ((t0_) + 7) / 32 + 1; const int j0_ = w < nt_ ? w : 0; \
        const bf16* kb_ = T.KI + (size_t)(b_) * SEQ * 64 + (size_t)c32 * 64 + 8 * hi + (size_t)j0_ * 32 * 64; \
        _Pragma("unroll") for (int kk = 0; kk < 4; ++kk) bcur[kk] = *(const bf16x8*)(kb_ + 16 * kk); } while (0)
    int uu = blockIdx.x; int b = 0, t0 = 0;
    if (uu < 2048) { IDX_DECODE(uu, b, t0); if (tid_ < 128) ((LAS float*)(F.lds + WQ_OFF))[tid_] = T.WI[(size_t)(b * SEQ + t0) * 16 + tid_]; IDX_LOAD(b, t0); }
    LDS_WAIT(); __syncthreads();
    for (; uu < 2048; uu += F.G) {
        { IDXT_BEGIN(1);
        for (int srep = 0; srep < 1 + DBG_IDX_REP_SCORE; ++srep) {
            f32x2 wq[4][8];
            { const LAS float* wrow = (const LAS float*)(F.lds + WQ_OFF) + hi * 16;
#pragma unroll
              for (int p = 0; p < 4; ++p)
#pragma unroll
                  for (int i = 0; i < 4; ++i) { const f32x4 t4 = *(const LAS f32x4*)(wrow + p * 32 + 4 * i); wq[p][2 * i] = (f32x2){t4[0], t4[1]}; wq[p][2 * i + 1] = (f32x2){t4[2], t4[3]}; } }
            const int ntile = (t0 + 7) / 32 + 1;
            const bf16* kbase = T.KI + (size_t)b * SEQ * 64 + (size_t)c32 * 64 + 8 * hi;
            LAS float* srow = scores + hi * 4096 + c32;
            float vmax[4], vmin[4];
#pragma unroll
            for (int p = 0; p < 4; ++p) { vmax[p] = -INF; vmin[p] = INF; }
            bf16x8 bnxt[4];
            for (int jt = w; jt < ntile; jt += 8) {
                const int jn = jt + 8 < ntile ? jt + 8 : jt;
#pragma unroll
                for (int kk = 0; kk < 4; ++kk) bnxt[kk] = *(const bf16x8*)(kbase + (size_t)jn * 32 * 64 + 16 * kk);
                const int krel = jt * 32 + c32 - t0 - hi;
#pragma unroll
                for (int ph = 0; ph < 2; ++ph) {
                    f32x16 acc0 = {}, acc1 = {};
#pragma unroll
                    for (int kk = 0; kk < 4; ++kk) { acc0 = __builtin_amdgcn_mfma_f32_32x32x16_bf16(afr[2 * ph][kk], bcur[kk], acc0, 0, 0, 0);
                                                     acc1 = __builtin_amdgcn_mfma_f32_32x32x16_bf16(afr[2 * ph + 1][kk], bcur[kk], acc1, 0, 0, 0); }
#pragma unroll
                    for (int q = 0; q < 2; ++q) { const int p = 2 * ph + q; const f32x16& acc = q ? acc1 : acc0;
                        f32x2 s2 = {0.f, 0.f};
#pragma unroll
                        for (int r = 0; r < 8; ++r) { f32x2 a2 = {relu_i(acc[2 * r]), relu_i(acc[2 * r + 1])}; s2 = __builtin_elementwise_fma(wq[p][r], a2, s2); }
                        const bool valid = krel <= 2 * p;
                        const float s = valid ? s2[0] + s2[1] : -INF;
                        vmax[p] = fmaxf(vmax[p], s); vmin[p] = fminf(vmin[p], valid ? s : INF);
                        srow[p * 2 * 4096 + jt * 32] = s; }
                }
#pragma unroll
                for (int kk = 0; kk < 4; ++kk) bcur[kk] = bnxt[kk];
            }
#pragma unroll
            for (int o = 1; o < 32; o <<= 1)
#pragma unroll
                for (int p = 0; p < 4; ++p) { vmax[p] = fmaxf(vmax[p], __shfl_xor(vmax[p], o)); vmin[p] = fminf(vmin[p], __shfl_xor(vmin[p], o)); }
            if (c32 == 0) {
#pragma unroll
                for (int p = 0; p < 4; ++p) { mm[(w * 8 + 2 * p + hi) * 2] = vmin[p]; mm[(w * 8 + 2 * p + hi) * 2 + 1] = vmax[p]; } }
        }
        IDXT_END(1); }
        const int b_cur = b, t0_cur = t0;
        float wpre = 0.f; const bool has_next = uu + F.G < 2048;
        if (has_next) { IDX_DECODE(uu + F.G, b, t0); if (tid_ < 128) wpre = T.WI[(size_t)(b * SEQ + t0) * 16 + tid_]; IDX_LOAD(b, t0); }
        IDXT_BEGIN(5);
        P0Desc cd[A2_NCV] = {}; f32x4 cv[A2_NCV][8] = {}, cga[A2_NCV] = {}, cgb[A2_NCV] = {}; bool ch[A2_NCV];
#define CONV_ISSUE(k) do { const int c_ = uu * NWAVES + w + (k) * 2048 * NWAVES; ch[k] = DEFER_CONV == 2 && c_ < A2_ITEMS; \
            if (ch[k]) { int ln = lane; asm volatile("" : "+v"(ln)); a2_item_desc(F, cj, c_, ln, cd[k]); p0_load_nn(cd[k], cv[k], cga[k], cgb[k]); } } while (0)
#pragma unroll
        for (int k = 0; k < A2_NCV; ++k) { ch[k] = false; if (k < A2_EARLY) CONV_ISSUE(k); }
        bool cissued = A2_EARLY >= A2_NCV;
#define CONV_ISSUE_LATE() do { if (!cissued) { _Pragma("unroll") for (int k_ = A2_EARLY; k_ < A2_NCV; ++k_) CONV_ISSUE(k_); cissued = true; } } while (0)
        IDXT_END(5);
        { IDXT_BEGIN(3); LDS_WAIT(); __builtin_amdgcn_s_barrier(); asm volatile("" ::: "memory"); IDXT_END(3); }
        bool cdone = false;
#define CONV_STORE() do { if (!cdone) { _Pragma("unroll") for (int k_ = 0; k_ < A2_NCV; ++k_) if (ch[k_]) p0_store<A2_NT_STORE != 0>(cd[k_], cv[k_], cga[k_], cgb[k_]); cdone = true; } } while (0)
        { IDXT_BEGIN(2);
        for (int lrep = 0; lrep < 1 + DBG_IDX_REP_SEL; ++lrep) {
            const int t = t0_cur + w, n = t + 1;
            const LAS float* sc = scores + w * 4096;
            const int nch = (n + 63) >> 6;
            unsigned long long myword = 0ull;
            if (n <= TOPK) {
#pragma unroll 4
                for (int j = 0; j < nch; ++j) { const int i = 64 * j + lane; const unsigned long long mk = __ballot(i < n); if (lane == j) myword = mk; }
            } else {
                float lo = INF, hv = -INF;
#pragma unroll
                for (int k = 0; k < 8; ++k) { lo = fminf(lo, mm[(k * 8 + w) * 2]); hv = fmaxf(hv, mm[(k * 8 + w) * 2 + 1]); }
                int need = TOPK; bool done = false;
                for (int level = 0; level < 6 && !done; ++level) {
                    if (!(hv > lo)) break;
                    const float scale = fminf(511.9f / (hv - lo), 3.0e37f), off = -lo * scale;
#pragma unroll
                    for (int k = 0; k < 8; ++k) hist[k * 64 + lane] = 0u;
                    LDS_WAIT();
                    for (int j0 = 0; j0 < nch; j0 += 8) {
                        float vb[8];
#pragma unroll
                        for (int k = 0; k < 8; ++k) vb[k] = sc[64 * ((j0 + k) & 63) + lane];
#pragma unroll
                        for (int k = 0; k < 8; ++k) { const int i = 64 * (j0 + k) + lane; const float v = vb[k];
                            if (i < n && v >= lo && v <= hv) { int bin = (int)fmaf(v, scale, off); bin = bin > 511 ? 511 : bin; __hip_atomic_fetch_add(hist + bin, 1u, __ATOMIC_RELAXED, __HIP_MEMORY_SCOPE_WORKGROUP); } } }
                    if (A2_STORE_MID) CONV_STORE();
                    CONV_ISSUE_LATE();
                    LDS_WAIT();
                    unsigned h[8]; unsigned ssum = 0;
                    { const v4u a = *(const LAS v4u*)(hist + 8 * lane), bq = *(const LAS v4u*)(hist + 8 * lane + 4); h[0] = a.x; h[1] = a.y; h[2] = a.z; h[3] = a.w; h[4] = bq.x; h[5] = bq.y; h[6] = bq.z; h[7] = bq.w; }
#pragma unroll
                    for (int k = 0; k < 8; ++k) ssum += h[k];
                    unsigned S = ssum;
#pragma unroll
                    for (int o = 1; o < 64; o <<= 1) { const unsigned tt = __shfl_down(S, o); if (lane + o < 64) S += tt; }
                    const unsigned long long bal = __ballot(S >= (unsigned)need);
                    const int L = __popcll(bal) - 1;
                    const int Lc = L < 0 ? 0 : L;
                    unsigned cum = (Lc < 63) ? (unsigned)__shfl(S, Lc + 1) : 0u; if (Lc >= 63) cum = 0u;
                    int bstar = 8 * Lc; unsigned cstar = 0, abv = cum; bool found = false;
#pragma unroll
                    for (int k = 7; k >= 0; --k) { const unsigned hk = (unsigned)__shfl(h[k], Lc);
                        if (!found && cum + hk >= (unsigned)need) { bstar = 8 * Lc + k; cstar = hk; abv = cum; found = true; }
                        cum += hk; }
                    need -= (int)abv;
                    float nlo = INF, nhv = -INF; int base = 0; const bool few = cstar <= 64u;
                    for (int j0 = 0; j0 < nch; j0 += 8) {
                        float vb[8];
#pragma unroll
                        for (int k = 0; k < 8; ++k) vb[k] = sc[64 * ((j0 + k) & 63) + lane];
#pragma unroll
                        for (int k = 0; k < 8; ++k) { const int j = j0 + k, i = 64 * j + lane; const float v = vb[k]; const bool valid = i < n;
                            int bin = (int)fmaf(v, scale, off); bin = bin > 511 ? 511 : bin;
                            const bool member = valid && v >= lo && v <= hv, inb = member && bin == bstar, sure = valid && (v > hv || (member && bin > bstar));
                            const unsigned long long ms = __ballot(sure); if (lane == j) myword = ms;
                            if (inb) { nlo = fminf(nlo, v); nhv = fmaxf(nhv, v); }
                            if (few) { const unsigned long long mk = __ballot(inb);
                                if (inb) { const int pos = base + __popcll(mk & ((1ull << lane) - 1ull)); if (pos < 64) { cand[pos] = v; ((LAS int*)hist)[pos] = i; } }
                                base += __popcll(mk); } } }
                    if (few) {
                        LDS_WAIT();
                        const int nc = base < 64 ? base : 64;
                        const float myv = lane < nc ? cand[lane] : -INF; const int myi = lane < nc ? ((const LAS int*)hist)[lane] : 0; int cnt = 0;
                        for (int i = 0; i < nc; ++i) cnt += (__shfl(myv, i) > myv) ? 1 : 0;
                        unsigned long long msel = __ballot(lane < nc && cnt < need);
                        while (msel) { const int src = __builtin_ctzll(msel); msel &= msel - 1ull; const int ki = __shfl(myi, src);
                            if (lane == (ki >> 6)) myword |= 1ull << (ki & 63); }
                        done = true;
                    } else { lo = wave_min(nlo); hv = wave_max(nhv); }
                }
                if (!done) {
#pragma unroll 4
                    for (int j = 0; j < nch; ++j) { const int i = 64 * j + lane; const float v = sc[i]; const unsigned long long mk = __ballot(i < n && v >= lo); if (lane == j) myword = mk; }
                }
            }
            const int nwords = ((t | 255) + 1) >> 6;
            if (lane < nwords) T.MASK[((size_t)b_cur * 64 + lane) * SEQ + t] = myword;
        }
        IDXT_END(2); }
        CONV_ISSUE_LATE();
        { IDXT_BEGIN(6); CONV_STORE(); IDXT_END(6); }
#undef CONV_STORE
#undef CONV_ISSUE
#undef CONV_ISSUE_LATE
        if (has_next && tid_ < 128) ((LAS float*)(F.lds + WQ_OFF))[tid_] = wpre;
        { IDXT_BEGIN(4); LDS_WAIT(); __builtin_amdgcn_s_barrier(); asm volatile("" ::: "memory"); IDXT_END(4); }
    }
#undef IDX_DECODE
#undef IDX_LOAD
}

template <bool FP8OUT> __device__ __forceinline__ void conv_phase(Frame& F, const bf16* Bg, const bf16* Z, const float* cw, bf16* Gout) {
    const int nunit = (M / 32) * 4;
    for (int uu = (blockIdx.x * NWAVES + F.wave); uu < nunit; uu += F.G * NWAVES) {
        const int run = uu >> 2, cb = (uu & 3) * 512 + F.lane * 8, r0 = run * 32;
        float w0[8], w1[8], w2[8];
#pragma unroll
        for (int j = 0; j < 8; ++j) { w0[j] = cw[cb + j]; w1[j] = cw[DM + cb + j]; w2[j] = cw[2 * DM + cb + j]; }
        float zm2[8], zm1[8];
        const bool first = (r0 % SEQ) == 0;
        { v4u a = {0, 0, 0, 0}, bq = {0, 0, 0, 0};
          if (!first) { a = *(const v4u*)(Z + (size_t)(r0 - 2) * DM + cb); bq = *(const v4u*)(Z + (size_t)(r0 - 1) * DM + cb); }
          const unsigned aw[4] = {a.x, a.y, a.z, a.w}, bw[4] = {bq.x, bq.y, bq.z, bq.w};
#pragma unroll
          for (int j = 0; j < 4; ++j) { zm2[2 * j] = __uint_as_float(aw[j] << 16); zm2[2 * j + 1] = __uint_as_float(aw[j] & 0xffff0000u); zm1[2 * j] = __uint_as_float(bw[j] << 16); zm1[2 * j + 1] = __uint_as_float(bw[j] & 0xffff0000u); } }
#pragma unroll 4
        for (int r = 0; r < 32; ++r) {
            const v4u zz = *(const v4u*)(Z + (size_t)(r0 + r) * DM + cb), bb = *(const v4u*)(Bg + (size_t)(r0 + r) * DM + cb);
            const unsigned zw[4] = {zz.x, zz.y, zz.z, zz.w}, bw[4] = {bb.x, bb.y, bb.z, bb.w};
            float z0[8], o[8];
#pragma unroll
            for (int j = 0; j < 4; ++j) { z0[2 * j] = __uint_as_float(zw[j] << 16); z0[2 * j + 1] = __uint_as_float(zw[j] & 0xffff0000u); }
#pragma unroll
            for (int j = 0; j < 8; ++j) { const float bv = (j & 1) ? __uint_as_float(bw[j >> 1] & 0xffff0000u) : __uint_as_float(bw[j >> 1] << 16);
                o[j] = bv * (w0[j] * zm2[j] + w1[j] * zm1[j] + w2[j] * z0[j]); zm2[j] = zm1[j]; zm1[j] = z0[j]; }
            if (FP8OUT) {
#pragma unroll
                for (int j = 0; j < 8; ++j) o[j] = fminf(fmaxf(o[j] * pg8::FP8_SG, -448.f), 448.f);
                int w0 = 0, w1 = 0; w0 = __builtin_amdgcn_cvt_pk_fp8_f32(o[0], o[1], w0, false); w0 = __builtin_amdgcn_cvt_pk_fp8_f32(o[2], o[3], w0, true);
                w1 = __builtin_amdgcn_cvt_pk_fp8_f32(o[4], o[5], w1, false); w1 = __builtin_amdgcn_cvt_pk_fp8_f32(o[6], o[7], w1, true);
                v2u ov; ov.x = (unsigned)w0; ov.y = (unsigned)w1; *(v2u*)((unsigned char*)Gout + (size_t)(r0 + r) * DM + cb) = ov;
            } else {
            v4u ov; ov.x = pk2(o[0], o[1]); ov.y = pk2(o[2], o[3]); ov.z = pk2(o[4], o[5]); ov.w = pk2(o[6], o[7]);
            *(v4u*)(Gout + (size_t)(r0 + r) * DM + cb) = ov; }
        }
    }
}

#ifndef PH_P0
#define PH_P0 1
#endif
#ifndef PH_A1
#define PH_A1 1
#endif
#ifndef PH_A2
#define PH_A2 1
#endif
#ifndef PH_A3
#define PH_A3 1
#endif
#ifndef PH_A4
#define PH_A4 1
#endif
#ifndef PH_C1
#define PH_C1 1
#endif
#ifndef PH_C1B
#define PH_C1B 1
#endif
#ifndef PH_C2
#define PH_C2 1
#endif
#ifndef PH_M1
#define PH_M1 1
#endif
#ifndef PH_M2
#define PH_M2 1
#endif
struct Args { Inputs in; float* out; unsigned char* ws; int ph_lo, ph_hi; };
#ifndef DBG_REP_LAYER
#define DBG_REP_LAYER -1
#endif
#ifndef DBG_REP_P0
#define DBG_REP_P0 0
#endif
#ifndef DBG_REP_A1
#define DBG_REP_A1 0
#endif
#ifndef DBG_REP_A2
#define DBG_REP_A2 0
#endif
#ifndef DBG_REP_A3
#define DBG_REP_A3 0
#endif
#ifndef DBG_REP_A4
#define DBG_REP_A4 0
#endif
#ifndef DBG_REP_C1
#define DBG_REP_C1 0
#endif
#ifndef DBG_REP_C1B
#define DBG_REP_C1B 0
#endif
#ifndef DBG_REP_C2
#define DBG_REP_C2 0
#endif
#ifndef DBG_REP_M1
#define DBG_REP_M1 0
#endif
#ifndef DBG_REP_M2
#define DBG_REP_M2 0
#endif
constexpr size_t WS_DUMMY_OUT = WS_END + 32 * MiB, WS_DUMMY_XB = WS_END + 160 * MiB, WS_DUMMY_SSQ = WS_END + 224 * MiB;
#define REPEAT(n) _Pragma("unroll") for (int rep = 0, nrep = ((li == DBG_REP_LAYER) ? 1 + (n) : 1); rep < nrep; ++rep)
#define REPBAR do { if (rep) { if (!MK_PER_PHASE) xcd_barrier(bar); } } while (0)
#define IN(k) (lo <= (k) && (k) < hi)
#define SEAM(k) do { if (IN(k) && IN((k) + 1)) { if (!MK_PER_PHASE) xcd_barrier(bar); } } while (0)
template <int li> __device__ __forceinline__ void layer_body(Frame& F, const Args& args, const XcdBarrier& bar, const int lo, const int hi, unsigned char* lds) {
    const Inputs& I = args.in; unsigned char* ws = args.ws;
    bf16* const XB = (bf16*)(ws + WS_XB); pg8::ssq_t* const SSQ = (pg8::ssq_t*)(ws + WS_SSQ);
    const unsigned* const ropeM = (const unsigned*)(ws + WS_ROPEM); const unsigned* const ropeI = (const unsigned*)(ws + WS_ROPEI);

        const int j = li >> 1, pb = 1 + 6 * li;
        if ((li & 1) == 0) {
            STAMP(pb + 0);
            if (PH_A1 && IN(pb + 0)) REPEAT(DBG_REP_A1) { REPBAR;
                pg8::Gemm g{XB, (const bf16*)(ws + WS_WA1 + j * SZ_WA1), M, NA1, DM}; pg8::StaticOrder S; S.init(M, NA1, F.G, (int)blockIdx.x);
                pg8::EpiA1 E{SSQ + (size_t)(2 * li) * M, (bf16*)(ws + WS_Q), (bf16*)(ws + WS_K), (bf16*)(ws + WS_V), (bf16*)(ws + WS_QI), (bf16*)(ws + WS_KI), (float*)(ws + WS_WI),
                             (const float*)(ws + WS_QG) + j * 128, (const float*)(ws + WS_KG) + j * 128, ropeM, ropeI, (PG8_LAS float*)(F.lds + AUX_OFF)};
                pg8::gemm_phase<pg8::EpiA1, pg8::StaticOrder, true, true>(F.lds + RING_OFF, g, S, E);
                if (DEFER_CONV) {
                    const bool part = F.G == 256; const int bx = (int)blockIdx.x;
                    if (!part || bx >= 64) { const Inputs Iw = *(const Inputs*)(ws + WS_INPTR);
                        convert_ranges(F, Iw, ranges_deferred(j), (part ? bx - 64 : bx) * NWAVES + F.wave, (part ? 192 : F.G) * NWAVES); } }
            } SEAM(pb + 0);
            STAMP(pb + 1);
            if (PH_A2 && IN(pb + 1)) REPEAT(DBG_REP_A2) { REPBAR; IdxTensors T{(const bf16*)(ws + WS_QI), (const bf16*)(ws + WS_KI), (const float*)(ws + WS_WI), (unsigned long long*)(ws + WS_MASK), args.out};
#if defined(DBG_DUMP)
                for (size_t e = (size_t)blockIdx.x * 512 + F.tid; e < (size_t)M * DM; e += (size_t)F.G * 512) { const int row = (int)(e / DM), c = (int)(e % DM); float v = 0.f;
                    if (c < 1024) v = bf2f(T.QI[(size_t)row * 1024 + c]); else if (c < 1088) v = bf2f(T.KI[(size_t)row * 64 + c - 1024]); else if (c < 1104) v = T.WI[(size_t)row * 16 + c - 1088];
                    args.out[e] = v; }
#else
                idx_phase(F, T, j);
#endif
                } SEAM(pb + 1);
            STAMP(pb + 2);
            if (PH_A3 && IN(pb + 2)) REPEAT(DBG_REP_A3) { REPBAR; const att::Tensors T{(const att::bf16*)(ws + WS_Q), (const att::bf16*)(ws + WS_K), (const att::bf16*)(ws + WS_V), (att::bf16*)(ws + WS_O), (const att::u64*)(ws + WS_MASK)};
                att::attn_phase((char*)lds + RING_OFF, T, (int)blockIdx.x, F.G); } SEAM(pb + 2);
            STAMP(pb + 3);
            if (PH_A4 && IN(pb + 3)) REPEAT(DBG_REP_A4) { REPBAR; const bool dummy = rep + 1 < nrep;
                pg8::Gemm g{(const bf16*)(ws + DBG_A4_SRC), (const bf16*)(ws + WS_WA4 + j * SZ_WSQ), M, DM, DM}; pg8::StaticOrder S; S.init(M, DM, F.G, (int)blockIdx.x);
                pg8::EpiRes<false, ((M1_FP8 >> li) & 1) != 0> E{XB, dummy ? (bf16*)(ws + WS_DUMMY_XB) : XB, nullptr, dummy ? (pg8::ssq_t*)(ws + WS_DUMMY_SSQ) : SSQ + (size_t)(2 * li + 1) * M, 1.0f, ws + WS_XB8};
                pg8::gemm_phase<pg8::EpiRes<false, ((M1_FP8 >> li) & 1) != 0>, pg8::StaticOrder, PG8_ALIGN_X, PG8_SP2_X>(F.lds + RING_OFF, g, S, E);
            } SEAM(pb + 3);
        } else {
            STAMP(pb + 0);
            if (PH_C1 && IN(pb + 0)) REPEAT(DBG_REP_C1) { REPBAR;
                constexpr bool c1f8 = ((C1_FP8 >> li) & 1) != 0;
                pg8::Gemm g{c1f8 ? (const bf16*)(ws + WS_XB8) : XB, (const bf16*)(ws + WS_WC1 + j * SZ_WC1), M, NC1, c1f8 ? DM / 2 : DM}; pg8::StaticOrder S; S.init(M, NC1, F.G, (int)blockIdx.x);
                pg8::EpiC1 E{(bf16*)(ws + WS_BG), (bf16*)(ws + WS_Z), SSQ + (size_t)(2 * li) * M, c1f8 ? 1.0f / (pg8::FP8_SX * pg8::FP8_SWI) : 1.0f};
                pg8::gemm_phase<pg8::EpiC1, pg8::StaticOrder, PG8_ALIGN_X, PG8_SP2_X, c1f8>(F.lds + RING_OFF, g, S, E);
            } SEAM(pb + 0);
            STAMP(pb + 1);
            if (PH_C1B && IN(pb + 1)) REPEAT(DBG_REP_C1B) { REPBAR; conv_phase<((C2_FP8 >> li) & 1) != 0>(F, (const bf16*)(ws + WS_BG), (const bf16*)(ws + WS_Z), (const float*)(ws + WS_CONVW) + (size_t)j * 3 * DM, (bf16*)(ws + WS_G)); } SEAM(pb + 1);
            STAMP(pb + 2);
            if (PH_C2 && IN(pb + 2)) REPEAT(DBG_REP_C2) { REPBAR; const bool dummy = rep + 1 < nrep;
                pg8::Gemm g{(const bf16*)(ws + WS_G), (const bf16*)(ws + WS_WC2 + j * SZ_WSQ), M, DM, ((C2_FP8 >> li) & 1) ? DM / 2 : DM}; pg8::StaticOrder S; S.init(M, DM, F.G, (int)blockIdx.x);
                pg8::EpiRes<false, ((M1_FP8 >> li) & 1) != 0> E{XB, dummy ? (bf16*)(ws + WS_DUMMY_XB) : XB, nullptr, dummy ? (pg8::ssq_t*)(ws + WS_DUMMY_SSQ) : SSQ + (size_t)(2 * li + 1) * M, ((C2_FP8 >> li) & 1) ? 1.0f / (pg8::FP8_SG * pg8::FP8_SWC) : 1.0f, ws + WS_XB8};
                pg8::gemm_phase<pg8::EpiRes<false, ((M1_FP8 >> li) & 1) != 0>, pg8::StaticOrder, PG8_ALIGN_X, PG8_SP2_X, ((C2_FP8 >> li) & 1) != 0>(F.lds + RING_OFF, g, S, E);
            } SEAM(pb + 2);
            STAMP(pb + 3);
        }
        STAMP(pb + 4);
        if (PH_M1 && IN(pb + 4)) REPEAT(DBG_REP_M1) { REPBAR;
            constexpr bool m1f8 = ((M1_FP8 >> li) & 1) != 0;
            pg8::Gemm g{m1f8 ? (const bf16*)(ws + WS_XB8) : XB, (const bf16*)(ws + WS_WM1 + li * SZ_WM), M, DFF, m1f8 ? DM / 2 : DM}; pg8::StaticOrder S; S.init(M, DFF, F.G, (int)blockIdx.x);
            pg8::EpiM1<((MLP_FP8 >> li) & 1) != 0> E{(bf16*)(ws + WS_H), SSQ + (size_t)(2 * li + 1) * M, m1f8 ? 1.0f / (pg8::FP8_SX * pg8::FP8_SWI) : 1.0f};
            pg8::gemm_phase<pg8::EpiM1<((MLP_FP8 >> li) & 1) != 0>, pg8::StaticOrder, PG8_ALIGN_X, PG8_SP2_X, m1f8>(F.lds + RING_OFF, g, S, E);
        } SEAM(pb + 4);
        STAMP(pb + 5);
        if (PH_M2 && IN(pb + 5)) REPEAT(DBG_REP_M2) { REPBAR; const bool dummy = rep + 1 < nrep;
            pg8::Gemm g{(const bf16*)(ws + WS_H), (const bf16*)(ws + WS_WM2 + li * SZ_WM), M, DM, ((MLP_FP8 >> li) & 1) ? DFF / 2 : DFF}; pg8::StaticOrder S; S.init(M, DM, F.G, (int)blockIdx.x);
            constexpr bool nx8 = li + 1 < DEPTH && ((C1_FP8 >> (li + 1)) & 1) != 0;
            pg8::EpiRes<li == DEPTH - 1, nx8> E{XB, dummy ? (bf16*)(ws + WS_DUMMY_XB) : XB, dummy ? (float*)(ws + WS_DUMMY_OUT) : args.out, dummy ? (pg8::ssq_t*)(ws + WS_DUMMY_SSQ) : SSQ + (size_t)(2 * li + 2) * M, ((MLP_FP8 >> li) & 1) ? 1.0f / (pg8::FP8_SA * pg8::FP8_SW) : 1.0f, ws + WS_XB8};
            pg8::gemm_phase<pg8::EpiRes<li == DEPTH - 1, nx8>, pg8::StaticOrder, PG8_ALIGN_X, (((MLP_FP8 >> li) & 1) ? PG8_SP2_F8 : PG8_SP2_X), ((MLP_FP8 >> li) & 1) != 0>(F.lds + RING_OFF, g, S, E);
        } SEAM(pb + 5);
    }
#undef IN
#undef SEAM
__global__ void __launch_bounds__(NWAVES * 64, 2) trunk_fwd(Args args) {
    extern __shared__ __attribute__((aligned(16))) unsigned char lds[];
    Frame F;
    F.lds = (LAS unsigned char*)lds;
    F.MISC = (volatile LAS unsigned*)(F.lds + MISC_OFF);
    F.tid = threadIdx.x; F.lane = F.tid & 63; F.wave = __builtin_amdgcn_readfirstlane(F.tid >> 6);
    F.G = gridDim.x; { const int bx = blockIdx.x; F.vcu = (F.G % 8 == 0) ? (bx % 8) * (F.G / 8) + bx / 8 : bx; }
    F.ws = args.ws; F.ctl = (gu32*)(args.ws + WS_CTL);
    for (int u = F.tid; u < 64; u += NWAVES * 64) ((LAS unsigned*)(F.lds + MISC_OFF))[u] = 0u;
    __syncthreads();
    XcdBarrier bar; bar.bar = (unsigned*)(F.ctl + CW_BAR); bar.x = 0; bar.st = nullptr;
    if (!MK_PER_PHASE) bar = xcd_barrier_post((unsigned*)(F.ctl + CW_BAR), F.MISC + 8);
    const int lo = args.ph_lo, hi = args.ph_hi;
    const Inputs& I = args.in;
    unsigned char* ws = args.ws;
#define IN(k) (lo <= (k) && (k) < hi)
#define SEAM(k) do { if (IN(k) && IN((k) + 1)) { if (!MK_PER_PHASE) xcd_barrier(bar); } } while (0)
    bf16* const XB = (bf16*)(ws + WS_XB);
    pg8::ssq_t* const SSQ = (pg8::ssq_t*)(ws + WS_SSQ);
    const unsigned* const ropeM = (const unsigned*)(ws + WS_ROPEM); const unsigned* const ropeI = (const unsigned*)(ws + WS_ROPEI);

    STAMP(0);
    if (PH_P0 && IN(0)) { for (int rep = 0; rep < 1 + DBG_REP_P0; ++rep) { if (rep) xcd_barrier(bar); p0_prologue(F, I, args.out); } } SEAM(0);

    layer_body<0>(F, args, bar, lo, hi, lds); layer_body<1>(F, args, bar, lo, hi, lds); layer_body<2>(F, args, bar, lo, hi, lds); layer_body<3>(F, args, bar, lo, hi, lds);
    STAMP(1 + 6 * DEPTH);
#if defined(DBG_EPI_TYPE)
    if (blockIdx.x == 0 && threadIdx.x == 0) { const unsigned long long dt = (unsigned long long)F.MISC[20] * 9ull, t0 = __builtin_amdgcn_s_memrealtime(); while (__builtin_amdgcn_s_memrealtime() - t0 < dt) __builtin_amdgcn_s_sleep(8); }
#endif
    if ((DBG_IDX_TIME > 0 || DBG_P0_TIME > 0) && blockIdx.x == 0 && threadIdx.x == 0) { const unsigned long long dt = (unsigned long long)F.MISC[20] * 9ull, t0 = __builtin_amdgcn_s_memrealtime(); while (__builtin_amdgcn_s_memrealtime() - t0 < dt) __builtin_amdgcn_s_sleep(8); }
    if (DBG_CLK_PHASE >= 0 && blockIdx.x == 0 && threadIdx.x == 0) {
        const unsigned long long c0 = (unsigned long long)F.MISC[32] | ((unsigned long long)F.MISC[33] << 32), r0 = (unsigned long long)F.MISC[34] | ((unsigned long long)F.MISC[35] << 32);
        const unsigned long long c1 = (unsigned long long)F.MISC[36] | ((unsigned long long)F.MISC[37] << 32), r1 = (unsigned long long)F.MISC[38] | ((unsigned long long)F.MISC[39] << 32);
        const unsigned long long dt = (r1 > r0) ? ((c1 - c0) * 1000ull) / (r1 - r0) : 0ull, t0 = __builtin_amdgcn_s_memrealtime(); while (__builtin_amdgcn_s_memrealtime() - t0 < dt) __builtin_amdgcn_s_sleep(8); }
    if (DBG_TIME_PHASE >= 0 && blockIdx.x == 0 && threadIdx.x == 0) { const unsigned long long tsA = (unsigned long long)F.MISC[16] | ((unsigned long long)F.MISC[17] << 32), tsB = (unsigned long long)F.MISC[18] | ((unsigned long long)F.MISC[19] << 32); const unsigned long long dt = (tsB - tsA) * 9ull, t0 = __builtin_amdgcn_s_memrealtime(); while (__builtin_amdgcn_s_memrealtime() - t0 < dt) __builtin_amdgcn_s_sleep(8); }
#undef IN
#undef SEAM
}

#ifndef DBG_NPH
#define DBG_NPH (1 + 6 * DEPTH)
#endif
constexpr int N_PHASES = DBG_NPH;
extern "C" void kernel_launch(void* const* d_in, const int* in_sizes, int n_in, void* d_out, int out_size, void* d_ws, size_t ws_size, hipStream_t stream) {
    static int grid = 0;
    if (grid == 0) {
        if (n_in != 14 || in_sizes[0] != M * DM || out_size != M * DM || ws_size < WS_END + 32 * MiB + (DBG_REP_LAYER >= 0 ? 232 * MiB : 0)) { fprintf(stderr, "kernel_launch: shape/workspace mismatch (n_in %d, in0 %d, out %d, ws %zu, need %zu)\n", n_in, n_in > 0 ? in_sizes[0] : -1, out_size, ws_size, (size_t)WS_END); grid = -1; return; }
        int dev = 0, cus = 0, per_cu = 0;
        if (hipGetDevice(&dev) != hipSuccess || hipDeviceGetAttribute(&cus, hipDeviceAttributeMultiprocessorCount, dev) != hipSuccess) { grid = -1; return; }
        if (hipFuncSetAttribute((const void*)trunk_fwd, hipFuncAttributeMaxDynamicSharedMemorySize, LDS_BYTES) != hipSuccess) { fprintf(stderr, "kernel_launch: hipFuncSetAttribute failed\n"); grid = -1; return; }
        if (hipOccupancyMaxActiveBlocksPerMultiprocessor(&per_cu, (const void*)trunk_fwd, NWAVES * 64, LDS_BYTES) != hipSuccess || per_cu < 1) fprintf(stderr, "kernel_launch: occupancy query reports %d\n", per_cu);
        (void)hipGetLastError();
        grid = cus;
    }
    if (grid < 0) return;
    if (hipMemsetAsync((char*)d_ws + WS_CTL, 0, CTL_ZERO_BYTES, stream) != hipSuccess) { fprintf(stderr, "kernel_launch: memset failed\n"); return; }
    Args a{};
    a.in.x = (const float*)d_in[0]; a.in.pos = (const int*)d_in[1]; a.in.attn_norm_g = (const float*)d_in[2]; a.in.attn_w_in = (const float*)d_in[3]; a.in.attn_q_g = (const float*)d_in[4];
    a.in.attn_k_g = (const float*)d_in[5]; a.in.attn_w_out = (const float*)d_in[6]; a.in.conv_norm_g = (const float*)d_in[7]; a.in.conv_w_in = (const float*)d_in[8]; a.in.conv_w = (const float*)d_in[9];
    a.in.conv_w_out = (const float*)d_in[10]; a.in.mlp_norm_g = (const float*)d_in[11]; a.in.mlp_w1 = (const float*)d_in[12]; a.in.mlp_w2 = (const float*)d_in[13];
    a.out = (float*)d_out; a.ws = (unsigned char*)d_ws;
#if MK_PER_PHASE
    for (int ph = 0; ph < N_PHASES; ++ph) {
        const int li = (ph - 1) / 6, k = (ph - 1) % 6;
        if (ph > 0 && (li & 1) == 1 && k == 3) continue;
        a.ph_lo = ph; a.ph_hi = ph + 1;
        hipLaunchKernelGGL(trunk_fwd, dim3(grid), dim3(NWAVES * 64), LDS_BYTES, stream, a);
    }
#else
    a.ph_lo = 0; a.ph_hi = N_PHASES;
    hipLaunchKernelGGL(trunk_fwd, dim3(grid), dim3(NWAVES * 64), LDS_BYTES, stream, a);
#endif
    const hipError_t le = hipPeekAtLastError();
    if (le != hipSuccess) fprintf(stderr, "kernel_launch: launch failed: %s\n", hipGetErrorName(le));
}
```

```cpp
#define MK_PER_PHASE 0
#include <hip/hip_runtime.h>
#include <cstdio>
#include <cstdint>
#ifndef PG8_WGM
#define PG8_WGM 4
#endif
namespace pg8 {
#define PG8_LAS __attribute__((address_space(3)))
typedef unsigned short bf16_t;
typedef short bf16x8 __attribute__((ext_vector_type(8)));
typedef float f32x4 __attribute__((ext_vector_type(4)));
typedef unsigned u32x4 __attribute__((ext_vector_type(4)));
constexpr int BM = 256, BK = 64, HALF = 128, HTB = HALF * BK * 2  , STAGE_BYTES = 8 * HTB, NXCD = 8, WGM = PG8_WGM;

__host__ __device__ __forceinline__ int lds_byte(int r, int c) { const int st = (r >> 4) * 2 + (c >> 5), rr = r & 15, cc = c & 31, ob = rr * 64 + cc * 2; return st * 1024 + (ob ^ (((ob >> 9) & 1) << 5)); }
__host__ __device__ __forceinline__ void stage_rc(int b, int& R, int& C) { const int st = b / 1024, sb = b % 1024, swz = sb ^ (((sb >> 9) & 1) << 5); R = (st >> 1) * 16 + swz / 64; C = (st & 1) * 32 + (swz % 64) / 2; }
__host__ __device__ __forceinline__ int perm32(int rho) { const int n = rho >> 4, i = rho & 15; return 8 * (i >> 2) + 4 * n + (i & 3); }

typedef int v8i_t __attribute__((ext_vector_type(8)));
typedef int v4i_t __attribute__((ext_vector_type(4)));
__device__ __forceinline__ v8i_t cat8(bf16x8 a, bf16x8 b) { const v4i_t x = __builtin_bit_cast(v4i_t, a), y = __builtin_bit_cast(v4i_t, b); return __builtin_shufflevector(x, y, 0, 1, 2, 3, 4, 5, 6, 7); }
struct Unit { int pm, pn; };
struct Gemm { const bf16_t* A; const bf16_t* Bt; int M, N, K; };

struct StaticOrder {
    int nM, nN, nwg, G, c;
    __host__ __device__ void init(int M, int N, int G_, int c_) { nM = M / BM; nN = N / BM; nwg = nM * nN; G = G_; c = c_; }
    __host__ __device__ bool next(int i, Unit& u) const {
        const long L = (long)i * G + c; if (L >= nwg) return false;
        int wgid = (int)L; { const int q = nwg / NXCD, r = nwg % NXCD, xcd = wgid % NXCD, off = wgid / NXCD; wgid = (xcd < r ? xcd * (q + 1) : r * (q + 1) + (xcd - r) * q) + off; }
        const int nig = WGM * nN, gid = wgid / nig, fm = gid * WGM, gsz = (nM - fm) < WGM ? (nM - fm) : WGM;
        u.pm = fm + ((wgid % nig) % gsz); u.pn = (wgid % nig) / gsz; return true;
    }
    __device__ __forceinline__ void a_ready(const Unit&) const {}
    __device__ __forceinline__ void done(const Unit&) const {}
};
__device__ __forceinline__ unsigned cvt_pk_bf16(float lo, float hi) { unsigned r; asm volatile("v_cvt_pk_bf16_f32 %0, %1, %2" : "=v"(r) : "v"(lo), "v"(hi)); return r; }
typedef unsigned u32x2 __attribute__((ext_vector_type(2)));
constexpr float RMS_EPS = 1e-6f;
typedef unsigned long long ssq_t;
__device__ __forceinline__ float rstd_of(ssq_t ssq) { return __builtin_amdgcn_rsqf((float)ssq * (1.0f / (2048.0f * 1048576.0f)) + RMS_EPS); }
__device__ __forceinline__ ssq_t ssq_fix(float s) { return (ssq_t)(s * 1048576.0f + 0.5f); }

constexpr float FP8_SX = 2.0f, FP8_SWI = 1024.0f;
template <bool FINAL, bool XB8 = false> struct EpiRes {
    static constexpr bool PERM = true, AFTER_DRAIN = false;
    const bf16_t* base; bf16_t* xb; float* out; ssq_t* ssq; float scale; unsigned char* xb8;
    __device__ __forceinline__ void operator()(const f32x4 (&acc)[2][2][4][2], const Unit& u, int wr, int wc, int fr, int fq) const {
        const int row0 = u.pm * BM + wr * 64 + fr, col0 = u.pn * BM + wc * 32 + 8 * fq;
        u32x4 bw[2][4][2];
#pragma unroll
        for (int ai = 0; ai < 2; ++ai)
#pragma unroll
            for (int m = 0; m < 4; ++m)
#pragma unroll
                for (int bj = 0; bj < 2; ++bj) bw[ai][m][bj] = *(const u32x4*)(base + (size_t)(row0 + ai * HALF + m * 16) * 2048 + col0 + bj * HALF);
        asm volatile("" ::: "memory");
#pragma unroll
        for (int ai = 0; ai < 2; ++ai)
#pragma unroll
            for (int m = 0; m < 4; ++m) {
                const int row = row0 + ai * HALF + m * 16; const size_t off = (size_t)row * 2048 + col0; float s = 0.f;
#pragma unroll
                for (int bj = 0; bj < 2; ++bj) {
                    const u32x4 b = bw[ai][m][bj];
                    const f32x4 b0 = {__uint_as_float(b.x << 16), __uint_as_float(b.x & 0xffff0000u), __uint_as_float(b.y << 16), __uint_as_float(b.y & 0xffff0000u)};
                    const f32x4 b1 = {__uint_as_float(b.z << 16), __uint_as_float(b.z & 0xffff0000u), __uint_as_float(b.w << 16), __uint_as_float(b.w & 0xffff0000u)};
                    const f32x4 o0 = b0 + acc[ai][bj][m][0] * scale, o1 = b1 + acc[ai][bj][m][1] * scale;
                    if (FINAL) { *(f32x4*)(out + off + bj * HALF) = o0; *(f32x4*)(out + off + bj * HALF + 4) = o1; }
                    else {
                        s += ((o0[0] * o0[0] + o0[1] * o0[1]) + (o0[2] * o0[2] + o0[3] * o0[3])) + ((o1[0] * o1[0] + o1[1] * o1[1]) + (o1[2] * o1[2] + o1[3] * o1[3]));
                        u32x4 w; w.x = cvt_pk_bf16(o0[0], o0[1]); w.y = cvt_pk_bf16(o0[2], o0[3]); w.z = cvt_pk_bf16(o1[0], o1[1]); w.w = cvt_pk_bf16(o1[2], o1[3]);
                        *(u32x4*)(xb + off + bj * HALF) = w;
                        if (XB8) { f32x4 e0 = o0 * FP8_SX, e1 = o1 * FP8_SX;
#pragma unroll
                            for (int j = 0; j < 4; ++j) { e0[j] = fminf(fmaxf(e0[j], -448.f), 448.f); e1[j] = fminf(fmaxf(e1[j], -448.f), 448.f); }
                            int w0 = 0, w1 = 0; w0 = __builtin_amdgcn_cvt_pk_fp8_f32(e0[0], e0[1], w0, false); w0 = __builtin_amdgcn_cvt_pk_fp8_f32(e0[2], e0[3], w0, true);
                            w1 = __builtin_amdgcn_cvt_pk_fp8_f32(e1[0], e1[1], w1, false); w1 = __builtin_amdgcn_cvt_pk_fp8_f32(e1[2], e1[3], w1, true);
                            u32x2 w8; w8.x = (unsigned)w0; w8.y = (unsigned)w1; *(u32x2*)(xb8 + off + bj * HALF) = w8; } }
                }
                if (!FINAL) { s += __shfl_xor(s, 16); s += __shfl_xor(s, 32);
                    if (fq == 0) __hip_atomic_fetch_add(ssq + row, ssq_fix(s), __ATOMIC_RELAXED, __HIP_MEMORY_SCOPE_AGENT); }
            }
    }
};

constexpr float FP8_SG = 16.0f, FP8_SWC = 1024.0f;
constexpr float FP8_SA = 8.0f, FP8_SW = 2048.0f;
template <bool FP8OUT> struct EpiM1 {
    static constexpr bool PERM = true, AFTER_DRAIN = false;
    bf16_t* H; const ssq_t* ssq; float iscale;
    __device__ __forceinline__ void operator()(const f32x4 (&acc)[2][2][4][2], const Unit& u, int wr, int wc, int fr, int fq) const {
        const int row0 = u.pm * BM + wr * 64 + fr, col0 = u.pn * BM + wc * 32 + 8 * fq;
        ssq_t sq[2][4];
#pragma unroll
        for (int ai = 0; ai < 2; ++ai)
#pragma unroll
            for (int m = 0; m < 4; ++m) sq[ai][m] = ssq[row0 + ai * HALF + m * 16];
        asm volatile("" ::: "memory");
#pragma unroll
        for (int ai = 0; ai < 2; ++ai)
#pragma unroll
            for (int m = 0; m < 4; ++m) {
                const int row = row0 + ai * HALF + m * 16; const float r = rstd_of(sq[ai][m]) * iscale;
#pragma unroll
                for (int bj = 0; bj < 2; ++bj) {
                    f32x4 v0 = acc[ai][bj][m][0] * r, v1 = acc[ai][bj][m][1] * r;
#pragma unroll
                    for (int j = 0; j < 4; ++j) { v0[j] = fmaxf(v0[j], 0.f); v1[j] = fmaxf(v1[j], 0.f); }
                    v0 = v0 * v0; v1 = v1 * v1;
                    if (FP8OUT) { v0 = v0 * FP8_SA; v1 = v1 * FP8_SA;
#pragma unroll
                        for (int j = 0; j < 4; ++j) { v0[j] = fminf(v0[j], 448.f); v1[j] = fminf(v1[j], 448.f); }
                        int w0 = 0, w1 = 0; w0 = __builtin_amdgcn_cvt_pk_fp8_f32(v0[0], v0[1], w0, false); w0 = __builtin_amdgcn_cvt_pk_fp8_f32(v0[2], v0[3], w0, true);
                        w1 = __builtin_amdgcn_cvt_pk_fp8_f32(v1[0], v1[1], w1, false); w1 = __builtin_amdgcn_cvt_pk_fp8_f32(v1[2], v1[3], w1, true);
                        u32x2 w; w.x = (unsigned)w0; w.y = (unsigned)w1;
                        *(u32x2*)((unsigned char*)H + (size_t)row * 8192 + col0 + bj * HALF) = w; }
                    else { u32x4 w; w.x = cvt_pk_bf16(v0[0], v0[1]); w.y = cvt_pk_bf16(v0[2], v0[3]); w.z = cvt_pk_bf16(v1[0], v1[1]); w.w = cvt_pk_bf16(v1[2], v1[3]);
                        *(u32x4*)(H + (size_t)row * 8192 + col0 + bj * HALF) = w; } }
            }
    }
};

struct EpiC1 {
    static constexpr bool PERM = true, AFTER_DRAIN = false;
    bf16_t* Bg; bf16_t* Z; const ssq_t* ssq; float iscale;
    __device__ __forceinline__ void operator()(const f32x4 (&acc)[2][2][4][2], const Unit& u, int wr, int wc, int fr, int fq) const {
        const int row0 = u.pm * BM + wr * 64 + fr;
        ssq_t sq[2][4];
#pragma unroll
        for (int ai = 0; ai < 2; ++ai)
#pragma unroll
            for (int m = 0; m < 4; ++m) sq[ai][m] = ssq[row0 + ai * HALF + m * 16];
        asm volatile("" ::: "memory");
        if (u.pn < 8) {
            const int col0 = u.pn * BM + wc * 32 + 8 * fq;
#pragma unroll
            for (int ai = 0; ai < 2; ++ai)
#pragma unroll
                for (int m = 0; m < 4; ++m) {
                    const int row = row0 + ai * HALF + m * 16; const float r = rstd_of(sq[ai][m]) * iscale; bf16_t* rowp = Bg + (size_t)row * 2048 + col0;
#pragma unroll
                    for (int bj = 0; bj < 2; ++bj) {
                        const f32x4 v0 = acc[ai][bj][m][0] * r, v1 = acc[ai][bj][m][1] * r;
                        u32x4 w; w.x = cvt_pk_bf16(v0[0], v0[1]); w.y = cvt_pk_bf16(v0[2], v0[3]); w.z = cvt_pk_bf16(v1[0], v1[1]); w.w = cvt_pk_bf16(v1[2], v1[3]);
                        *(u32x4*)(rowp + bj * HALF) = w; }
                }
        } else {
            const int col0 = (u.pn - 8) * HALF + wc * 32 + 8 * fq;
#pragma unroll
            for (int ai = 0; ai < 2; ++ai)
#pragma unroll
                for (int m = 0; m < 4; ++m) {
                    const int row = row0 + ai * HALF + m * 16; const float r = rstd_of(sq[ai][m]) * iscale; const float r2 = r * r;
                    const f32x4 v0 = acc[ai][0][m][0] * acc[ai][1][m][0] * r2, v1 = acc[ai][0][m][1] * acc[ai][1][m][1] * r2;
                    u32x4 w; w.x = cvt_pk_bf16(v0[0], v0[1]); w.y = cvt_pk_bf16(v0[2], v0[3]); w.z = cvt_pk_bf16(v1[0], v1[1]); w.w = cvt_pk_bf16(v1[2], v1[3]);
                    *(u32x4*)(Z + (size_t)row * 2048 + col0) = w;
                }
        }
    }
};

__device__ __forceinline__ float h2f_lo(unsigned w) { return (float)__builtin_bit_cast(_Float16, (unsigned short)(w & 0xffffu)); }
__device__ __forceinline__ float h2f_hi(unsigned w) { return (float)__builtin_bit_cast(_Float16, (unsigned short)(w >> 16)); }
__device__ __forceinline__ f32x4 cos4(u32x4 w) { return (f32x4){h2f_lo(w.x), h2f_lo(w.y), h2f_lo(w.z), h2f_lo(w.w)}; }
__device__ __forceinline__ f32x4 sin4(u32x4 w) { return (f32x4){h2f_hi(w.x), h2f_hi(w.y), h2f_hi(w.z), h2f_hi(w.w)}; }
struct EpiA1 {
    static constexpr bool PERM = false, AFTER_DRAIN = false;
    const ssq_t* ssq; bf16_t *Q, *K, *V, *QI, *KI; float* WI; const float *qg, *kg; const unsigned *ropeM, *ropeI; PG8_LAS float* P;
    __device__ __forceinline__ void operator()(const f32x4 (&acc)[2][2][4][2], const Unit& u, int wr, int wc, int fr, int fq) const {
        const int pn = u.pn, rl0 = wr * 64 + fr, row0 = u.pm * BM + rl0;
        ssq_t sq[2][4];
#pragma unroll
        for (int ai = 0; ai < 2; ++ai)
#pragma unroll
            for (int m = 0; m < 4; ++m) sq[ai][m] = ssq[row0 + ai * HALF + m * 16];
        if (pn < 10) {
            const bool isq = pn < 8; const float* g = isq ? qg : kg;
            const f32x4 g0 = *(const f32x4*)(g + 32 * wc + 4 * fq), g1 = *(const f32x4*)(g + 32 * wc + 16 + 4 * fq);
            u32x4 cw[2][4];
#pragma unroll
            for (int ai = 0; ai < 2; ++ai)
#pragma unroll
                for (int m = 0; m < 4; ++m) { const int row = row0 + ai * HALF + m * 16; cw[ai][m] = (u32x4){0x3c00u, 0x3c00u, 0x3c00u, 0x3c00u};
                    if (wc == 0) cw[ai][m] = *(const u32x4*)(ropeM + (size_t)row * 16 + 4 * fq); }
#pragma unroll
            for (int ai = 0; ai < 2; ++ai)
#pragma unroll
                for (int m = 0; m < 4; ++m) { const int rl = rl0 + ai * HALF + m * 16;
#pragma unroll
                    for (int bj = 0; bj < 2; ++bj) { const f32x4 a = acc[ai][bj][m][0], b = acc[ai][bj][m][1];
                        float s = ((a[0] * a[0] + a[1] * a[1]) + (a[2] * a[2] + a[3] * a[3])) + ((b[0] * b[0] + b[1] * b[1]) + (b[2] * b[2] + b[3] * b[3]));
                        s += __shfl_xor(s, 16); s += __shfl_xor(s, 32);
                        if (fq == 0) P[(rl * 2 + bj) * 4 + wc] = s; } }
            asm volatile("s_waitcnt lgkmcnt(0)" ::: "memory"); __builtin_amdgcn_s_barrier(); asm volatile("" ::: "memory");
#pragma unroll
            for (int ai = 0; ai < 2; ++ai)
#pragma unroll
                for (int m = 0; m < 4; ++m) { const int rl = rl0 + ai * HALF + m * 16, row = row0 + ai * HALF + m * 16; const float rs = rstd_of(sq[ai][m]);
                    bf16_t* dst = isq ? Q + (size_t)row * 2048 + pn * BM + wc * 32 + 4 * fq : K + (size_t)row * 512 + (pn - 8) * BM + wc * 32 + 4 * fq;
#pragma unroll
                    for (int bj = 0; bj < 2; ++bj) { const f32x4 pp = *(const PG8_LAS f32x4*)(P + (rl * 2 + bj) * 4);
                        const float tot = (pp[0] + pp[1]) + (pp[2] + pp[3]);
                        const float sc = rs * __builtin_amdgcn_rsqf(rs * rs * tot * (1.0f / 128.0f) + RMS_EPS);
                        f32x4 v0 = acc[ai][bj][m][0] * sc * g0, v1 = acc[ai][bj][m][1] * sc * g1;
                        if (wc == 0) { const f32x4 x1 = v0, x2 = v1, cs = cos4(cw[ai][m]), sn = sin4(cw[ai][m]); v0 = x1 * cs - x2 * sn; v1 = x2 * cs + x1 * sn; }
                        u32x2 w0, w1; w0.x = cvt_pk_bf16(v0[0], v0[1]); w0.y = cvt_pk_bf16(v0[2], v0[3]); w1.x = cvt_pk_bf16(v1[0], v1[1]); w1.y = cvt_pk_bf16(v1[2], v1[3]);
                        *(u32x2*)(dst + bj * HALF) = w0; *(u32x2*)(dst + bj * HALF + 16) = w1; } }
        } else if (pn < 12) {
            asm volatile("" ::: "memory");
#pragma unroll
            for (int ai = 0; ai < 2; ++ai)
#pragma unroll
                for (int m = 0; m < 4; ++m) { const int row = row0 + ai * HALF + m * 16; const float rs = rstd_of(sq[ai][m]);
                    bf16_t* dst = V + (size_t)row * 512 + (pn - 10) * BM + wc * 32 + 4 * fq;
#pragma unroll
                    for (int bj = 0; bj < 2; ++bj) { const f32x4 v0 = acc[ai][bj][m][0] * rs, v1 = acc[ai][bj][m][1] * rs;
                        u32x2 w0, w1; w0.x = cvt_pk_bf16(v0[0], v0[1]); w0.y = cvt_pk_bf16(v0[2], v0[3]); w1.x = cvt_pk_bf16(v1[0], v1[1]); w1.y = cvt_pk_bf16(v1[2], v1[3]);
                        *(u32x2*)(dst + bj * HALF) = w0; *(u32x2*)(dst + bj * HALF + 16) = w1; } }
        } else {
            const bool rot = ((wc & 1) == 0) && fq < 2;
            const int d0 = (wc & 1) ? 32 + 4 * fq : (fq < 2 ? 4 * fq : 16 + 4 * (fq - 2)), d1 = (wc & 1) ? 48 + 4 * fq : (fq < 2 ? 8 + 4 * fq : 24 + 4 * (fq - 2));
            const bool iski = pn == 16;
            u32x4 cw[2][4];
#pragma unroll
            for (int ai = 0; ai < 2; ++ai)
#pragma unroll
                for (int m = 0; m < 4; ++m) { const int row = row0 + ai * HALF + m * 16; cw[ai][m] = (u32x4){0x3c00u, 0x3c00u, 0x3c00u, 0x3c00u};
                    if (rot) cw[ai][m] = *(const u32x4*)(ropeI + (size_t)row * 8 + 4 * fq); }
            asm volatile("" ::: "memory");
#pragma unroll
            for (int ai = 0; ai < 2; ++ai)
#pragma unroll
                for (int m = 0; m < 4; ++m) { const int row = row0 + ai * HALF + m * 16; const float rs = rstd_of(sq[ai][m]);
#pragma unroll
                    for (int bj = 0; bj < 2; ++bj) {
                        f32x4 v0 = acc[ai][bj][m][0] * rs, v1 = acc[ai][bj][m][1] * rs;
                        if (iski) {
                            if (bj == 0) {
                                if (wc < 2) { if (rot) { const f32x4 x1 = v0, x2 = v1, cs = cos4(cw[ai][m]), sn = sin4(cw[ai][m]); v0 = x1 * cs - x2 * sn; v1 = x2 * cs + x1 * sn; }
                                    u32x2 w0, w1; w0.x = cvt_pk_bf16(v0[0], v0[1]); w0.y = cvt_pk_bf16(v0[2], v0[3]); w1.x = cvt_pk_bf16(v1[0], v1[1]); w1.y = cvt_pk_bf16(v1[2], v1[3]);
                                    bf16_t* dst = KI + (size_t)row * 64; *(u32x2*)(dst + d0) = w0; *(u32x2*)(dst + d1) = w1; }
                                else if (wc == 2) { *(f32x4*)(WI + (size_t)row * 16 + 4 * fq) = v0 * 0.03125f; }
                            }
                        } else {
                            if (rot) { const f32x4 x1 = v0, x2 = v1, cs = cos4(cw[ai][m]), sn = sin4(cw[ai][m]); v0 = x1 * cs - x2 * sn; v1 = x2 * cs + x1 * sn; }
                            u32x2 w0, w1; w0.x = cvt_pk_bf16(v0[0], v0[1]); w0.y = cvt_pk_bf16(v0[2], v0[3]); w1.x = cvt_pk_bf16(v1[0], v1[1]); w1.y = cvt_pk_bf16(v1[2], v1[3]);
                            bf16_t* dst = QI + (size_t)row * 1024 + ((pn - 12) * 4 + 2 * bj + (wc >> 1)) * 64; *(u32x2*)(dst + d0) = w0; *(u32x2*)(dst + d1) = w1; }
                    } }
        }
    }
};
template <class T> struct EpiTag { static constexpr int id = 0; };
template <> struct EpiTag<EpiA1> { static constexpr int id = 1; };
template <> struct EpiTag<EpiC1> { static constexpr int id = 2; };
template <> struct EpiTag<EpiM1<false>> { static constexpr int id = 3; };
template <> struct EpiTag<EpiM1<true>> { static constexpr int id = 4; };
template <class Epi, class Sched, bool ALIGN_EPI = false, bool SP2 = false, bool FP8 = false>
__device__ __forceinline__ void gemm_phase(PG8_LAS unsigned char* lds, const Gemm g, const Sched& S, const Epi& E) {
    int tid = threadIdx.x; asm volatile("" : "+v"(tid));
    const int wid = __builtin_amdgcn_readfirstlane(tid >> 6), lane = tid & 63, wr = wid >> 2, wc = wid & 3, fr = lane & 15, fq = lane >> 4;
    const int K = g.K, nt = K / BK;
    unsigned voffA[2], voffB[2];
#pragma unroll
    for (int i = 0; i < 2; ++i) { int R, C; stage_rc(tid * 16 + i * 8192, R, C); const int Rb = Epi::PERM ? ((R & ~31) + perm32(R & 31)) : R;
        voffA[i] = (unsigned)(R * K + C) * 2u; voffB[i] = (unsigned)(Rb * K + C) * 2u; }
    const size_t kstep = (size_t)(BK * 2);
    const size_t hstep = (size_t)HALF * K * 2;
    const size_t tstep = 2 * hstep;
    const unsigned ldsw = (unsigned)wid * 1024u;
    const int aoff = FP8 ? lds_byte(wr * 64 + fr, 16 * (fq & 1)) + (fq >> 1) * 1024 : lds_byte(wr * 64 + fr, fq * 8), boff = FP8 ? lds_byte(wc * 32 + fr, 16 * (fq & 1)) + (fq >> 1) * 1024 : lds_byte(wc * 32 + fr, fq * 8);
#define PG8_SA(b, h) (((b) * 2 + (h)) * HTB)
#define PG8_SB(b, h) ((4 + (b) * 2 + (h)) * HTB)
#define PG8_STAGE(bufoff, gbase, voff) do { _Pragma("unroll") for (int _i = 0; _i < 2; ++_i) \
        __builtin_amdgcn_global_load_lds((const unsigned*)((const char*)(gbase) + (voff)[_i]), (PG8_LAS unsigned*)(lds + (bufoff) + ldsw + _i * 8192), 16, 0, 0); } while (0)
#define PG8_LDA(dst, b, h) do { if constexpr (FP8) { _Pragma("unroll") for (int m = 0; m < 4; ++m) dst##8[m] = cat8(*(const PG8_LAS bf16x8*)(lds + PG8_SA(b, h) + aoff + m * 2048), *(const PG8_LAS bf16x8*)(lds + PG8_SA(b, h) + aoff + m * 2048 + 16)); } \
    else { _Pragma("unroll") for (int m = 0; m < 4; ++m) _Pragma("unroll") for (int k = 0; k < 2; ++k) dst[m][k] = *(const PG8_LAS bf16x8*)(lds + PG8_SA(b, h) + aoff + m * 2048 + k * 1024); } } while (0)
#define PG8_LDB(dst, b, h) do { if constexpr (FP8) { _Pragma("unroll") for (int n = 0; n < 2; ++n) dst##8[n] = cat8(*(const PG8_LAS bf16x8*)(lds + PG8_SB(b, h) + boff + n * 2048), *(const PG8_LAS bf16x8*)(lds + PG8_SB(b, h) + boff + n * 2048 + 16)); } \
    else { _Pragma("unroll") for (int n = 0; n < 2; ++n) _Pragma("unroll") for (int k = 0; k < 2; ++k) dst[n][k] = *(const PG8_LAS bf16x8*)(lds + PG8_SB(b, h) + boff + n * 2048 + k * 1024); } } while (0)
#define PG8_MMA(ai, bj, At, Bt) do { __builtin_amdgcn_s_setprio(1); if constexpr (FP8) { _Pragma("unroll") for (int m = 0; m < 4; ++m) _Pragma("unroll") for (int n = 0; n < 2; ++n) \
        asm volatile("v_mfma_scale_f32_16x16x128_f8f6f4 %0, %1, %2, %0, %3, %3 op_sel_hi:[0,0,0]" : "+v"(acc[ai][bj][m][n]) : "v"(Bt##8[n]), "v"(At##8[m]), "v"(sc1)); } \
    else { _Pragma("unroll") for (int m = 0; m < 4; ++m) _Pragma("unroll") for (int n = 0; n < 2; ++n) _Pragma("unroll") for (int k = 0; k < 2; ++k) \
        acc[ai][bj][m][n] = __builtin_amdgcn_mfma_f32_16x16x32_bf16(Bt[n][k], At[m][k], acc[ai][bj][m][n], 0, 0, 0); } __builtin_amdgcn_s_setprio(0); } while (0)
#define PG8_WAIT_V(n) asm volatile("s_waitcnt vmcnt(" #n ")" ::: "memory")
#define PG8_WAIT_L(n) asm volatile("s_waitcnt lgkmcnt(" #n ")" ::: "memory")
#define PG8_BAR __builtin_amdgcn_s_barrier()
#define PG8_SCHED __builtin_amdgcn_sched_barrier(0)
    Unit cur, nxt; int ui = 0;
    if (!S.next(0, cur)) return;
    f32x4 acc[2][2][4][2];
#pragma unroll
    for (int a = 0; a < 2; ++a)
#pragma unroll
        for (int b = 0; b < 2; ++b)
#pragma unroll
            for (int m = 0; m < 4; ++m)
#pragma unroll
                for (int n = 0; n < 2; ++n) acc[a][b][m][n] = (f32x4){0.f, 0.f, 0.f, 0.f};
    const int sc1 = 0x7f7f7f7f;
    bf16x8 At[4][2], B0[2][2], B1[2][2]; v8i_t At8[4], B08[2], B18[2];
    const char* cA = (const char*)g.A + (size_t)cur.pm * tstep; const char* cB = (const char*)g.Bt + (size_t)cur.pn * tstep;
    S.a_ready(cur);
    if constexpr (SP2) {
        PG8_STAGE(PG8_SB(0, 0), cB, voffB); PG8_STAGE(PG8_SB(0, 1), cB + hstep, voffB); PG8_STAGE(PG8_SA(0, 0), cA, voffA); PG8_STAGE(PG8_SA(0, 1), cA + hstep, voffA);
        if (wr == 1) PG8_BAR;
        PG8_WAIT_V(2); PG8_BAR;
        PG8_STAGE(PG8_SB(1, 0), cB + kstep, voffB); PG8_STAGE(PG8_SA(1, 0), cA + kstep, voffA); PG8_STAGE(PG8_SB(1, 1), cB + hstep + kstep, voffB);
        PG8_WAIT_V(6); PG8_BAR;
    } else {
        PG8_STAGE(PG8_SB(0, 0), cB, voffB); PG8_STAGE(PG8_SA(0, 0), cA, voffA); PG8_STAGE(PG8_SB(0, 1), cB + hstep, voffB); PG8_STAGE(PG8_SA(0, 1), cA + hstep, voffA);
        if (wr == 1) PG8_BAR;
        PG8_WAIT_V(4); PG8_BAR;
        PG8_STAGE(PG8_SB(1, 0), cB + kstep, voffB); PG8_STAGE(PG8_SA(1, 0), cA + kstep, voffA); PG8_STAGE(PG8_SB(1, 1), cB + hstep + kstep, voffB);
        PG8_WAIT_V(6); PG8_BAR;
    }
    for (;;) {
        const bool has_next = S.next(ui + 1, nxt);
        const char* nA = has_next ? (const char*)g.A + (size_t)nxt.pm * tstep : cA; const char* nB = has_next ? (const char*)g.Bt + (size_t)nxt.pn * tstep : cB;
        for (int t = 0; t < nt; t += 2) {
            const bool last = (t == nt - 2);
            const char* a1 = cA + (size_t)(t + 1) * kstep;
            const char* a2 = last ? nA : cA + (size_t)(t + 2) * kstep; const char* b2 = last ? nB : cB + (size_t)(t + 2) * kstep;
            const char* a3 = a2 + kstep; const char* b3 = b2 + kstep;
            if (last && has_next) S.a_ready(nxt);
            if constexpr (SP2) {
            PG8_LDB(B0, 0, 0); PG8_LDB(B1, 0, 1); PG8_SCHED; PG8_LDA(At, 0, 0); PG8_STAGE(PG8_SA(1, 1), a1 + hstep, voffA);
            PG8_WAIT_V(8); PG8_WAIT_L(0); PG8_BAR; PG8_MMA(0, 0, At, B0); PG8_MMA(0, 1, At, B1); PG8_BAR; PG8_SCHED;
            PG8_LDA(At, 0, 1); PG8_STAGE(PG8_SB(0, 0), b2, voffB); PG8_STAGE(PG8_SB(0, 1), b2 + hstep, voffB); PG8_STAGE(PG8_SA(0, 0), a2, voffA);
            PG8_WAIT_V(8); PG8_WAIT_L(0); PG8_BAR; PG8_MMA(1, 0, At, B0); PG8_MMA(1, 1, At, B1); PG8_BAR; PG8_SCHED;
            PG8_LDB(B0, 1, 0); PG8_LDB(B1, 1, 1); PG8_SCHED; PG8_LDA(At, 1, 0); PG8_STAGE(PG8_SA(0, 1), a2 + hstep, voffA);
            PG8_WAIT_V(8); PG8_WAIT_L(0); PG8_BAR; PG8_MMA(0, 0, At, B0); PG8_MMA(0, 1, At, B1); PG8_BAR; PG8_SCHED;
            PG8_LDA(At, 1, 1); PG8_STAGE(PG8_SB(1, 0), b3, voffB); PG8_STAGE(PG8_SB(1, 1), b3 + hstep, voffB); PG8_STAGE(PG8_SA(1, 0), a3, voffA);
            PG8_WAIT_V(8); PG8_WAIT_L(0); PG8_BAR; PG8_MMA(1, 0, At, B0); PG8_MMA(1, 1, At, B1); PG8_BAR; PG8_SCHED;
            } else {
            PG8_LDB(B0, 0, 0); PG8_SCHED; PG8_LDA(At, 0, 0); PG8_STAGE(PG8_SA(1, 1), a1 + hstep, voffA);
            PG8_WAIT_L(8); PG8_BAR; PG8_WAIT_L(0); PG8_MMA(0, 0, At, B0); PG8_BAR; PG8_SCHED;
            PG8_LDB(B1, 0, 1); PG8_STAGE(PG8_SB(0, 0), b2, voffB);
            PG8_BAR; PG8_WAIT_L(0); PG8_MMA(0, 1, At, B1); PG8_BAR;
            PG8_LDA(At, 0, 1); PG8_STAGE(PG8_SA(0, 0), a2, voffA);
            PG8_BAR; PG8_WAIT_L(0); PG8_MMA(1, 0, At, B0); PG8_BAR; PG8_SCHED;
            PG8_STAGE(PG8_SB(0, 1), b2 + hstep, voffB);
            PG8_WAIT_V(6); PG8_BAR; PG8_MMA(1, 1, At, B1); PG8_BAR;
            PG8_LDB(B0, 1, 0); PG8_SCHED; PG8_LDA(At, 1, 0); PG8_STAGE(PG8_SA(0, 1), a2 + hstep, voffA);
            PG8_WAIT_L(8); PG8_BAR; PG8_WAIT_L(0); PG8_MMA(0, 0, At, B0); PG8_BAR; PG8_SCHED;
            PG8_LDB(B1, 1, 1); PG8_STAGE(PG8_SB(1, 0), b3, voffB);
            PG8_BAR; PG8_WAIT_L(0); PG8_MMA(0, 1, At, B1); PG8_BAR;
            PG8_LDA(At, 1, 1); PG8_STAGE(PG8_SA(1, 0), a3, voffA);
            PG8_BAR; PG8_WAIT_L(0); PG8_MMA(1, 0, At, B0); PG8_BAR; PG8_SCHED;
            PG8_STAGE(PG8_SB(1, 1), b3 + hstep, voffB);
            PG8_WAIT_V(6); PG8_BAR; PG8_MMA(1, 1, At, B1); PG8_BAR;
            }
        }
        if constexpr (ALIGN_EPI) { if (wr == 0) PG8_BAR; }
#if defined(DBG_EPI_TYPE)
        unsigned long long et_ = 0; if (EpiTag<Epi>::id == DBG_EPI_TYPE && blockIdx.x == 0 && threadIdx.x == 0) et_ = __builtin_amdgcn_s_memrealtime();
#endif
        if constexpr (!Epi::AFTER_DRAIN) { E(acc, cur, wr, wc, fr, fq); S.done(cur); }
#if defined(DBG_EPI_TYPE)
        if (EpiTag<Epi>::id == DBG_EPI_TYPE && blockIdx.x == 0 && threadIdx.x == 0) { asm volatile("s_waitcnt vmcnt(0)" ::: "memory"); *(volatile PG8_LAS unsigned*)(lds + 150016 + 80) += (unsigned)(__builtin_amdgcn_s_memrealtime() - et_); }
#endif
        if (!has_next) break;
#pragma unroll
        for (int a = 0; a < 2; ++a)
#pragma unroll
            for (int b = 0; b < 2; ++b)
#pragma unroll
                for (int m = 0; m < 4; ++m)
#pragma unroll
                    for (int n = 0; n < 2; ++n) acc[a][b][m][n] = (f32x4){0.f, 0.f, 0.f, 0.f};
        cur = nxt; cA = nA; cB = nB; ++ui;
        if constexpr (ALIGN_EPI) { if (wr == 1) PG8_BAR; }
    }
    PG8_WAIT_V(0);
    if constexpr (!ALIGN_EPI) { if (wr == 0) PG8_BAR; }
    PG8_BAR;
    if constexpr (Epi::AFTER_DRAIN) { E.fused(acc, cur, wr, wc, fr, fq, lds, wid, lane); S.done(cur); }
#undef PG8_SA
#undef PG8_SB
#undef PG8_STAGE
#undef PG8_LDA
#undef PG8_LDB
#undef PG8_MMA
#undef PG8_WAIT_V
#undef PG8_WAIT_L
#undef PG8_BAR
#undef PG8_SCHED
}
}
#ifndef ATT_THR
#define ATT_THR 16.f
#endif
namespace att {
typedef unsigned short bf16;
typedef short bf16x8 __attribute__((ext_vector_type(8)));
typedef short s16x4 __attribute__((ext_vector_type(4)));
typedef float f32x16 __attribute__((ext_vector_type(16)));
typedef float f32x4 __attribute__((ext_vector_type(4)));
typedef unsigned u32x4 __attribute__((ext_vector_type(4)));
typedef unsigned long long u64;
constexpr int D = 128, SEQ = 4096, QP = 2048, KP = 512;
constexpr float SCALE = 0.08838834764831845f;
constexpr float THR = ATT_THR;
constexpr int NW = 8, QBLK = 32, KVBLK = 64, QB = NW * QBLK;
constexpr int SHM_V = KVBLK * D * 2, SHM_K = KVBLK * D * 2;
constexpr int LDS_BYTES = 2 * SHM_V + 2 * SHM_K + NW * 64 * 4;

#define KSWZ(row, colB) ((row) * 256 + ((colB) ^ (((row) & 7) << 4)))
#define SBAR() __builtin_amdgcn_sched_barrier(0)
__device__ __forceinline__ int v_st(int k, int c) { const int kk = (k & ~0xC) | ((k & 4) << 1) | ((k & 8) >> 1); return ((kk >> 3) * 4 + (c >> 5)) * 512 + ((kk & 7) * 32 + (c & 31)) * 2; }
__device__ __forceinline__ int v_rd_base(int lane) { return ((lane & 3) << 3) | (((lane >> 2) & 3) << 6) | (((lane >> 4) & 1) << 5) | (((lane >> 5) & 1) << 8); }
constexpr int v_rd_off(int d0, int ks, int half) { return d0 * 512 + ks * 4096 + half * 2048; }
__device__ __forceinline__ int crow(int r, int hi) { return (r & 3) + 8 * (r >> 2) + 4 * hi; }
__device__ __forceinline__ unsigned cvtpk(float lo, float hi) { unsigned r; asm volatile("v_cvt_pk_bf16_f32 %0, %1, %2" : "=v"(r) : "v"(lo), "v"(hi)); return r; }
__device__ __forceinline__ bf16x8 load8(const bf16* p) { return *reinterpret_cast<const bf16x8*>(p); }
template <bool NOP> __device__ __forceinline__ void mask_tile(f32x16& p0, f32x16& p1, u64 mk, int hi) {
    const unsigned m0 = (unsigned)mk >> (4 * hi), m1 = (unsigned)(mk >> 32) >> (4 * hi);
    const unsigned NEGINF = 0xFF800000u;
    if (NOP) asm volatile("s_nop 15\n\ts_nop 7" ::: "memory");
#pragma unroll
    for (int r = 0; r < 16; ++r) {
        const int c = (r & 3) + 8 * (r >> 2);
        unsigned t0, t1;
        asm volatile("v_bfe_i32 %0, %1, %2, 1" : "=v"(t0) : "v"(m0), "n"(c));
        asm volatile("v_bfi_b32 %0, %1, %0, %2" : "+v"(p0[r]) : "v"(t0), "s"(NEGINF));
        asm volatile("v_bfe_i32 %0, %1, %2, 1" : "=v"(t1) : "v"(m1), "n"(c));
        asm volatile("v_bfi_b32 %0, %1, %0, %2" : "+v"(p1[r]) : "v"(t1), "s"(NEGINF));
    }
}
__device__ __forceinline__ void partialSM(f32x16& p0, f32x16& p1, float& m_reg, float& mn, float& alpha) {
    float pmax = p0[0]; for (int r = 1; r < 16; ++r) pmax = fmaxf(pmax, p0[r]); for (int r = 0; r < 16; ++r) pmax = fmaxf(pmax, p1[r]);
    { auto rr = __builtin_amdgcn_permlane32_swap(__float_as_uint(pmax), __float_as_uint(pmax), false, false);
      pmax = fmaxf(__uint_as_float(rr[0]), __uint_as_float(rr[1])); }
    constexpr float C2 = 1.4426950408889634f * SCALE;
    if (__builtin_expect(__all((pmax - m_reg) * SCALE <= THR), 1)) { mn = m_reg; alpha = 1.f; }
    else { mn = fmaxf(m_reg, pmax); alpha = __builtin_amdgcn_exp2f((m_reg - mn) * C2); m_reg = mn; }
    const float mnL = -mn * C2;
    for (int r = 0; r < 16; ++r) p0[r] = fmaf(p0[r], C2, mnL); for (int r = 0; r < 16; ++r) p1[r] = fmaf(p1[r], C2, mnL);
    for (int r = 0; r < 16; ++r) p0[r] = __builtin_amdgcn_exp2f(p0[r]);
}
__device__ __forceinline__ void finishSM(f32x16& p0, f32x16& p1, float alpha, float& l_reg, bf16x8& pa0, bf16x8& pa1, bf16x8& pa2, bf16x8& pa3) {
    for (int r = 0; r < 16; ++r) p1[r] = __builtin_amdgcn_exp2f(p1[r]);
    float ps = 0; for (int r = 0; r < 16; ++r) ps += p0[r]; for (int r = 0; r < 16; ++r) ps += p1[r];
    { auto rr = __builtin_amdgcn_permlane32_swap(__float_as_uint(ps), __float_as_uint(ps), false, false);
      ps = __uint_as_float(rr[0]) + __uint_as_float(rr[1]); }
    l_reg = l_reg * alpha + ps;
#define PK4(P, B_, OUT) do { unsigned a0 = cvtpk(P[B_+0], P[B_+1]), a1 = cvtpk(P[B_+2], P[B_+3]);                          \
        unsigned b0 = cvtpk(P[B_+4], P[B_+5]), b1 = cvtpk(P[B_+6], P[B_+7]);                                             \
        auto r0 = __builtin_amdgcn_permlane32_swap(a0, b0, false, false); auto r1 = __builtin_amdgcn_permlane32_swap(a1, b1, false, false); \
        u32x4 w = {r0[0], r1[0], r0[1], r1[1]}; OUT = *reinterpret_cast<bf16x8*>(&w); } while (0)
    PK4(p0, 0, pa0); PK4(p0, 8, pa1); PK4(p1, 0, pa2); PK4(p1, 8, pa3);
#undef PK4
}
template <int KB>
__device__ __forceinline__ void qkt(f32x16& p0, f32x16& p1, const char* K_lds, int r32, int hi, const bf16x8* qr) {
    p0 = f32x16{}; p1 = f32x16{};
    const char* kb[4];
#pragma unroll
    for (int dd = 0; dd < 4; ++dd) kb[dd] = K_lds + KB * SHM_K + KSWZ(r32, (dd * 16 + hi * 8) * 2);
#pragma unroll
    for (int d0 = 0; d0 < 8; ++d0) { const char* a = kb[d0 & 3] + (d0 >> 2) * 128;
        bf16x8 b0 = *reinterpret_cast<const bf16x8*>(a);
        bf16x8 b1 = *reinterpret_cast<const bf16x8*>(a + 32 * 256);
        p0 = __builtin_amdgcn_mfma_f32_32x32x16_bf16(b0, qr[d0], p0, 0, 0, 0);
        p1 = __builtin_amdgcn_mfma_f32_32x32x16_bf16(b1, qr[d0], p1, 0, 0, 0); }
}
template <int VB>
__device__ __forceinline__ void pv_tile(f32x16* o, int vb0, bf16x8 pa0, bf16x8 pa1, bf16x8 pa2, bf16x8 pa3) {
#define TRRD(dst, off) asm volatile("ds_read_b64_tr_b16 %0, %1 offset:%2" : "=&v"(dst) : "v"(vb0), "i"(off) : "memory")
#define PV_D0(d0) do { s16x4 l0, l1, l2, l3, h0, h1, h2, h3; constexpr int b_ = VB * SHM_V + v_rd_off(d0, 0, 0); \
        TRRD(l0, b_); TRRD(h0, b_ + 2048); TRRD(l1, b_ + 4096); TRRD(h1, b_ + 6144); TRRD(l2, b_ + 8192); TRRD(h2, b_ + 10240); TRRD(l3, b_ + 12288); TRRD(h3, b_ + 14336); \
        asm volatile("s_waitcnt lgkmcnt(0)" ::: "memory"); SBAR();   \
        o[d0] = __builtin_amdgcn_mfma_f32_32x32x16_bf16(pa0, (bf16x8){l0[0], l0[1], l0[2], l0[3], h0[0], h0[1], h0[2], h0[3]}, o[d0], 0, 0, 0);   \
        o[d0] = __builtin_amdgcn_mfma_f32_32x32x16_bf16(pa1, (bf16x8){l1[0], l1[1], l1[2], l1[3], h1[0], h1[1], h1[2], h1[3]}, o[d0], 0, 0, 0);   \
        o[d0] = __builtin_amdgcn_mfma_f32_32x32x16_bf16(pa2, (bf16x8){l2[0], l2[1], l2[2], l2[3], h2[0], h2[1], h2[2], h2[3]}, o[d0], 0, 0, 0);   \
        o[d0] = __builtin_amdgcn_mfma_f32_32x32x16_bf16(pa3, (bf16x8){l3[0], l3[1], l3[2], l3[3], h3[0], h3[1], h3[2], h3[3]}, o[d0], 0, 0, 0); } while (0)
    PV_D0(0); PV_D0(1); PV_D0(2); PV_D0(3);
#undef PV_D0
#undef TRRD
}
__device__ __forceinline__ u64 causal_word(int n) { return n >= 64 ? ~0ull : (n <= 0 ? 0ull : ((1ull << n) - 1ull)); }
struct BlockRef { const bf16* Q; const bf16* K; const bf16* V; bf16* O; const u64* M; int P0; };
struct Seam { bf16x8 qr[8]; bf16x8 st_v0, st_v1, st_k0, st_k1; };
#define ROW(p, k0, rr) ((p) + (unsigned)(((k0) + (rr)) * KP + sc))
#define VMW() asm volatile("s_waitcnt vmcnt(0)" ::: "memory")
#define VMWN(n) asm volatile("s_waitcnt vmcnt(%0)" :: "i"(n) : "memory")
#define SLOAD_H(Kp, Vp, k0) do { S.st_v0 = load8(ROW(Vp, k0, sr)); S.st_v1 = load8(ROW(Vp, k0, 32 + sr));              \
                         S.st_k0 = load8(ROW(Kp, k0, sr)); S.st_k1 = load8(ROW(Kp, k0, 32 + sr)); } while (0)
#define SWRITE_HK(bf) do { *(bf16x8*)(K_lds + (bf) * SHM_K + kws) = S.st_k0; *(bf16x8*)(K_lds + (bf) * SHM_K + kws + 32 * 256) = S.st_k1; } while (0)
#define SWRITE_HV(bf) do { *(bf16x8*)(V_lds + (bf) * SHM_V + vst0) = S.st_v0; *(bf16x8*)(V_lds + (bf) * SHM_V + vst1) = S.st_v1; } while (0)
#define SWRITE_H(bf) do { SWRITE_HV(bf); SWRITE_HK(bf); } while (0)
__device__ __forceinline__ void attn_prime(const BlockRef& cur, char* lds, Seam& S) {
    int tid = threadIdx.x; asm volatile("" : "+v"(tid));
    const int wid = __builtin_amdgcn_readfirstlane(tid >> 6), lane = tid & 63, r32 = lane & 31, hi = lane >> 5;
    const int sr = tid >> 4, sc = (tid & 15) * 8, kws = KSWZ(sr, sc * 2); char* K_lds = lds + 2 * SHM_V;
    for (int d0 = 0; d0 < 8; ++d0) S.qr[d0] = load8(cur.Q + (unsigned)((wid * QBLK + r32) * QP + d0 * 16 + hi * 8));
    SLOAD_H(cur.K, cur.V, 0); VMW(); SWRITE_HK(0);
    __syncthreads();
}
__device__ __forceinline__ void attn_block(const BlockRef& cur, const BlockRef& nxt, char* lds, Seam& S) {
    int tid = threadIdx.x; asm volatile("" : "+v"(tid));
    const int wid = __builtin_amdgcn_readfirstlane(tid >> 6), lane = tid & 63, r32 = lane & 31, hi = lane >> 5;
    const int NT = (cur.P0 + QB - 1) / KVBLK + 1;
    char* V_lds = lds; char* K_lds = lds + 2 * SHM_V;
    float* ws = (float*)(lds + 2 * SHM_V + 2 * SHM_K) + wid * 64; float* li_l = ws, * al_l = ws + 32;
    float m_reg = -1e30f, l_reg = 0; f32x16 o[4] = {};
    const int sr = tid >> 4, sc = (tid & 15) * 8, vst0 = v_st(sr, sc), vst1 = v_st(32 + sr, sc), kws = KSWZ(sr, sc * 2);
    const int vb0 = (int)(uintptr_t)V_lds + v_rd_base(lane);
    const bf16* Kh = cur.K; const bf16* Vh = cur.V;
    const u64* Mb = cur.M; const unsigned mo = (unsigned)(cur.P0 + wid * QBLK + r32);
#if defined(DBG_CAUSAL_ONLY)
#define LOADMK(t) causal_word((int)mo - 64 * (t) + 1)
#else
#define LOADMK(t) Mb[mo + (unsigned)((t) * SEQ)]
#endif
#define RESC(a) do { if (__any((a) < 1.f)) { if (hi == 0) al_l[r32] = (a); asm volatile("s_waitcnt lgkmcnt(0)" ::: "memory");              \
                     for (int d_ = 0; d_ < 4; ++d_) for (int r = 0; r < 16; ++r) o[d_][r] *= al_l[crow(r, hi)]; } } while (0)
#define KBASE(t) ((t) * KVBLK)
#define SEAM_K0() do { VMWN(8); SWRITE_HK(0); SBAR(); } while (0)
    f32x16 pA0, pA1, pB0, pB1; float mnA, mnB, alA, alB; bf16x8 pa0, pa1, pa2, pa3; u64 mk;
    SWRITE_HV(0); SBAR();
    mk = LOADMK(0);
    if (NT > 1) { SLOAD_H(Kh, Vh, KBASE(1)); }
    SBAR(); qkt<0>(pA0, pA1, K_lds, r32, hi, S.qr); SBAR();
    VMW();
    mask_tile<true>(pA0, pA1, mk, hi); partialSM(pA0, pA1, m_reg, mnA, alA);
    if (NT > 1) { SWRITE_H(1); }
    __syncthreads();
#define HALF_STEP(PX0, PX1, mnX, alX, PY0, PY1, alY, t, KB, VB, SB) do {                                                     \
        mk = LOADMK(t);                                                                                           \
        SBAR(); qkt<KB>(PX0, PX1, K_lds, r32, hi, S.qr);                                                                      \
        finishSM(PY0, PY1, alY, l_reg, pa0, pa1, pa2, pa3); SBAR();                                                           \
        if ((t) + 1 < NT) { SLOAD_H(Kh, Vh, KBASE((t) + 1)); SBAR(); }                                                        \
        pv_tile<VB>(o, vb0, pa0, pa1, pa2, pa3);                                                                              \
        if ((t) + 1 < NT) VMWN(4); else VMW();                                                                                \
        mask_tile<false>(PX0, PX1, mk, hi); partialSM(PX0, PX1, m_reg, mnX, alX);                                                    \
        __syncthreads();                                                                                                      \
        if ((t) + 1 < NT) { VMW(); SWRITE_H(SB); }                                                                            \
        RESC(alX); __syncthreads(); } while (0)
    for (int t = 1; t + 1 < NT; t += 2) {
        HALF_STEP(pB0, pB1, mnB, alB, pA0, pA1, alA, t, 1, 0, 0);
        HALF_STEP(pA0, pA1, mnA, alA, pB0, pB1, alB, t + 1, 0, 1, 1);
    }
    const bool even = (NT & 1) == 0;
    if (even) { mk = LOADMK(NT - 1); SBAR(); qkt<1>(pB0, pB1, K_lds, r32, hi, S.qr); SBAR(); }
    SLOAD_H(nxt.K, nxt.V, 0); SBAR();
#pragma unroll
    for (int d0 = 0; d0 < 8; ++d0) S.qr[d0] = load8(nxt.Q + (unsigned)((wid * QBLK + r32) * QP + d0 * 16 + hi * 8));
    SBAR();
    finishSM(pA0, pA1, alA, l_reg, pa0, pa1, pa2, pa3); SBAR();
    pv_tile<0>(o, vb0, pa0, pa1, pa2, pa3);
    if (even) { VMWN(12); mask_tile<false>(pB0, pB1, mk, hi); partialSM(pB0, pB1, m_reg, mnB, alB); __syncthreads(); RESC(alB);
        finishSM(pB0, pB1, alB, l_reg, pa0, pa1, pa2, pa3); SBAR(); pv_tile<1>(o, vb0, pa0, pa1, pa2, pa3); }
    SBAR(); SEAM_K0();
    if (hi == 0) li_l[r32] = l_reg; asm volatile("s_waitcnt lgkmcnt(0)" ::: "memory");
    float rli[16];
#pragma unroll
    for (int r = 0; r < 16; ++r) rli[r] = __builtin_amdgcn_rcpf(li_l[crow(r, hi)]);
    bf16* Ow = cur.O + (unsigned)((wid * QBLK) * QP);
#pragma unroll
    for (int r = 0; r < 16; ++r) { const int orow = crow(r, hi);
#pragma unroll
        for (int d0 = 0; d0 < 4; ++d0) { const float v = o[d0][r] * rli[r];
            const float vn = __shfl_xor(v, 1);
            if ((r32 & 1) == 0) *(unsigned*)(Ow + (unsigned)(orow * QP + d0 * 32 + r32)) = cvtpk(v, vn); } }
    __syncthreads();
#undef RESC
#undef KBASE
#undef SEAM_K0
#undef HALF_STEP
}
#undef ROW
#undef VMW
#undef VMWN
#undef SLOAD_H
#undef SWRITE_HK
#undef SWRITE_HV
#undef SWRITE_H
struct Item { int bh, qb0, qb1; };
__device__ __forceinline__ Item decode(int L) {
    constexpr int G = 4, nx = 8, per = G * nx; Item it;
    const int xcd = L & 7, k = L >> 3, gi = k / per, r = k - gi * per;
    it.bh = (gi * 8 + xcd) * G + r / nx; const int x = r % nx;
    it.qb0 = x; it.qb1 = 15 - x; return it;
}
struct Tensors { const bf16* Q; const bf16* K; const bf16* V; bf16* O; const u64* M; };
__device__ __forceinline__ BlockRef make_ref(const Item& it, int pass, const Tensors& T) {
    const int qb = pass ? it.qb1 : it.qb0, b = it.bh >> 4, h = it.bh & 15, kvh = h >> 2;
    BlockRef r;
    r.Q = T.Q + ((size_t)b * SEQ + (size_t)qb * QB) * QP + h * D; r.O = T.O + ((size_t)b * SEQ + (size_t)qb * QB) * QP + h * D;
    r.K = T.K + (size_t)b * SEQ * KP + kvh * D; r.V = T.V + (size_t)b * SEQ * KP + kvh * D; r.M = T.M + (size_t)b * 64 * SEQ; r.P0 = qb * QB;
    return r;
}
__device__ __forceinline__ void attn_phase(char* lds, const Tensors& T, int wg, int nwg) {
    constexpr int total = 512;
    int L = wg; if (L >= total) return;
    Item it = decode(L); int pass = 0;
    BlockRef cur = make_ref(it, 0, T);
    Seam S;
    attn_prime(cur, lds, S);
    for (;;) {
        const bool more_pass = pass == 0 && it.qb1 != it.qb0, more_item = L + nwg < total, last = !more_pass && !more_item;
        Item itn = it; int passn = pass + 1, Ln = L;
        if (!more_pass) { passn = 0; Ln = more_item ? L + nwg : L; itn = decode(Ln); }
        const BlockRef nxt = last ? cur : make_ref(itn, passn, T);
        attn_block(cur, nxt, lds, S);
        if (last) break;
        cur = nxt; it = itn; pass = passn; L = Ln;
    }
}
#undef KSWZ
#undef SBAR
}
constexpr int NWAVES = 8;
#ifndef DBG_P0_TIME
#define DBG_P0_TIME 0
#endif
#define P0T_BEGIN(k) unsigned long long p0t##k = 0; if (DBG_P0_TIME == (k) && blockIdx.x == 0 && threadIdx.x == 0) p0t##k = __builtin_amdgcn_s_memrealtime()
#define P0T_END(k) do { if (DBG_P0_TIME == (k) && blockIdx.x == 0 && threadIdx.x == 0) { asm volatile("s_waitcnt vmcnt(0)" ::: "memory"); F.MISC[20] += (unsigned)(__builtin_amdgcn_s_memrealtime() - p0t##k); } } while (0)
#ifndef P0_NT
#define P0_NT 1
#endif
#if P0_NT
#define P0_LOAD(p) __builtin_nontemporal_load(p)
#else
#define P0_LOAD(p) (*(p))
#endif
#ifndef DBG_IDX_TID
#define DBG_IDX_TID 0
#endif
#ifndef DBG_IDX_TIME
#define DBG_IDX_TIME 0
#endif
#define IDXT_BEGIN(k) unsigned long long idxt_ = 0; if (DBG_IDX_TIME == (k) && blockIdx.x == 0 && threadIdx.x == DBG_IDX_TID) idxt_ = __builtin_amdgcn_s_memrealtime()
#define IDXT_END(k) do { if (DBG_IDX_TIME == (k) && blockIdx.x == 0 && threadIdx.x == DBG_IDX_TID) { const unsigned long long d_ = __builtin_amdgcn_s_memrealtime() - idxt_; F.MISC[20] += (unsigned)d_; } } while (0)
#ifndef C2_FP8
#define C2_FP8 0x8
#endif
#ifndef C1_FP8
#define C1_FP8 0x8
#endif
#ifndef M1_FP8
#define M1_FP8 0xC
#endif
#ifndef MLP_FP8
#define MLP_FP8 0xE
#endif
#ifndef DBG_TIME_PHASE
#define DBG_TIME_PHASE -1
#endif
#ifndef DBG_TIME_TO
#define DBG_TIME_TO (DBG_TIME_PHASE + 1)
#endif
#ifndef DBG_CLK_PHASE
#define DBG_CLK_PHASE -1
#endif
#define CLKSTAMP(k) do { if (DBG_CLK_PHASE >= 0 && (DBG_CLK_PHASE == (k) || DBG_CLK_PHASE + 1 == (k)) && blockIdx.x == 0 && threadIdx.x == 0) { const unsigned long long c_ = __builtin_readcyclecounter(), r_ = __builtin_amdgcn_s_memrealtime(); \
    volatile LAS unsigned* m_ = F.MISC + (DBG_CLK_PHASE == (k) ? 32 : 36); m_[0] = (unsigned)c_; m_[1] = (unsigned)(c_ >> 32); m_[2] = (unsigned)r_; m_[3] = (unsigned)(r_ >> 32); } } while (0)
#define STAMP(k) do { CLKSTAMP(k); if (DBG_TIME_PHASE >= 0 && (DBG_TIME_PHASE == (k) || DBG_TIME_TO == (k)) && blockIdx.x == 0 && threadIdx.x == 0) { const unsigned long long ts_ = __builtin_amdgcn_s_memrealtime(); volatile LAS unsigned* m_ = F.MISC + (DBG_TIME_PHASE == (k) ? 16 : 18); m_[0] = (unsigned)ts_; m_[1] = (unsigned)(ts_ >> 32); } } while (0)
#ifndef DBG_IDX_REP_SCORE
#define DBG_IDX_REP_SCORE 0
#endif
#ifndef DBG_IDX_REP_SEL
#define DBG_IDX_REP_SEL 0
#endif
#ifndef PG8_ALIGN_X
#define PG8_ALIGN_X true
#endif
#ifndef PG8_SP2_F8
#define PG8_SP2_F8 true
#endif
#ifndef PG8_SP2_X
#define PG8_SP2_X true
#endif
#ifndef DBG_A4_SRC
#define DBG_A4_SRC WS_O
#endif
#ifndef MK_PER_PHASE
#define MK_PER_PHASE 0
#endif
constexpr int BATCH = 4, SEQ = 4096, DM = 2048, M = BATCH * SEQ, DFF = 8192, DEPTH = 4;
constexpr int NA1 = 4352, NA1_SRC = 4176, NC1 = 6144;
constexpr int TOPK = 256;
constexpr size_t MiB = 1u << 20;
constexpr size_t WS_CTL = 0, CTL_ZERO_BYTES = 3 * MiB;
constexpr int CW_P0Q = 8192;
constexpr int CW_BAR = 4096;
constexpr size_t WS_SSQ = 1 * MiB;
constexpr size_t WS_ROPEM = 3 * MiB;
constexpr size_t WS_ROPEI = 5 * MiB;
constexpr size_t WS_SMALL = WS_ROPEI + 512 * 1024;
constexpr size_t WS_QG = WS_SMALL, WS_KG = WS_SMALL + 1024, WS_CONVW = WS_SMALL + 4096, WS_INPTR = WS_SMALL + 65536;
constexpr size_t WS_WA1 = 6 * MiB;  static_assert(WS_SSQ + 9 * (size_t)M * 8 <= CTL_ZERO_BYTES, "ssq inside memset");
constexpr size_t SZ_WA1 = (size_t)NA1 * DM * 2;
constexpr size_t WS_WA4 = WS_WA1 + 2 * SZ_WA1;
constexpr size_t SZ_WSQ = (size_t)DM * DM * 2;
constexpr size_t WS_WC1 = WS_WA4 + 2 * SZ_WSQ;
constexpr size_t SZ_WC1 = (size_t)NC1 * DM * 2;
constexpr size_t WS_WC2 = WS_WC1 + 2 * SZ_WC1;
constexpr size_t WS_WM1 = WS_WC2 + 2 * SZ_WSQ;
constexpr size_t SZ_WM = (size_t)DFF * DM * 2;
constexpr size_t WS_WM2 = WS_WM1 + 4 * SZ_WM;
constexpr size_t WS_XB = WS_WM2 + 4 * SZ_WM;
constexpr size_t WS_ACT = WS_XB + (size_t)M * DM * 2;
constexpr size_t SZ_MD = (size_t)M * DM * 2;
constexpr size_t WS_H = WS_ACT;
constexpr size_t WS_Q = WS_ACT, WS_O = WS_ACT + SZ_MD, WS_K = WS_ACT + 2 * SZ_MD, WS_V = WS_K + 16 * MiB, WS_QI = WS_V + 16 * MiB, WS_KI = WS_QI + 32 * MiB,
                 WS_WI = WS_KI + 2 * MiB, WS_MASK = WS_WI + 1 * MiB;
constexpr size_t WS_BG = WS_ACT, WS_Z = WS_ACT + SZ_MD, WS_G = WS_ACT + 2 * SZ_MD;
constexpr size_t WS_END = WS_ACT + 256 * MiB;
constexpr size_t WS_XB8 = WS_END;
static_assert(WS_MASK + 8 * MiB <= WS_END && WS_G + SZ_MD <= WS_END && WS_H + (size_t)M * DFF * 2 <= WS_END, "d_ws map");
constexpr int RING_OFF = 0, RING_BYTES = 131072;
constexpr int AUX_OFF = RING_BYTES, AUX_BYTES = 16384 + 2048 + 512;
constexpr int MISC_OFF = AUX_OFF + AUX_BYTES;
constexpr int WQ_OFF = MISC_OFF + 256;
constexpr int LDS_BYTES = WQ_OFF + 512;
static_assert(LDS_BYTES <= 160 * 1024 && MISC_OFF == 150016, "LDS map");

#define GAS __attribute__((address_space(1)))
#define LAS __attribute__((address_space(3)))
typedef unsigned short bf16;
typedef unsigned v4u __attribute__((ext_vector_type(4)));
typedef unsigned v2u __attribute__((ext_vector_type(2)));
typedef float f32x4 __attribute__((ext_vector_type(4)));
typedef short bf16x8 __attribute__((ext_vector_type(8)));
typedef float f32x16 __attribute__((ext_vector_type(16)));
typedef GAS unsigned gu32;
#define RLX_AGENT __ATOMIC_RELAXED, __HIP_MEMORY_SCOPE_AGENT
#define LDS_WAIT() asm volatile("s_waitcnt lgkmcnt(0)" ::: "memory")
#define VM_WAIT() asm volatile("s_waitcnt vmcnt(0)" ::: "memory")
__device__ __forceinline__ unsigned f2bf(float f) { unsigned u = __builtin_bit_cast(unsigned, f); return (u + 0x7fffu + ((u >> 16) & 1u)) >> 16; }
__device__ __forceinline__ unsigned pk2(float lo, float hi) { return f2bf(lo) | (f2bf(hi) << 16); }
__device__ __forceinline__ float bf2f(unsigned short b) { return __uint_as_float((unsigned)b << 16); }
__device__ __forceinline__ float wave_sum(float v) {
#pragma unroll
    for (int o = 1; o < 64; o <<= 1) v += __shfl_xor(v, o);
    return v;
}
__device__ __forceinline__ float wave_min(float v) {
#pragma unroll
    for (int o = 1; o < 64; o <<= 1) v = fminf(v, __shfl_xor(v, o));
    return v;
}
__device__ __forceinline__ float wave_max(float v) {
#pragma unroll
    for (int o = 1; o < 64; o <<= 1) v = fmaxf(v, __shfl_xor(v, o));
    return v;
}

#define XB_TMO      128
#define XB_XCNT(j)  (256  + 64 * (j))
#define XB_XSUB(j)  (1280 + 64 * (j))
#define XB_XGEN(j)  (2304 + 64 * (j))
#define XB_TOP      3328
#define XB_TOPGEN   3392
#define XCD_BAR_WORDS 3456
#define XB_SPIN_CAP (1u << 18)

__device__ __forceinline__ unsigned xb_ld(unsigned* p)              { return __hip_atomic_load(p, __ATOMIC_RELAXED, __HIP_MEMORY_SCOPE_AGENT); }
__device__ __forceinline__ unsigned xb_add(unsigned* p, unsigned v) { return __hip_atomic_fetch_add(p, v, __ATOMIC_RELAXED, __HIP_MEMORY_SCOPE_AGENT); }
__device__ __forceinline__ unsigned xb_xcc_id() { return (unsigned)__builtin_amdgcn_s_getreg((3 << 11) | 20) & 0xFu; }
#define XB_SPIN(cond, bar) do { unsigned _sp = 0; while (cond) { __builtin_amdgcn_s_sleep(1); \
    if ((++_sp & 255u) == 0u) { if (xb_ld(&(bar)[XB_TMO])) break; if (_sp > XB_SPIN_CAP) { atomicAdd(&(bar)[XB_TMO], 1u); break; } } } } while (0)

struct XcdBarrier {
    unsigned* bar; unsigned x;
    volatile LAS unsigned* st;
};

__device__ __forceinline__ XcdBarrier xcd_barrier_post(unsigned* bar, volatile LAS unsigned* st) {
    XcdBarrier b; b.bar = bar; b.x = xb_xcc_id(); b.st = st;
    if (threadIdx.x == 0) (void)xb_add(&bar[XB_XCNT(b.x)], 1u);
    return b;
}
__device__ __forceinline__ void xcd_barrier_complete(unsigned* bar, unsigned x, unsigned& nloc, unsigned& nx) {
    const unsigned G = gridDim.x * gridDim.y * gridDim.z;
    unsigned sum, cnt, mine, sp = 0u;
    for (;;) {
        sum = 0u; cnt = 0u; mine = 0u;
#pragma unroll
        for (unsigned j = 0; j < 16; ++j) { const unsigned c = xb_ld(&bar[XB_XCNT(j)]); sum += c; cnt += (c > 0u) ? 1u : 0u; mine = (j == x) ? c : mine; }
        if (sum == G) break;
        __builtin_amdgcn_s_sleep(1);
        if ((++sp & 255u) == 0u) { if (xb_ld(&bar[XB_TMO])) break; if (sp > XB_SPIN_CAP) { atomicAdd(&bar[XB_TMO], 1u); break; } }
    }
    nloc = mine > 0u ? mine : 1u; nx = cnt > 0u ? cnt : 1u;
}

__device__ __forceinline__ void xcd_barrier(const XcdBarrier& b) {
    asm volatile("s_waitcnt vmcnt(0)" ::: "memory");
    __syncthreads();
    if (threadIdx.x == 0) {
        unsigned* bar = b.bar;
        __builtin_amdgcn_s_waitcnt(0);
        unsigned nloc = b.st[0], nx = b.st[1];
        if (nloc == 0u) { xcd_barrier_complete(bar, b.x, nloc, nx); b.st[0] = nloc; b.st[1] = nx; }
        const unsigned old = xb_add(&bar[XB_XSUB(b.x)], 1u);
        const unsigned gen = old / nloc;
        if (old + 1u == (gen + 1u) * nloc) {
            __builtin_amdgcn_fence(__ATOMIC_RELEASE, "agent");
            asm volatile("s_waitcnt vmcnt(0)" ::: "memory");
            const unsigned og = xb_add(&bar[XB_TOP], 1u);
            const unsigned tg = og / nx;
            if (og + 1u == (tg + 1u) * nx) xb_add(&bar[XB_TOPGEN], 1u);
            else XB_SPIN(xb_ld(&bar[XB_TOPGEN]) == tg, bar);
            __builtin_amdgcn_fence(__ATOMIC_ACQUIRE, "agent");
            xb_add(&bar[XB_XGEN(b.x)], 1u);
            asm volatile("s_waitcnt vmcnt(0)" ::: "memory");
        } else {
            XB_SPIN(xb_ld(&bar[XB_XGEN(b.x)]) == gen, bar);
            __builtin_amdgcn_fence(__ATOMIC_ACQUIRE, "agent");
            asm volatile("s_waitcnt vmcnt(0)" ::: "memory");
        }
    }
    __syncthreads();
}

struct Frame {
    LAS unsigned char* lds;
    volatile LAS unsigned* MISC;
    gu32* ctl;
    int tid, lane, wave, vcu, G;
    unsigned char* ws;
};

__device__ __forceinline__ int dmap64(int s) { if (s >= 32) return s; const int nn = s >> 4, fq = (s >> 2) & 3, j = s & 3; return fq < 2 ? 8 * nn + 4 * fq + j : 16 + 8 * nn + 4 * (fq - 2) + j; }
__device__ __forceinline__ int src_col(int kind, int n) {
    if (kind == 0) return n;
    const int pn = n >> 8, p = n & 255;
    if (kind == 1) {
        if (pn < 12) return n;
        if (pn < 16) return 3072 + (pn - 12) * 256 + (p >> 6) * 64 + dmap64(p & 63);
        if (p < 64) return 4096 + dmap64(p);
        if (p < 80) return 4160 + (p - 64);
        return -1;
    }
    if (pn < 8) return n;
    const int i = pn - 8; return p < 128 ? 2048 + 128 * i + p : 4096 + 128 * i + (p - 128);
}
struct P0Desc { const float* src; const float* g; bf16* dst; int Nsrc, K, fp8, hasg; };
__device__ __forceinline__ void p0_desc(const float* W, const float* g, int K, int Nsrc, int Npad, int kind, bf16* WT, int item, int lane, P0Desc& d, int fp8 = 0) {
    const int nblk = Npad / 32, kb = item / nblk, nb = item % nblk, kg = lane >> 3, ng = lane & 7, k0 = 64 * kb + 8 * kg, n0 = 32 * nb + 4 * ng;
    const int col = src_col(kind, n0);
    d.src = col >= 0 ? W + (size_t)k0 * Nsrc + col : nullptr; d.g = g ? g + k0 : nullptr; d.dst = fp8 ? (bf16*)((unsigned char*)WT + (size_t)n0 * K + k0) : WT + (size_t)n0 * K + k0; d.Nsrc = Nsrc; d.K = K; d.fp8 = fp8; d.hasg = g != nullptr;
}
__device__ __forceinline__ void p0_load(const P0Desc& d, f32x4 (&v)[8], f32x4& ga, f32x4& gb) {
#pragma unroll
    for (int i = 0; i < 8; ++i) v[i] = d.src ? P0_LOAD((const f32x4*)(d.src + (size_t)i * d.Nsrc)) : (f32x4){0.f, 0.f, 0.f, 0.f};
    if (d.g) { ga = *(const f32x4*)d.g; gb = *(const f32x4*)(d.g + 4); } else { ga = (f32x4){1.f, 1.f, 1.f, 1.f}; gb = ga; }
}
#ifndef P0_HWPK
#define P0_HWPK 1
#endif
#if P0_HWPK
#define P0_PK(a, b) pg8::cvt_pk_bf16(a, b)
#else
#define P0_PK(a, b) pk2(a, b)
#endif
__device__ __forceinline__ void p0_load_nn(const P0Desc& d, f32x4 (&v)[8], f32x4& ga, f32x4& gb) {
    const GAS float* sp = (const GAS float*)d.src;
#pragma unroll
    for (int i = 0; i < 8; ++i) v[i] = P0_LOAD((const GAS f32x4*)(sp + (size_t)i * d.Nsrc));
    if (d.hasg) { const GAS float* gp = (const GAS float*)d.g; ga = *(const GAS f32x4*)gp; gb = *(const GAS f32x4*)(gp + 4); } else { ga = (f32x4){1.f, 1.f, 1.f, 1.f}; gb = ga; }
}
template <bool NT = false> __device__ __forceinline__ void p0_store(const P0Desc& d, const f32x4 (&v)[8], const f32x4& ga, const f32x4& gb) {
    if (d.fp8) {
        const float s = d.fp8 == 2 ? pg8::FP8_SWC : pg8::FP8_SW; float gs[8];
#pragma unroll
        for (int i = 0; i < 8; ++i) gs[i] = (i < 4 ? ga[i & 3] : gb[i & 3]) * s;
#pragma unroll
        for (int q = 0; q < 4; ++q) { int w0 = 0, w1 = 0;
            float e[8];
#pragma unroll
            for (int i = 0; i < 8; ++i) e[i] = __builtin_amdgcn_fmed3f(v[i][q] * gs[i], -448.f, 448.f);
            w0 = __builtin_amdgcn_cvt_pk_fp8_f32(e[0], e[1], w0, false); w0 = __builtin_amdgcn_cvt_pk_fp8_f32(e[2], e[3], w0, true);
            w1 = __builtin_amdgcn_cvt_pk_fp8_f32(e[4], e[5], w1, false); w1 = __builtin_amdgcn_cvt_pk_fp8_f32(e[6], e[7], w1, true);
            v2u o; o.x = (unsigned)w0; o.y = (unsigned)w1; if (NT) __builtin_nontemporal_store(o, (GAS v2u*)((unsigned char*)d.dst + (size_t)q * d.K)); else *(GAS v2u*)((unsigned char*)d.dst + (size_t)q * d.K) = o; }
        return; }
    if (!d.hasg) {
#pragma unroll
        for (int q = 0; q < 4; ++q) { v4u o; o.x = P0_PK(v[0][q], v[1][q]); o.y = P0_PK(v[2][q], v[3][q]); o.z = P0_PK(v[4][q], v[5][q]); o.w = P0_PK(v[6][q], v[7][q]);
            if (NT) __builtin_nontemporal_store(o, (GAS v4u*)(d.dst + (size_t)q * d.K)); else *(GAS v4u*)(d.dst + (size_t)q * d.K) = o; }
        return; }
#pragma unroll
    for (int q = 0; q < 4; ++q) { v4u o; o.x = P0_PK(v[0][q] * ga[0], v[1][q] * ga[1]); o.y = P0_PK(v[2][q] * ga[2], v[3][q] * ga[3]); o.z = P0_PK(v[4][q] * gb[0], v[5][q] * gb[1]); o.w = P0_PK(v[6][q] * gb[2], v[7][q] * gb[3]);
        if (NT) __builtin_nontemporal_store(o, (GAS v4u*)(d.dst + (size_t)q * d.K)); else *(GAS v4u*)(d.dst + (size_t)q * d.K) = o; }
}
struct Inputs { const float* x; const int* pos; const float *attn_norm_g, *attn_w_in, *attn_q_g, *attn_k_g, *attn_w_out, *conv_norm_g, *conv_w_in, *conv_w, *conv_w_out, *mlp_norm_g, *mlp_w1, *mlp_w2; };
constexpr int I_A1 = (DM / 64) * (NA1 / 32), I_SQ = (DM / 64) * (DM / 32), I_C1 = (DM / 64) * (NC1 / 32), I_M1 = (DM / 64) * (DFF / 32), I_M2 = (DFF / 64) * (DM / 32);
constexpr int PER_J = I_A1 + I_SQ + I_C1 + I_SQ, PER_I = I_M1 + I_M2, NITEMS = 2 * PER_J + 4 * PER_I;
__device__ __forceinline__ void p0_item_desc(Frame& F, const Inputs& I, int it, P0Desc& d, int lane_ = -1) {
    int r = it; const int ln_ = lane_ >= 0 ? lane_ : F.lane;
    if (r < 2 * PER_J) { const int j = r / PER_J; r -= j * PER_J;
        if (r < I_A1) { p0_desc(I.attn_w_in + (size_t)j * DM * NA1_SRC, I.attn_norm_g + j * DM, DM, NA1_SRC, NA1, 1, (bf16*)(F.ws + WS_WA1 + j * SZ_WA1), r, ln_, d); return; } r -= I_A1;
        if (r < I_SQ) { p0_desc(I.attn_w_out + (size_t)j * DM * DM, nullptr, DM, DM, DM, 0, (bf16*)(F.ws + WS_WA4 + j * SZ_WSQ), r, ln_, d); return; } r -= I_SQ;
        if (r < I_C1) { p0_desc(I.conv_w_in + (size_t)j * DM * NC1, I.conv_norm_g + j * DM, DM, NC1, NC1, 2, (bf16*)(F.ws + WS_WC1 + j * SZ_WC1), r, ln_, d, ((C1_FP8 >> (2 * j + 1)) & 1) ? 2 : 0); return; } r -= I_C1;
        p0_desc(I.conv_w_out + (size_t)j * DM * DM, nullptr, DM, DM, DM, 0, (bf16*)(F.ws + WS_WC2 + j * SZ_WSQ), r, ln_, d, ((C2_FP8 >> (2 * j + 1)) & 1) ? 2 : 0); return; }
    r -= 2 * PER_J; const int i = r / PER_I; r -= i * PER_I;
    if (r < I_M1) { p0_desc(I.mlp_w1 + (size_t)i * DM * DFF, I.mlp_norm_g + i * DM, DM, DFF, DFF, 0, (bf16*)(F.ws + WS_WM1 + i * SZ_WM), r, ln_, d, ((M1_FP8 >> i) & 1) ? 2 : 0); return; } r -= I_M1;
    p0_desc(I.mlp_w2 + (size_t)i * DFF * DM, nullptr, DFF, DM, DM, 0, (bf16*)(F.ws + WS_WM2 + i * SZ_WM), r, ln_, d, (MLP_FP8 >> i) & 1);
}
struct ItemRanges { int lo[4], hi[4]; };
__device__ __forceinline__ int range_item(const ItemRanges& R, int c) {
#pragma unroll
    for (int k = 0; k < 4; ++k) { const int len = R.hi[k] - R.lo[k]; if (c < len) return R.lo[k] + c; c -= len; }
    return -1;
}
__device__ __forceinline__ void convert_ranges(Frame& F, const Inputs& I, const ItemRanges& R, int gw, int nw) {
    const int total = (R.hi[0] - R.lo[0]) + (R.hi[1] - R.lo[1]) + (R.hi[2] - R.lo[2]) + (R.hi[3] - R.lo[3]);
    f32x4 va[8], vb[8], gaa, gab, gba, gbb; P0Desc da, db;
    int c = gw; bool ha = c < total;
    if (ha) { p0_item_desc(F, I, range_item(R, c), da); p0_load(da, va, gaa, gab); }
    while (ha) {
        const int cn = c + nw; const bool hb = cn < total;
        if (hb) { p0_item_desc(F, I, range_item(R, cn), db); p0_load(db, vb, gba, gbb); }
        p0_store(da, va, gaa, gab);
        c = cn; ha = hb; da = db; gaa = gba; gab = gbb;
#pragma unroll
        for (int i = 0; i < 8; ++i) va[i] = vb[i];
    }
}
#ifndef DEFER_CONV
#define DEFER_CONV 2
#endif
#ifndef A2_NT_STORE
#define A2_NT_STORE 0
#endif
#ifndef A2_STORE_MID
#define A2_STORE_MID 0
#endif
#ifndef A2_NOASSERT
#define A2_NOASSERT 0
#endif
#ifndef A2_NCV
#define A2_NCV 2
#endif
#ifndef A2_SPLIT
#define A2_SPLIT 4096
#endif
__device__ __forceinline__ const float* in_ptr(const unsigned char* ws, const int field) {
    unsigned long long p_; asm volatile("s_load_dwordx2 %0, %1, %2\n\ts_waitcnt lgkmcnt(0)" : "=s"(p_) : "s"(ws + WS_INPTR), "n"(field * 8) : "memory"); return (const float*)p_; }
__device__ __forceinline__ void a2_item_desc(Frame& F, int j, int c, int lane, P0Desc& d) {
    if (c < I_SQ) { p0_desc(in_ptr(F.ws, 6) + (size_t)j * DM * DM, nullptr, DM, DM, DM, 0, (bf16*)(F.ws + WS_WA4 + j * SZ_WSQ), c, lane, d); return; }
    c -= I_SQ; int i = 2 * j;
    if (c >= PER_I) { c += A2_SPLIT - PER_I; i += 1; }
    if (c < I_M1) { p0_desc(in_ptr(F.ws, 12) + (size_t)i * DM * DFF, in_ptr(F.ws, 11) + i * DM, DM, DFF, DFF, 0, (bf16*)(F.ws + WS_WM1 + (size_t)i * SZ_WM), c, lane, d, ((M1_FP8 >> i) & 1) ? 2 : 0); return; }
    c -= I_M1;
    p0_desc(in_ptr(F.ws, 13) + (size_t)i * DFF * DM, nullptr, DFF, DM, DM, 0, (bf16*)(F.ws + WS_WM2 + (size_t)i * SZ_WM), c, lane, d, (MLP_FP8 >> i) & 1);
}
__device__ __forceinline__ ItemRanges ranges_a2(int j) {
    return ItemRanges{{j * PER_J + I_A1, 2 * PER_J + 2 * j * PER_I, 2 * PER_J + (2 * j + 1) * PER_I + A2_SPLIT, 0}, {j * PER_J + I_A1 + I_SQ, 2 * PER_J + (2 * j + 1) * PER_I, 2 * PER_J + (2 * j + 2) * PER_I, 0}}; }
constexpr int A2_ITEMS = I_SQ + PER_I + (PER_I - A2_SPLIT);
__device__ __forceinline__ ItemRanges ranges_p0() { if (DEFER_CONV == 2) return ItemRanges{{0, PER_J, 0, 0}, {I_A1, PER_J + I_A1, 0, 0}};
    if (DEFER_CONV) return ItemRanges{{0, PER_J, 2 * PER_J, 2 * PER_J + 2 * PER_I}, {I_A1 + I_SQ, PER_J + I_A1 + I_SQ, 2 * PER_J + PER_I, 2 * PER_J + 3 * PER_I}}; return ItemRanges{{0, 0, 0, 0}, {NITEMS, 0, 0, 0}}; }
__device__ __forceinline__ ItemRanges ranges_deferred(int j) {
    if (DEFER_CONV == 2) return ItemRanges{{j * PER_J + I_A1 + I_SQ, 2 * PER_J + (2 * j + 1) * PER_I, 0, 0}, {(j + 1) * PER_J, 2 * PER_J + (2 * j + 1) * PER_I + A2_SPLIT, 0, 0}};
    return ItemRanges{{j * PER_J + I_A1 + I_SQ, 2 * PER_J + (2 * j + 1) * PER_I, 0, 0}, {(j + 1) * PER_J, 2 * PER_J + (2 * j + 2) * PER_I, 0, 0}}; }
__device__ __forceinline__ void p0_prologue(Frame& F, const Inputs& I, float* out) {
    const int gw = F.vcu * NWAVES + F.wave, NGW = F.G * NWAVES;
    if (blockIdx.x == 0 && F.tid == 0) {
        Inputs* d_ = (Inputs*)(F.ws + WS_INPTR);
        d_->x = I.x; d_->pos = I.pos; d_->attn_norm_g = I.attn_norm_g; d_->attn_w_in = I.attn_w_in; d_->attn_q_g = I.attn_q_g; d_->attn_k_g = I.attn_k_g; d_->attn_w_out = I.attn_w_out;
        d_->conv_norm_g = I.conv_norm_g; d_->conv_w_in = I.conv_w_in; d_->conv_w = I.conv_w; d_->conv_w_out = I.conv_w_out; d_->mlp_norm_g = I.mlp_norm_g; d_->mlp_w1 = I.mlp_w1; d_->mlp_w2 = I.mlp_w2; }
    P0T_BEGIN(2);
    bf16* xb = (bf16*)(F.ws + WS_XB); pg8::ssq_t* ssq0 = (pg8::ssq_t*)(F.ws + WS_SSQ);
    {
        f32x4 va[8], vb[8]; int m = gw; bool ha = m < M;
        if (ha) { const GAS f32x4* xr = (const GAS f32x4*)(I.x + (size_t)m * DM) + F.lane;
#pragma unroll
            for (int j = 0; j < 8; ++j) va[j] = __builtin_nontemporal_load(xr + 64 * j); }
        while (ha) {
            const int mn = m + NGW; const bool hb = mn < M;
            if (hb) { const GAS f32x4* xr = (const GAS f32x4*)(I.x + (size_t)mn * DM) + F.lane;
#pragma unroll
                for (int j = 0; j < 8; ++j) vb[j] = __builtin_nontemporal_load(xr + 64 * j); }
            GAS unsigned long long* o8 = (GAS unsigned long long*)(xb + (size_t)m * DM) + F.lane; float s = 0.f;
#pragma unroll
            for (int j = 0; j < 8; ++j) { const f32x4 v = va[j]; s += (v.x * v.x + v.y * v.y) + (v.z * v.z + v.w * v.w);
                o8[64 * j] = (unsigned long long)pk2(v.x, v.y) | ((unsigned long long)pk2(v.z, v.w) << 32); }
            s = wave_sum(s); if (F.lane == 0) ssq0[m] = pg8::ssq_fix(s);
            m = mn; ha = hb;
#pragma unroll
            for (int j = 0; j < 8; ++j) va[j] = vb[j];
        }
    }
    P0T_END(2); P0T_BEGIN(3);
    unsigned* ropeM = (unsigned*)(F.ws + WS_ROPEM); unsigned* ropeI = (unsigned*)(F.ws + WS_ROPEI);
    for (int e = F.vcu * 512 + F.tid; e < M * 24; e += F.G * 512) {
        const int row = e / 24, d = e % 24; const float p = (float)I.pos[row];
        const float ex = d < 16 ? -(float)d * (1.0f / 16.0f) : -(float)(d - 16) * (1.0f / 8.0f);
        const float inv = __builtin_amdgcn_exp2f(ex * 18.931568569324174f);
        const float ang = p * inv;
        double rev = (double)ang * 0.15915494309189535; rev -= __builtin_floor(rev); const float rf = (float)rev;
        const float c = __builtin_amdgcn_cosf(rf), s = __builtin_amdgcn_sinf(rf);
        const unsigned pk = (unsigned)__builtin_bit_cast(unsigned short, (_Float16)c) | ((unsigned)__builtin_bit_cast(unsigned short, (_Float16)s) << 16);
        if (d < 16) ropeM[(size_t)row * 16 + d] = pk; else ropeI[(size_t)row * 8 + (d - 16)] = pk;
    }
    { float* qg = (float*)(F.ws + WS_QG); float* kg = (float*)(F.ws + WS_KG); float* cw = (float*)(F.ws + WS_CONVW);
      for (int e = F.vcu * 512 + F.tid; e < 2 * 3 * DM; e += F.G * 512) { cw[e] = I.conv_w[e]; if (e < 256) { qg[e] = I.attn_q_g[e]; kg[e] = I.attn_k_g[e]; } } }
    P0T_END(3); P0T_BEGIN(1);
    convert_ranges(F, I, ranges_p0(), gw, NGW);
    P0T_END(1);
    (void)out;
}

__device__ __forceinline__ float relu_i(float x) { const int i = __float_as_int(x); return __int_as_float(i > 0 ? i : 0); }
struct IdxTensors { const bf16* QI; const bf16* KI; const float* WI; unsigned long long* MASK; float* dbg; };
#define DBG_OUT T.dbg
__device__ __forceinline__ void idx_phase(Frame& F, const IdxTensors& T, const int cj) {
    static_assert(DEFER_CONV != 2 || A2_NOASSERT || A2_ITEMS <= A2_NCV * 2048 * NWAVES, "the indexer's conversion slots do not cover its items");
    typedef float f32x2 __attribute__((ext_vector_type(2)));
    LAS float* scores = (LAS float*)(F.lds + RING_OFF);
    LAS unsigned* hist = (LAS unsigned*)(F.lds + AUX_OFF) + F.wave * 512;
    LAS float* cand = (LAS float*)(F.lds + AUX_OFF + 16384) + F.wave * 64;
    LAS float* mm = (LAS float*)(F.lds + AUX_OFF + 16384 + 2048);
    int tid_ = threadIdx.x; asm volatile("" : "+v"(tid_));
    const int lane = tid_ & 63, w = F.wave, c32 = lane & 31, hi = lane >> 5;
    const float INF = __builtin_inff();
    const int qsel = (c32 >> 2) & 1, hh = (c32 & 3) + 4 * (c32 >> 3);
    bf16x8 afr[4][4]; bf16x8 bcur[4];
#define IDX_DECODE(uu_, b_, t0_) const int idx_ = (uu_) & 255, rr_ = (uu_) >> 8; b_ = rr_ >> 1; t0_ = ((rr_ & 1) ? 511 - idx_ : idx_) * 8
    const int qrow_w = 16 * w + (lane >> 2), qch = 2 * (lane & 3);
    LAS unsigned char* const qlds = F.lds + AUX_OFF;
#define QI_FETCH(b_, t0_) do { const bf16* qp_ = T.QI + ((size_t)((b_) * SEQ + (t0_) + w) * 1024 + lane * 16); qpre0 = *(const bf16x8*)qp_; qpre1 = *(const bf16x8*)(qp_ + 8); } while (0)
#define QI_PARK() do { *(LAS bf16x8*)(qlds + qrow_w * 128 + (((qch) ^ (qrow_w & 7)) << 4)) = qpre0; *(LAS bf16x8*)(qlds + qrow_w * 128 + (((qch + 1) ^ (qrow_w & 7)) << 4)) = qpre1; } while (0)
#define QI_READ() do { _Pragma("unroll") for (int p = 0; p < 4; ++p) _Pragma("unroll") for (int kk = 0; kk < 4; ++kk) { const int r_ = (qsel + 2 * p) * 16 + hh; \
            afr[p][kk] = *(const LAS bf16x8*)(qlds + r_ * 128 + (((hi + 2 * kk) ^ (r_ & 7)) << 4)); } } while (0)
#define IDX_LOAD(b_, t0_) do { \
        const int nt_ = ((t0_) + 7) / 32 + 1; const int j0_ = w < nt_ ? w : 0; \
        const bf16* kb_ = T.KI + (size_t)(b_) * SEQ * 64 + (size_t)c32 * 64 + 8 * hi + (size_t)j0_ * 32 * 64; \
        _Pragma("unroll") for (int kk = 0; kk < 4; ++kk) bcur[kk] = *(const bf16x8*)(kb_ + 16 * kk); } while (0)
    int uu = blockIdx.x; int b = 0, t0 = 0;
    if (uu < 2048) { IDX_DECODE(uu, b, t0); if (tid_ < 128) ((LAS float*)(F.lds + WQ_OFF))[tid_] = T.WI[(size_t)(b * SEQ + t0) * 16 + tid_]; bf16x8 qpre0, qpre1; QI_FETCH(b, t0); IDX_LOAD(b, t0); QI_PARK(); }
    LDS_WAIT(); __syncthreads();
    for (; uu < 2048; uu += F.G) {
        { IDXT_BEGIN(1);
        for (int srep = 0; srep < 1 + DBG_IDX_REP_SCORE; ++srep) {
            QI_READ();
            f32x2 wq[4][8];
            { const LAS float* wrow = (const LAS float*)(F.lds + WQ_OFF) + hi * 16;
#pragma unroll
              for (int p = 0; p < 4; ++p)
#pragma unroll
                  for (int i = 0; i < 4; ++i) { const f32x4 t4 = *(const LAS f32x4*)(wrow + p * 32 + 4 * i); wq[p][2 * i] = (f32x2){t4[0], t4[1]}; wq[p][2 * i + 1] = (f32x2){t4[2], t4[3]}; } }
            const int ntile = (t0 + 7) / 32 + 1;
            const bf16* kbase = T.KI + (size_t)b * SEQ * 64 + (size_t)c32 * 64 + 8 * hi;
            LAS float* srow = scores + hi * 4096 + c32;
            float vmax[4], vmin[4];
#pragma unroll
            for (int p = 0; p < 4; ++p) { vmax[p] = -INF; vmin[p] = INF; }
            bf16x8 bnxt[4];
            for (int jt = w; jt < ntile; jt += 8) {
                const int jn = jt + 8 < ntile ? jt + 8 : jt;
#pragma unroll
                for (int kk = 0; kk < 4; ++kk) bnxt[kk] = *(const bf16x8*)(kbase + (size_t)jn * 32 * 64 + 16 * kk);
                const int krel = jt * 32 + c32 - t0 - hi;
#pragma unroll
                for (int ph = 0; ph < 2; ++ph) {
                    f32x16 acc0 = {}, acc1 = {};
#pragma unroll
                    for (int kk = 0; kk < 4; ++kk) { acc0 = __builtin_amdgcn_mfma_f32_32x32x16_bf16(afr[2 * ph][kk], bcur[kk], acc0, 0, 0, 0);
                                                     acc1 = __builtin_amdgcn_mfma_f32_32x32x16_bf16(afr[2 * ph + 1][kk], bcur[kk], acc1, 0, 0, 0); }
#pragma unroll
                    for (int q = 0; q < 2; ++q) { const int p = 2 * ph + q; const f32x16& acc = q ? acc1 : acc0;
                        f32x2 s2 = {0.f, 0.f};
#pragma unroll
                        for (int r = 0; r < 8; ++r) { f32x2 a2 = {relu_i(acc[2 * r]), relu_i(acc[2 * r + 1])}; s2 = __builtin_elementwise_fma(wq[p][r], a2, s2); }
                        const bool valid = krel <= 2 * p;
                        const float s = valid ? s2[0] + s2[1] : -INF;
                        vmax[p] = fmaxf(vmax[p], s); vmin[p] = fminf(vmin[p], valid ? s : INF);
                        srow[p * 2 * 4096 + jt * 32] = s; }
                }
#pragma unroll
                for (int kk = 0; kk < 4; ++kk) bcur[kk] = bnxt[kk];
            }
#pragma unroll
            for (int o = 1; o < 32; o <<= 1)
#pragma unroll
                for (int p = 0; p < 4; ++p) { vmax[p] = fmaxf(vmax[p], __shfl_xor(vmax[p], o)); vmin[p] = fminf(vmin[p], __shfl_xor(vmin[p], o)); }
            if (c32 == 0) {
#pragma unroll
                for (int p = 0; p < 4; ++p) { mm[(w * 8 + 2 * p + hi) * 2] = vmin[p]; mm[(w * 8 + 2 * p + hi) * 2 + 1] = vmax[p]; } }
        }
        IDXT_END(1); }
        const int b_cur = b, t0_cur = t0;
        float wpre = 0.f; const bool has_next = uu + F.G < 2048; bf16x8 qpre0 = {}, qpre1 = {};
        if (has_next) { IDX_DECODE(uu + F.G, b, t0); if (tid_ < 128) wpre = T.WI[(size_t)(b * SEQ + t0) * 16 + tid_]; QI_FETCH(b, t0); IDX_LOAD(b, t0); }
        IDXT_BEGIN(5);
        P0Desc cd[A2_NCV] = {}; f32x4 cv[A2_NCV][8] = {}, cga[A2_NCV] = {}, cgb[A2_NCV] = {}; bool ch[A2_NCV];
#pragma unroll
        for (int k = 0; k < A2_NCV; ++k) { const int c = uu * NWAVES + w + k * 2048 * NWAVES; ch[k] = DEFER_CONV == 2 && c < A2_ITEMS;
            if (ch[k]) { int ln = lane; asm volatile("" : "+v"(ln)); a2_item_desc(F, cj, c, ln, cd[k]); p0_load_nn(cd[k], cv[k], cga[k], cgb[k]); } }
        IDXT_END(5);
        { IDXT_BEGIN(3); LDS_WAIT(); __builtin_amdgcn_s_barrier(); asm volatile("" ::: "memory"); IDXT_END(3); }
        bool cdone = false;
#define CONV_STORE() do { if (!cdone) { _Pragma("unroll") for (int k_ = 0; k_ < A2_NCV; ++k_) if (ch[k_]) p0_store<A2_NT_STORE != 0>(cd[k_], cv[k_], cga[k_], cgb[k_]); cdone = true; } } while (0)
        { IDXT_BEGIN(2);
        for (int lrep = 0; lrep < 1 + DBG_IDX_REP_SEL; ++lrep) {
            const int t = t0_cur + w, n = t + 1;
            const LAS float* sc = scores + w * 4096;
            const int nch = (n + 63) >> 6;
            unsigned long long myword = 0ull;
            if (n <= TOPK) {
#pragma unroll 4
                for (int j = 0; j < nch; ++j) { const int i = 64 * j + lane; const unsigned long long mk = __ballot(i < n); if (lane == j) myword = mk; }
            } else {
                float lo = INF, hv = -INF;
#pragma unroll
                for (int k = 0; k < 8; ++k) { lo = fminf(lo, mm[(k * 8 + w) * 2]); hv = fmaxf(hv, mm[(k * 8 + w) * 2 + 1]); }
                int need = TOPK; bool done = false;
                for (int level = 0; level < 6 && !done; ++level) {
                    if (!(hv > lo)) break;
                    const float scale = fminf(511.9f / (hv - lo), 3.0e37f), off = -lo * scale;
#pragma unroll
                    for (int k = 0; k < 8; ++k) hist[k * 64 + lane] = 0u;
                    LDS_WAIT();
                    for (int j0 = 0; j0 < nch; j0 += 8) {
                        float vb[8];
#pragma unroll
                        for (int k = 0; k < 8; ++k) vb[k] = sc[64 * ((j0 + k) & 63) + lane];
#pragma unroll
                        for (int k = 0; k < 8; ++k) { const int i = 64 * (j0 + k) + lane; const float v = vb[k];
                            if (i < n && v >= lo && v <= hv) { int bin = (int)fmaf(v, scale, off); bin = bin > 511 ? 511 : bin; __hip_atomic_fetch_add(hist + bin, 1u, __ATOMIC_RELAXED, __HIP_MEMORY_SCOPE_WORKGROUP); } } }
                    if (A2_STORE_MID) CONV_STORE();
                    LDS_WAIT();
                    unsigned h[8]; unsigned ssum = 0;
                    { const v4u a = *(const LAS v4u*)(hist + 8 * lane), bq = *(const LAS v4u*)(hist + 8 * lane + 4); h[0] = a.x; h[1] = a.y; h[2] = a.z; h[3] = a.w; h[4] = bq.x; h[5] = bq.y; h[6] = bq.z; h[7] = bq.w; }
#pragma unroll
                    for (int k = 0; k < 8; ++k) ssum += h[k];
                    unsigned S = ssum;
#pragma unroll
                    for (int o = 1; o < 64; o <<= 1) { const unsigned tt = __shfl_down(S, o); if (lane + o < 64) S += tt; }
                    const unsigned long long bal = __ballot(S >= (unsigned)need);
                    const int L = __popcll(bal) - 1;
                    const int Lc = L < 0 ? 0 : L;
                    unsigned cum = (Lc < 63) ? (unsigned)__shfl(S, Lc + 1) : 0u; if (Lc >= 63) cum = 0u;
                    int bstar = 8 * Lc; unsigned cstar = 0, abv = cum; bool found = false;
#pragma unroll
                    for (int k = 7; k >= 0; --k) { const unsigned hk = (unsigned)__shfl(h[k], Lc);
                        if (!found && cum + hk >= (unsigned)need) { bstar = 8 * Lc + k; cstar = hk; abv = cum; found = true; }
                        cum += hk; }
                    need -= (int)abv;
                    float nlo = INF, nhv = -INF; int base = 0; const bool few = cstar <= 64u;
                    for (int j0 = 0; j0 < nch; j0 += 8) {
                        float vb[8];
#pragma unroll
                        for (int k = 0; k < 8; ++k) vb[k] = sc[64 * ((j0 + k) & 63) + lane];
#pragma unroll
                        for (int k = 0; k < 8; ++k) { const int j = j0 + k, i = 64 * j + lane; const float v = vb[k]; const bool valid = i < n;
                            int bin = (int)fmaf(v, scale, off); bin = bin > 511 ? 511 : bin;
                            const bool member = valid && v >= lo && v <= hv, inb = member && bin == bstar, sure = valid && (v > hv || (member && bin > bstar));
                            const unsigned long long ms = __ballot(sure); if (lane == j) myword = ms;
                            if (inb) { nlo = fminf(nlo, v); nhv = fmaxf(nhv, v); }
                            if (few) { const unsigned long long mk = __ballot(inb);
                                if (inb) { const int pos = base + __popcll(mk & ((1ull << lane) - 1ull)); if (pos < 64) { cand[pos] = v; ((LAS int*)hist)[pos] = i; } }
                                base += __popcll(mk); } } }
                    if (few) {
                        LDS_WAIT();
                        const int nc = base < 64 ? base : 64;
                        const float myv = lane < nc ? cand[lane] : -INF; const int myi = lane < nc ? ((const LAS int*)hist)[lane] : 0; int cnt = 0;
                        for (int i = 0; i < nc; ++i) cnt += (__shfl(myv, i) > myv) ? 1 : 0;
                        unsigned long long msel = __ballot(lane < nc && cnt < need);
                        while (msel) { const int src = __builtin_ctzll(msel); msel &= msel - 1ull; const int ki = __shfl(myi, src);
                            if (lane == (ki >> 6)) myword |= 1ull << (ki & 63); }
                        done = true;
                    } else { lo = wave_min(nlo); hv = wave_max(nhv); }
                }
                if (!done) {
#pragma unroll 4
                    for (int j = 0; j < nch; ++j) { const int i = 64 * j + lane; const float v = sc[i]; const unsigned long long mk = __ballot(i < n && v >= lo); if (lane == j) myword = mk; }
                }
            }
            const int nwords = ((t | 255) + 1) >> 6;
            if (lane < nwords) T.MASK[((size_t)b_cur * 64 + lane) * SEQ + t] = myword;
        }
        IDXT_END(2); }
        { IDXT_BEGIN(6); CONV_STORE(); IDXT_END(6); }
#undef CONV_STORE
        if (has_next && tid_ < 128) ((LAS float*)(F.lds + WQ_OFF))[tid_] = wpre;
        if (has_next) QI_PARK();
        { IDXT_BEGIN(4); LDS_WAIT(); __builtin_amdgcn_s_barrier(); asm volatile("" ::: "memory"); IDXT_END(4); }
    }
#undef IDX_DECODE
#undef IDX_LOAD
#undef QI_FETCH
#undef QI_PARK
#undef QI_READ
}

template <bool FP8OUT> __device__ __forceinline__ void conv_phase(Frame& F, const bf16* Bg, const bf16* Z, const float* cw, bf16* Gout) {
    const int nunit = (M / 32) * 4;
    for (int uu = (blockIdx.x * NWAVES + F.wave); uu < nunit; uu += F.G * NWAVES) {
        const int run = uu >> 2, cb = (uu & 3) * 512 + F.lane * 8, r0 = run * 32;
        float w0[8], w1[8], w2[8];
#pragma unroll
        for (int j = 0; j < 8; ++j) { w0[j] = cw[cb + j]; w1[j] = cw[DM + cb + j]; w2[j] = cw[2 * DM + cb + j]; }
        float zm2[8], zm1[8];
        const bool first = (r0 % SEQ) == 0;
        { v4u a = {0, 0, 0, 0}, bq = {0, 0, 0, 0};
          if (!first) { a = *(const v4u*)(Z + (size_t)(r0 - 2) * DM + cb); bq = *(const v4u*)(Z + (size_t)(r0 - 1) * DM + cb); }
          const unsigned aw[4] = {a.x, a.y, a.z, a.w}, bw[4] = {bq.x, bq.y, bq.z, bq.w};
#pragma unroll
          for (int j = 0; j < 4; ++j) { zm2[2 * j] = __uint_as_float(aw[j] << 16); zm2[2 * j + 1] = __uint_as_float(aw[j] & 0xffff0000u); zm1[2 * j] = __uint_as_float(bw[j] << 16); zm1[2 * j + 1] = __uint_as_float(bw[j] & 0xffff0000u); } }
#pragma unroll 4
        for (int r = 0; r < 32; ++r) {
            const v4u zz = *(const v4u*)(Z + (size_t)(r0 + r) * DM + cb), bb = *(const v4u*)(Bg + (size_t)(r0 + r) * DM + cb);
            const unsigned zw[4] = {zz.x, zz.y, zz.z, zz.w}, bw[4] = {bb.x, bb.y, bb.z, bb.w};
            float z0[8], o[8];
#pragma unroll
            for (int j = 0; j < 4; ++j) { z0[2 * j] = __uint_as_float(zw[j] << 16); z0[2 * j + 1] = __uint_as_float(zw[j] & 0xffff0000u); }
#pragma unroll
            for (int j = 0; j < 8; ++j) { const float bv = (j & 1) ? __uint_as_float(bw[j >> 1] & 0xffff0000u) : __uint_as_float(bw[j >> 1] << 16);
                o[j] = bv * (w0[j] * zm2[j] + w1[j] * zm1[j] + w2[j] * z0[j]); zm2[j] = zm1[j]; zm1[j] = z0[j]; }
            if (FP8OUT) {
#pragma unroll
                for (int j = 0; j < 8; ++j) o[j] = fminf(fmaxf(o[j] * pg8::FP8_SG, -448.f), 448.f);
                int w0 = 0, w1 = 0; w0 = __builtin_amdgcn_cvt_pk_fp8_f32(o[0], o[1], w0, false); w0 = __builtin_amdgcn_cvt_pk_fp8_f32(o[2], o[3], w0, true);
                w1 = __builtin_amdgcn_cvt_pk_fp8_f32(o[4], o[5], w1, false); w1 = __builtin_amdgcn_cvt_pk_fp8_f32(o[6], o[7], w1, true);
                v2u ov; ov.x = (unsigned)w0; ov.y = (unsigned)w1; *(v2u*)((unsigned char*)Gout + (size_t)(r0 + r) * DM + cb) = ov;
            } else {
            v4u ov; ov.x = pk2(o[0], o[1]); ov.y = pk2(o[2], o[3]); ov.z = pk2(o[4], o[5]); ov.w = pk2(o[6], o[7]);
            *(v4u*)(Gout + (size_t)(r0 + r) * DM + cb) = ov; }
        }
    }
}

#ifndef PH_P0
#define PH_P0 1
#endif
#ifndef PH_A1
#define PH_A1 1
#endif
#ifndef PH_A2
#define PH_A2 1
#endif
#ifndef PH_A3
#define PH_A3 1
#endif
#ifndef PH_A4
#define PH_A4 1
#endif
#ifndef PH_C1
#define PH_C1 1
#endif
#ifndef PH_C1B
#define PH_C1B 1
#endif
#ifndef PH_C2
#define PH_C2 1
#endif
#ifndef PH_M1
#define PH_M1 1
#endif
#ifndef PH_M2
#define PH_M2 1
#endif
struct Args { Inputs in; float* out; unsigned char* ws; int ph_lo, ph_hi; };
#ifndef DBG_REP_LAYER
#define DBG_REP_LAYER -1
#endif
#ifndef DBG_REP_P0
#define DBG_REP_P0 0
#endif
#ifndef DBG_REP_A1
#define DBG_REP_A1 0
#endif
#ifndef DBG_REP_A2
#define DBG_REP_A2 0
#endif
#ifndef DBG_REP_A3
#define DBG_REP_A3 0
#endif
#ifndef DBG_REP_A4
#define DBG_REP_A4 0
#endif
#ifndef DBG_REP_C1
#define DBG_REP_C1 0
#endif
#ifndef DBG_REP_C1B
#define DBG_REP_C1B 0
#endif
#ifndef DBG_REP_C2
#define DBG_REP_C2 0
#endif
#ifndef DBG_REP_M1
#define DBG_REP_M1 0
#endif
#ifndef DBG_REP_M2
#define DBG_REP_M2 0
#endif
constexpr size_t WS_DUMMY_OUT = WS_END + 32 * MiB, WS_DUMMY_XB = WS_END + 160 * MiB, WS_DUMMY_SSQ = WS_END + 224 * MiB;
#define REPEAT(n) _Pragma("unroll") for (int rep = 0, nrep = ((li == DBG_REP_LAYER) ? 1 + (n) : 1); rep < nrep; ++rep)
#define REPBAR do { if (rep) { if (!MK_PER_PHASE) xcd_barrier(bar); } } while (0)
#define IN(k) (lo <= (k) && (k) < hi)
#define SEAM(k) do { if (IN(k) && IN((k) + 1)) { if (!MK_PER_PHASE) xcd_barrier(bar); } } while (0)
template <int li> __device__ __forceinline__ void layer_body(Frame& F, const Args& args, const XcdBarrier& bar, const int lo, const int hi, unsigned char* lds) {
    const Inputs& I = args.in; unsigned char* ws = args.ws;
    bf16* const XB = (bf16*)(ws + WS_XB); pg8::ssq_t* const SSQ = (pg8::ssq_t*)(ws + WS_SSQ);
    const unsigned* const ropeM = (const unsigned*)(ws + WS_ROPEM); const unsigned* const ropeI = (const unsigned*)(ws + WS_ROPEI);

        const int j = li >> 1, pb = 1 + 6 * li;
        if ((li & 1) == 0) {
            STAMP(pb + 0);
            if (PH_A1 && IN(pb + 0)) REPEAT(DBG_REP_A1) { REPBAR;
                pg8::Gemm g{XB, (const bf16*)(ws + WS_WA1 + j * SZ_WA1), M, NA1, DM}; pg8::StaticOrder S; S.init(M, NA1, F.G, (int)blockIdx.x);
                pg8::EpiA1 E{SSQ + (size_t)(2 * li) * M, (bf16*)(ws + WS_Q), (bf16*)(ws + WS_K), (bf16*)(ws + WS_V), (bf16*)(ws + WS_QI), (bf16*)(ws + WS_KI), (float*)(ws + WS_WI),
                             (const float*)(ws + WS_QG) + j * 128, (const float*)(ws + WS_KG) + j * 128, ropeM, ropeI, (PG8_LAS float*)(F.lds + AUX_OFF)};
                pg8::gemm_phase<pg8::EpiA1, pg8::StaticOrder, true, true>(F.lds + RING_OFF, g, S, E);
                if (DEFER_CONV) {
                    const bool part = F.G == 256; const int bx = (int)blockIdx.x;
                    if (!part || bx >= 64) { const Inputs Iw = *(const Inputs*)(ws + WS_INPTR);
                        convert_ranges(F, Iw, ranges_deferred(j), (part ? bx - 64 : bx) * NWAVES + F.wave, (part ? 192 : F.G) * NWAVES); } }
            } SEAM(pb + 0);
            STAMP(pb + 1);
            if (PH_A2 && IN(pb + 1)) REPEAT(DBG_REP_A2) { REPBAR; IdxTensors T{(const bf16*)(ws + WS_QI), (const bf16*)(ws + WS_KI), (const float*)(ws + WS_WI), (unsigned long long*)(ws + WS_MASK), args.out};
#if defined(DBG_DUMP)
                for (size_t e = (size_t)blockIdx.x * 512 + F.tid; e < (size_t)M * DM; e += (size_t)F.G * 512) { const int row = (int)(e / DM), c = (int)(e % DM); float v = 0.f;
                    if (c < 1024) v = bf2f(T.QI[(size_t)row * 1024 + c]); else if (c < 1088) v = bf2f(T.KI[(size_t)row * 64 + c - 1024]); else if (c < 1104) v = T.WI[(size_t)row * 16 + c - 1088];
                    args.out[e] = v; }
#else
                idx_phase(F, T, j);
#endif
                } SEAM(pb + 1);
            STAMP(pb + 2);
            if (PH_A3 && IN(pb + 2)) REPEAT(DBG_REP_A3) { REPBAR; const att::Tensors T{(const att::bf16*)(ws + WS_Q), (const att::bf16*)(ws + WS_K), (const att::bf16*)(ws + WS_V), (att::bf16*)(ws + WS_O), (const att::u64*)(ws + WS_MASK)};
                att::attn_phase((char*)lds + RING_OFF, T, (int)blockIdx.x, F.G); } SEAM(pb + 2);
            STAMP(pb + 3);
            if (PH_A4 && IN(pb + 3)) REPEAT(DBG_REP_A4) { REPBAR; const bool dummy = rep + 1 < nrep;
                pg8::Gemm g{(const bf16*)(ws + DBG_A4_SRC), (const bf16*)(ws + WS_WA4 + j * SZ_WSQ), M, DM, DM}; pg8::StaticOrder S; S.init(M, DM, F.G, (int)blockIdx.x);
                pg8::EpiRes<false, ((M1_FP8 >> li) & 1) != 0> E{XB, dummy ? (bf16*)(ws + WS_DUMMY_XB) : XB, nullptr, dummy ? (pg8::ssq_t*)(ws + WS_DUMMY_SSQ) : SSQ + (size_t)(2 * li + 1) * M, 1.0f, ws + WS_XB8};
                pg8::gemm_phase<pg8::EpiRes<false, ((M1_FP8 >> li) & 1) != 0>, pg8::StaticOrder, PG8_ALIGN_X, PG8_SP2_X>(F.lds + RING_OFF, g, S, E);
            } SEAM(pb + 3);
        } else {
            STAMP(pb + 0);
            if (PH_C1 && IN(pb + 0)) REPEAT(DBG_REP_C1) { REPBAR;
                constexpr bool c1f8 = ((C1_FP8 >> li) & 1) != 0;
                pg8::Gemm g{c1f8 ? (const bf16*)(ws + WS_XB8) : XB, (const bf16*)(ws + WS_WC1 + j * SZ_WC1), M, NC1, c1f8 ? DM / 2 : DM}; pg8::StaticOrder S; S.init(M, NC1, F.G, (int)blockIdx.x);
                pg8::EpiC1 E{(bf16*)(ws + WS_BG), (bf16*)(ws + WS_Z), SSQ + (size_t)(2 * li) * M, c1f8 ? 1.0f / (pg8::FP8_SX * pg8::FP8_SWI) : 1.0f};
                pg8::gemm_phase<pg8::EpiC1, pg8::StaticOrder, PG8_ALIGN_X, PG8_SP2_X, c1f8>(F.lds + RING_OFF, g, S, E);
            } SEAM(pb + 0);
            STAMP(pb + 1);
            if (PH_C1B && IN(pb + 1)) REPEAT(DBG_REP_C1B) { REPBAR; conv_phase<((C2_FP8 >> li) & 1) != 0>(F, (const bf16*)(ws + WS_BG), (const bf16*)(ws + WS_Z), (const float*)(ws + WS_CONVW) + (size_t)j * 3 * DM, (bf16*)(ws + WS_G)); } SEAM(pb + 1);
            STAMP(pb + 2);
            if (PH_C2 && IN(pb + 2)) REPEAT(DBG_REP_C2) { REPBAR; const bool dummy = rep + 1 < nrep;
                pg8::Gemm g{(const bf16*)(ws + WS_G), (const bf16*)(ws + WS_WC2 + j * SZ_WSQ), M, DM, ((C2_FP8 >> li) & 1) ? DM / 2 : DM}; pg8::StaticOrder S; S.init(M, DM, F.G, (int)blockIdx.x);
                pg8::EpiRes<false, ((M1_FP8 >> li) & 1) != 0> E{XB, dummy ? (bf16*)(ws + WS_DUMMY_XB) : XB, nullptr, dummy ? (pg8::ssq_t*)(ws + WS_DUMMY_SSQ) : SSQ + (size_t)(2 * li + 1) * M, ((C2_FP8 >> li) & 1) ? 1.0f / (pg8::FP8_SG * pg8::FP8_SWC) : 1.0f, ws + WS_XB8};
                pg8::gemm_phase<pg8::EpiRes<false, ((M1_FP8 >> li) & 1) != 0>, pg8::StaticOrder, PG8_ALIGN_X, PG8_SP2_X, ((C2_FP8 >> li) & 1) != 0>(F.lds + RING_OFF, g, S, E);
            } SEAM(pb + 2);
            STAMP(pb + 3);
        }
        STAMP(pb + 4);
        if (PH_M1 && IN(pb + 4)) REPEAT(DBG_REP_M1) { REPBAR;
            constexpr bool m1f8 = ((M1_FP8 >> li) & 1) != 0;
            pg8::Gemm g{m1f8 ? (const bf16*)(ws + WS_XB8) : XB, (const bf16*)(ws + WS_WM1 + li * SZ_WM), M, DFF, m1f8 ? DM / 2 : DM}; pg8::StaticOrder S; S.init(M, DFF, F.G, (int)blockIdx.x);
            pg8::EpiM1<((MLP_FP8 >> li) & 1) != 0> E{(bf16*)(ws + WS_H), SSQ + (size_t)(2 * li + 1) * M, m1f8 ? 1.0f / (pg8::FP8_SX * pg8::FP8_SWI) : 1.0f};
            pg8::gemm_phase<pg8::EpiM1<((MLP_FP8 >> li) & 1) != 0>, pg8::StaticOrder, PG8_ALIGN_X, PG8_SP2_X, m1f8>(F.lds + RING_OFF, g, S, E);
        } SEAM(pb + 4);
        STAMP(pb + 5);
        if (PH_M2 && IN(pb + 5)) REPEAT(DBG_REP_M2) { REPBAR; const bool dummy = rep + 1 < nrep;
            pg8::Gemm g{(const bf16*)(ws + WS_H), (const bf16*)(ws + WS_WM2 + li * SZ_WM), M, DM, ((MLP_FP8 >> li) & 1) ? DFF / 2 : DFF}; pg8::StaticOrder S; S.init(M, DM, F.G, (int)blockIdx.x);
            constexpr bool nx8 = li + 1 < DEPTH && ((C1_FP8 >> (li + 1)) & 1) != 0;
            pg8::EpiRes<li == DEPTH - 1, nx8> E{XB, dummy ? (bf16*)(ws + WS_DUMMY_XB) : XB, dummy ? (float*)(ws + WS_DUMMY_OUT) : args.out, dummy ? (pg8::ssq_t*)(ws + WS_DUMMY_SSQ) : SSQ + (size_t)(2 * li + 2) * M, ((MLP_FP8 >> li) & 1) ? 1.0f / (pg8::FP8_SA * pg8::FP8_SW) : 1.0f, ws + WS_XB8};
            pg8::gemm_phase<pg8::EpiRes<li == DEPTH - 1, nx8>, pg8::StaticOrder, PG8_ALIGN_X, (((MLP_FP8 >> li) & 1) ? PG8_SP2_F8 : PG8_SP2_X), ((MLP_FP8 >> li) & 1) != 0>(F.lds + RING_OFF, g, S, E);
        } SEAM(pb + 5);
    }
#undef IN
#undef SEAM
__global__ void __launch_bounds__(NWAVES * 64, 2) trunk_fwd(Args args) {
    extern __shared__ __attribute__((aligned(16))) unsigned char lds[];
    Frame F;
    F.lds = (LAS unsigned char*)lds;
    F.MISC = (volatile LAS unsigned*)(F.lds + MISC_OFF);
    F.tid = threadIdx.x; F.lane = F.tid & 63; F.wave = __builtin_amdgcn_readfirstlane(F.tid >> 6);
    F.G = gridDim.x; { const int bx = blockIdx.x; F.vcu = (F.G % 8 == 0) ? (bx % 8) * (F.G / 8) + bx / 8 : bx; }
    F.ws = args.ws; F.ctl = (gu32*)(args.ws + WS_CTL);
    for (int u = F.tid; u < 64; u += NWAVES * 64) ((LAS unsigned*)(F.lds + MISC_OFF))[u] = 0u;
    __syncthreads();
    XcdBarrier bar; bar.bar = (unsigned*)(F.ctl + CW_BAR); bar.x = 0; bar.st = nullptr;
    if (!MK_PER_PHASE) bar = xcd_barrier_post((unsigned*)(F.ctl + CW_BAR), F.MISC + 8);
    const int lo = args.ph_lo, hi = args.ph_hi;
    const Inputs& I = args.in;
    unsigned char* ws = args.ws;
#define IN(k) (lo <= (k) && (k) < hi)
#define SEAM(k) do { if (IN(k) && IN((k) + 1)) { if (!MK_PER_PHASE) xcd_barrier(bar); } } while (0)
    bf16* const XB = (bf16*)(ws + WS_XB);
    pg8::ssq_t* const SSQ = (pg8::ssq_t*)(ws + WS_SSQ);
    const unsigned* const ropeM = (const unsigned*)(ws + WS_ROPEM); const unsigned* const ropeI = (const unsigned*)(ws + WS_ROPEI);

    STAMP(0);
    if (PH_P0 && IN(0)) { for (int rep = 0; rep < 1 + DBG_REP_P0; ++rep) { if (rep) xcd_barrier(bar); p0_prologue(F, I, args.out); } } SEAM(0);

    layer_body<0>(F, args, bar, lo, hi, lds); layer_body<1>(F, args, bar, lo, hi, lds); layer_body<2>(F, args, bar, lo, hi, lds); layer_body<3>(F, args, bar, lo, hi, lds);
    STAMP(1 + 6 * DEPTH);
#if defined(DBG_EPI_TYPE)
    if (blockIdx.x == 0 && threadIdx.x == 0) { const unsigned long long dt = (unsigned long long)F.MISC[20] * 9ull, t0 = __builtin_amdgcn_s_memrealtime(); while (__builtin_amdgcn_s_memrealtime() - t0 < dt) __builtin_amdgcn_s_sleep(8); }
#endif
    if ((DBG_IDX_TIME > 0 || DBG_P0_TIME > 0) && blockIdx.x == 0 && threadIdx.x == 0) { const unsigned long long dt = (unsigned long long)F.MISC[20] * 9ull, t0 = __builtin_amdgcn_s_memrealtime(); while (__builtin_amdgcn_s_memrealtime() - t0 < dt) __builtin_amdgcn_s_sleep(8); }
    if (DBG_CLK_PHASE >= 0 && blockIdx.x == 0 && threadIdx.x == 0) {
        const unsigned long long c0 = (unsigned long long)F.MISC[32] | ((unsigned long long)F.MISC[33] << 32), r0 = (unsigned long long)F.MISC[34] | ((unsigned long long)F.MISC[35] << 32);
        const unsigned long long c1 = (unsigned long long)F.MISC[36] | ((unsigned long long)F.MISC[37] << 32), r1 = (unsigned long long)F.MISC[38] | ((unsigned long long)F.MISC[39] << 32);
        const unsigned long long dt = (r1 > r0) ? ((c1 - c0) * 1000ull) / (r1 - r0) : 0ull, t0 = __builtin_amdgcn_s_memrealtime(); while (__builtin_amdgcn_s_memrealtime() - t0 < dt) __builtin_amdgcn_s_sleep(8); }
    if (DBG_TIME_PHASE >= 0 && blockIdx.x == 0 && threadIdx.x == 0) { const unsigned long long tsA = (unsigned long long)F.MISC[16] | ((unsigned long long)F.MISC[17] << 32), tsB = (unsigned long long)F.MISC[18] | ((unsigned long long)F.MISC[19] << 32); const unsigned long long dt = (tsB - tsA) * 9ull, t0 = __builtin_amdgcn_s_memrealtime(); while (__builtin_amdgcn_s_memrealtime() - t0 < dt) __builtin_amdgcn_s_sleep(8); }
#undef IN
#undef SEAM
}

#ifndef DBG_NPH
#define DBG_NPH (1 + 6 * DEPTH)
#endif
constexpr int N_PHASES = DBG_NPH;
extern "C" void kernel_launch(void* const* d_in, const int* in_sizes, int n_in, void* d_out, int out_size, void* d_ws, size_t ws_size, hipStream_t stream) {
    static int grid = 0;
    if (grid == 0) {
        if (n_in != 14 || in_sizes[0] != M * DM || out_size != M * DM || ws_size < WS_END + 32 * MiB + (DBG_REP_LAYER >= 0 ? 232 * MiB : 0)) { fprintf(stderr, "kernel_launch: shape/workspace mismatch (n_in %d, in0 %d, out %d, ws %zu, need %zu)\n", n_in, n_in > 0 ? in_sizes[0] : -1, out_size, ws_size, (size_t)WS_END); grid = -1; return; }
        int dev = 0, cus = 0, per_cu = 0;
        if (hipGetDevice(&dev) != hipSuccess || hipDeviceGetAttribute(&cus, hipDeviceAttributeMultiprocessorCount, dev) != hipSuccess) { grid = -1; return; }
        if (hipFuncSetAttribute((const void*)trunk_fwd, hipFuncAttributeMaxDynamicSharedMemorySize, LDS_BYTES) != hipSuccess) { fprintf(stderr, "kernel_launch: hipFuncSetAttribute failed\n"); grid = -1; return; }
        if (hipOccupancyMaxActiveBlocksPerMultiprocessor(&per_cu, (const void*)trunk_fwd, NWAVES * 64, LDS_BYTES) != hipSuccess || per_cu < 1) fprintf(stderr, "kernel_launch: occupancy query reports %d\n", per_cu);
        (void)hipGetLastError();
        grid = cus;
    }
    if (grid < 0) return;
    if (hipMemsetAsync((char*)d_ws + WS_CTL, 0, CTL_ZERO_BYTES, stream) != hipSuccess) { fprintf(stderr, "kernel_launch: memset failed\n"); return; }
    Args a{};
    a.in.x = (const float*)d_in[0]; a.in.pos = (const int*)d_in[1]; a.in.attn_norm_g = (const float*)d_in[2]; a.in.attn_w_in = (const float*)d_in[3]; a.in.attn_q_g = (const float*)d_in[4];
    a.in.attn_k_g = (const float*)d_in[5]; a.in.attn_w_out = (const float*)d_in[6]; a.in.conv_norm_g = (const float*)d_in[7]; a.in.conv_w_in = (const float*)d_in[8]; a.in.conv_w = (const float*)d_in[9];
    a.in.conv_w_out = (const float*)d_in[10]; a.in.mlp_norm_g = (const float*)d_in[11]; a.in.mlp_w1 = (const float*)d_in[12]; a.in.mlp_w2 = (const float*)d_in[13];
    a.out = (float*)d_out; a.ws = (unsigned char*)d_ws;
#if MK_PER_PHASE
    for (int ph = 0; ph < N_PHASES; ++ph) {
        const int li = (ph - 1) / 6, k = (ph - 1) % 6;
        if (ph > 0 && (li & 1) == 1 && k == 3) continue;
        a.ph_lo = ph; a.ph_hi = ph + 1;
        hipLaunchKernelGGL(trunk_fwd, dim3(grid), dim3(NWAVES * 64), LDS_BYTES, stream, a);
    }
#else
    a.ph_lo = 0; a.ph_hi = N_PHASES;
    hipLaunchKernelGGL(trunk_fwd, dim3(grid), dim3(NWAVES * 64), LDS_BYTES, stream, a);
#endif
    const hipError_t le = hipPeekAtLastError();
    if (le != hipSuccess) fprintf(stderr, "kernel_launch: launch failed: %s\n", hipGetErrorName(le));
}
```

```cpp
#define MK_PER_PHASE 0
#include <hip/hip_runtime.h>
#include <cstdio>
#include <cstdint>
#ifndef PG8_WGM
#define PG8_WGM 4
#endif
namespace pg8 {
#define PG8_LAS __attribute__((address_space(3)))
typedef unsigned short bf16_t;
typedef short bf16x8 __attribute__((ext_vector_type(8)));
typedef float f32x4 __attribute__((ext_vector_type(4)));
typedef unsigned u32x4 __attribute__((ext_vector_type(4)));
constexpr int BM = 256, BK = 64, HALF = 128, HTB = HALF * BK * 2  , STAGE_BYTES = 8 * HTB, NXCD = 8, WGM = PG8_WGM;

__host__ __device__ __forceinline__ int lds_byte(int r, int c) { const int st = (r >> 4) * 2 + (c >> 5), rr = r & 15, cc = c & 31, ob = rr * 64 + cc * 2; return st * 1024 + (ob ^ (((ob >> 9) & 1) << 5)); }
__host__ __device__ __forceinline__ void stage_rc(int b, int& R, int& C) { const int st = b / 1024, sb = b % 1024, swz = sb ^ (((sb >> 9) & 1) << 5); R = (st >> 1) * 16 + swz / 64; C = (st & 1) * 32 + (swz % 64) / 2; }
__host__ __device__ __forceinline__ int perm32(int rho) { const int n = rho >> 4, i = rho & 15; return 8 * (i >> 2) + 4 * n + (i & 3); }

typedef int v8i_t __attribute__((ext_vector_type(8)));
typedef int v4i_t __attribute__((ext_vector_type(4)));
__device__ __forceinline__ v8i_t cat8(bf16x8 a, bf16x8 b) { const v4i_t x = __builtin_bit_cast(v4i_t, a), y = __builtin_bit_cast(v4i_t, b); return __builtin_shufflevector(x, y, 0, 1, 2, 3, 4, 5, 6, 7); }
struct Unit { int pm, pn; };
struct Gemm { const bf16_t* A; const bf16_t* Bt; int M, N, K; };

struct StaticOrder {
    int nM, nN, nwg, G, c;
    __host__ __device__ void init(int M, int N, int G_, int c_) { nM = M / BM; nN = N / BM; nwg = nM * nN; G = G_; c = c_; }
    __host__ __device__ bool next(int i, Unit& u) const {
        const long L = (long)i * G + c; if (L >= nwg) return false;
        int wgid = (int)L; { const int q = nwg / NXCD, r = nwg % NXCD, xcd = wgid % NXCD, off = wgid / NXCD; wgid = (xcd < r ? xcd * (q + 1) : r * (q + 1) + (xcd - r) * q) + off; }
        const int nig = WGM * nN, gid = wgid / nig, fm = gid * WGM, gsz = (nM - fm) < WGM ? (nM - fm) : WGM;
        u.pm = fm + ((wgid % nig) % gsz); u.pn = (wgid % nig) / gsz; return true;
    }
    __device__ __forceinline__ void a_ready(const Unit&) const {}
    __device__ __forceinline__ void done(const Unit&) const {}
};
__device__ __forceinline__ unsigned cvt_pk_bf16(float lo, float hi) { unsigned r; asm volatile("v_cvt_pk_bf16_f32 %0, %1, %2" : "=v"(r) : "v"(lo), "v"(hi)); return r; }
typedef unsigned u32x2 __attribute__((ext_vector_type(2)));
constexpr float RMS_EPS = 1e-6f;
typedef unsigned long long ssq_t;
__device__ __forceinline__ float rstd_of(ssq_t ssq) { return __builtin_amdgcn_rsqf((float)ssq * (1.0f / (2048.0f * 1048576.0f)) + RMS_EPS); }
__device__ __forceinline__ ssq_t ssq_fix(float s) { return (ssq_t)(s * 1048576.0f + 0.5f); }

constexpr float FP8_SX = 2.0f, FP8_SWI = 1024.0f;
template <bool FINAL, bool XB8 = false> struct EpiRes {
    static constexpr bool PERM = true, AFTER_DRAIN = false;
    const bf16_t* base; bf16_t* xb; float* out; ssq_t* ssq; float scale; unsigned char* xb8;
    __device__ __forceinline__ void operator()(const f32x4 (&acc)[2][2][4][2], const Unit& u, int wr, int wc, int fr, int fq) const {
        const int row0 = u.pm * BM + wr * 64 + fr, col0 = u.pn * BM + wc * 32 + 8 * fq;
        u32x4 bw[2][4][2];
#pragma unroll
        for (int ai = 0; ai < 2; ++ai)
#pragma unroll
            for (int m = 0; m < 4; ++m)
#pragma unroll
                for (int bj = 0; bj < 2; ++bj) bw[ai][m][bj] = *(const u32x4*)(base + (size_t)(row0 + ai * HALF + m * 16) * 2048 + col0 + bj * HALF);
        asm volatile("" ::: "memory");
#pragma unroll
        for (int ai = 0; ai < 2; ++ai)
#pragma unroll
            for (int m = 0; m < 4; ++m) {
                const int row = row0 + ai * HALF + m * 16; const size_t off = (size_t)row * 2048 + col0; float s = 0.f;
#pragma unroll
                for (int bj = 0; bj < 2; ++bj) {
                    const u32x4 b = bw[ai][m][bj];
                    const f32x4 b0 = {__uint_as_float(b.x << 16), __uint_as_float(b.x & 0xffff0000u), __uint_as_float(b.y << 16), __uint_as_float(b.y & 0xffff0000u)};
                    const f32x4 b1 = {__uint_as_float(b.z << 16), __uint_as_float(b.z & 0xffff0000u), __uint_as_float(b.w << 16), __uint_as_float(b.w & 0xffff0000u)};
                    const f32x4 o0 = b0 + acc[ai][bj][m][0] * scale, o1 = b1 + acc[ai][bj][m][1] * scale;
                    if (FINAL) { *(f32x4*)(out + off + bj * HALF) = o0; *(f32x4*)(out + off + bj * HALF + 4) = o1; }
                    else {
                        s += ((o0[0] * o0[0] + o0[1] * o0[1]) + (o0[2] * o0[2] + o0[3] * o0[3])) + ((o1[0] * o1[0] + o1[1] * o1[1]) + (o1[2] * o1[2] + o1[3] * o1[3]));
                        u32x4 w; w.x = cvt_pk_bf16(o0[0], o0[1]); w.y = cvt_pk_bf16(o0[2], o0[3]); w.z = cvt_pk_bf16(o1[0], o1[1]); w.w = cvt_pk_bf16(o1[2], o1[3]);
                        *(u32x4*)(xb + off + bj * HALF) = w;
                        if (XB8) { f32x4 e0 = o0 * FP8_SX, e1 = o1 * FP8_SX;
#pragma unroll
                            for (int j = 0; j < 4; ++j) { e0[j] = fminf(fmaxf(e0[j], -448.f), 448.f); e1[j] = fminf(fmaxf(e1[j], -448.f), 448.f); }
                            int w0 = 0, w1 = 0; w0 = __builtin_amdgcn_cvt_pk_fp8_f32(e0[0], e0[1], w0, false); w0 = __builtin_amdgcn_cvt_pk_fp8_f32(e0[2], e0[3], w0, true);
                            w1 = __builtin_amdgcn_cvt_pk_fp8_f32(e1[0], e1[1], w1, false); w1 = __builtin_amdgcn_cvt_pk_fp8_f32(e1[2], e1[3], w1, true);
                            u32x2 w8; w8.x = (unsigned)w0; w8.y = (unsigned)w1; *(u32x2*)(xb8 + off + bj * HALF) = w8; } }
                }
                if (!FINAL) { s += __shfl_xor(s, 16); s += __shfl_xor(s, 32);
                    if (fq == 0) __hip_atomic_fetch_add(ssq + row, ssq_fix(s), __ATOMIC_RELAXED, __HIP_MEMORY_SCOPE_AGENT); }
            }
    }
};

constexpr float FP8_SG = 16.0f, FP8_SWC = 1024.0f;
constexpr float FP8_SA = 8.0f, FP8_SW = 2048.0f;
template <bool FP8OUT> struct EpiM1 {
    static constexpr bool PERM = true, AFTER_DRAIN = false;
    bf16_t* H; const ssq_t* ssq; float iscale;
    __device__ __forceinline__ void operator()(const f32x4 (&acc)[2][2][4][2], const Unit& u, int wr, int wc, int fr, int fq) const {
        const int row0 = u.pm * BM + wr * 64 + fr, col0 = u.pn * BM + wc * 32 + 8 * fq;
        ssq_t sq[2][4];
#pragma unroll
        for (int ai = 0; ai < 2; ++ai)
#pragma unroll
            for (int m = 0; m < 4; ++m) sq[ai][m] = ssq[row0 + ai * HALF + m * 16];
        asm volatile("" ::: "memory");
#pragma unroll
        for (int ai = 0; ai < 2; ++ai)
#pragma unroll
            for (int m = 0; m < 4; ++m) {
                const int row = row0 + ai * HALF + m * 16; const float r = rstd_of(sq[ai][m]) * iscale;
#pragma unroll
                for (int bj = 0; bj < 2; ++bj) {
                    f32x4 v0 = acc[ai][bj][m][0] * r, v1 = acc[ai][bj][m][1] * r;
#pragma unroll
                    for (int j = 0; j < 4; ++j) { v0[j] = fmaxf(v0[j], 0.f); v1[j] = fmaxf(v1[j], 0.f); }
                    v0 = v0 * v0; v1 = v1 * v1;
                    if (FP8OUT) { v0 = v0 * FP8_SA; v1 = v1 * FP8_SA;
#pragma unroll
                        for (int j = 0; j < 4; ++j) { v0[j] = fminf(v0[j], 448.f); v1[j] = fminf(v1[j], 448.f); }
                        int w0 = 0, w1 = 0; w0 = __builtin_amdgcn_cvt_pk_fp8_f32(v0[0], v0[1], w0, false); w0 = __builtin_amdgcn_cvt_pk_fp8_f32(v0[2], v0[3], w0, true);
                        w1 = __builtin_amdgcn_cvt_pk_fp8_f32(v1[0], v1[1], w1, false); w1 = __builtin_amdgcn_cvt_pk_fp8_f32(v1[2], v1[3], w1, true);
                        u32x2 w; w.x = (unsigned)w0; w.y = (unsigned)w1;
                        *(u32x2*)((unsigned char*)H + (size_t)row * 8192 + col0 + bj * HALF) = w; }
                    else { u32x4 w; w.x = cvt_pk_bf16(v0[0], v0[1]); w.y = cvt_pk_bf16(v0[2], v0[3]); w.z = cvt_pk_bf16(v1[0], v1[1]); w.w = cvt_pk_bf16(v1[2], v1[3]);
                        *(u32x4*)(H + (size_t)row * 8192 + col0 + bj * HALF) = w; } }
            }
    }
};

struct EpiC1 {
    static constexpr bool PERM = true, AFTER_DRAIN = false;
    bf16_t* Bg; bf16_t* Z; const ssq_t* ssq; float iscale;
    __device__ __forceinline__ void operator()(const f32x4 (&acc)[2][2][4][2], const Unit& u, int wr, int wc, int fr, int fq) const {
        const int row0 = u.pm * BM + wr * 64 + fr;
        ssq_t sq[2][4];
#pragma unroll
        for (int ai = 0; ai < 2; ++ai)
#pragma unroll
            for (int m = 0; m < 4; ++m) sq[ai][m] = ssq[row0 + ai * HALF + m * 16];
        asm volatile("" ::: "memory");
        if (u.pn < 8) {
            const int col0 = u.pn * BM + wc * 32 + 8 * fq;
#pragma unroll
            for (int ai = 0; ai < 2; ++ai)
#pragma unroll
                for (int m = 0; m < 4; ++m) {
                    const int row = row0 + ai * HALF + m * 16; const float r = rstd_of(sq[ai][m]) * iscale; bf16_t* rowp = Bg + (size_t)row * 2048 + col0;
#pragma unroll
                    for (int bj = 0; bj < 2; ++bj) {
                        const f32x4 v0 = acc[ai][bj][m][0] * r, v1 = acc[ai][bj][m][1] * r;
                        u32x4 w; w.x = cvt_pk_bf16(v0[0], v0[1]); w.y = cvt_pk_bf16(v0[2], v0[3]); w.z = cvt_pk_bf16(v1[0], v1[1]); w.w = cvt_pk_bf16(v1[2], v1[3]);
                        *(u32x4*)(rowp + bj * HALF) = w; }
                }
        } else {
            const int col0 = (u.pn - 8) * HALF + wc * 32 + 8 * fq;
#pragma unroll
            for (int ai = 0; ai < 2; ++ai)
#pragma unroll
                for (int m = 0; m < 4; ++m) {
                    const int row = row0 + ai * HALF + m * 16; const float r = rstd_of(sq[ai][m]) * iscale; const float r2 = r * r;
                    const f32x4 v0 = acc[ai][0][m][0] * acc[ai][1][m][0] * r2, v1 = acc[ai][0][m][1] * acc[ai][1][m][1] * r2;
                    u32x4 w; w.x = cvt_pk_bf16(v0[0], v0[1]); w.y = cvt_pk_bf16(v0[2], v0[3]); w.z = cvt_pk_bf16(v1[0], v1[1]); w.w = cvt_pk_bf16(v1[2], v1[3]);
                    *(u32x4*)(Z + (size_t)row * 2048 + col0) = w;
                }
        }
    }
};

__device__ __forceinline__ float h2f_lo(unsigned w) { return (float)__builtin_bit_cast(_Float16, (unsigned short)(w & 0xffffu)); }
__device__ __forceinline__ float h2f_hi(unsigned w) { return (float)__builtin_bit_cast(_Float16, (unsigned short)(w >> 16)); }
__device__ __forceinline__ f32x4 cos4(u32x4 w) { return (f32x4){h2f_lo(w.x), h2f_lo(w.y), h2f_lo(w.z), h2f_lo(w.w)}; }
__device__ __forceinline__ f32x4 sin4(u32x4 w) { return (f32x4){h2f_hi(w.x), h2f_hi(w.y), h2f_hi(w.z), h2f_hi(w.w)}; }
struct EpiA1 {
    static constexpr bool PERM = false, AFTER_DRAIN = false;
    const ssq_t* ssq; bf16_t *Q, *K, *V, *QI, *KI; float* WI; const float *qg, *kg; const unsigned *ropeM, *ropeI; PG8_LAS float* P;
    __device__ __forceinline__ void operator()(const f32x4 (&acc)[2][2][4][2], const Unit& u, int wr, int wc, int fr, int fq) const {
        const int pn = u.pn, rl0 = wr * 64 + fr, row0 = u.pm * BM + rl0;
        ssq_t sq[2][4];
#pragma unroll
        for (int ai = 0; ai < 2; ++ai)
#pragma unroll
            for (int m = 0; m < 4; ++m) sq[ai][m] = ssq[row0 + ai * HALF + m * 16];
        if (pn < 10) {
            const bool isq = pn < 8; const float* g = isq ? qg : kg;
            const f32x4 g0 = *(const f32x4*)(g + 32 * wc + 4 * fq), g1 = *(const f32x4*)(g + 32 * wc + 16 + 4 * fq);
            u32x4 cw[2][4];
#pragma unroll
            for (int ai = 0; ai < 2; ++ai)
#pragma unroll
                for (int m = 0; m < 4; ++m) { const int row = row0 + ai * HALF + m * 16; cw[ai][m] = (u32x4){0x3c00u, 0x3c00u, 0x3c00u, 0x3c00u};
                    if (wc == 0) cw[ai][m] = *(const u32x4*)(ropeM + (size_t)row * 16 + 4 * fq); }
#pragma unroll
            for (int ai = 0; ai < 2; ++ai)
#pragma unroll
                for (int m = 0; m < 4; ++m) { const int rl = rl0 + ai * HALF + m * 16;
#pragma unroll
                    for (int bj = 0; bj < 2; ++bj) { const f32x4 a = acc[ai][bj][m][0], b = acc[ai][bj][m][1];
                        float s = ((a[0] * a[0] + a[1] * a[1]) + (a[2] * a[2] + a[3] * a[3])) + ((b[0] * b[0] + b[1] * b[1]) + (b[2] * b[2] + b[3] * b[3]));
                        s += __shfl_xor(s, 16); s += __shfl_xor(s, 32);
                        if (fq == 0) P[(rl * 2 + bj) * 4 + wc] = s; } }
            asm volatile("s_waitcnt lgkmcnt(0)" ::: "memory"); __builtin_amdgcn_s_barrier(); asm volatile("" ::: "memory");
#pragma unroll
            for (int ai = 0; ai < 2; ++ai)
#pragma unroll
                for (int m = 0; m < 4; ++m) { const int rl = rl0 + ai * HALF + m * 16, row = row0 + ai * HALF + m * 16; const float rs = rstd_of(sq[ai][m]);
                    bf16_t* dst = isq ? Q + (size_t)row * 2048 + pn * BM + wc * 32 + 4 * fq : K + (size_t)row * 512 + (pn - 8) * BM + wc * 32 + 4 * fq;
#pragma unroll
                    for (int bj = 0; bj < 2; ++bj) { const f32x4 pp = *(const PG8_LAS f32x4*)(P + (rl * 2 + bj) * 4);
                        const float tot = (pp[0] + pp[1]) + (pp[2] + pp[3]);
                        const float sc = rs * __builtin_amdgcn_rsqf(rs * rs * tot * (1.0f / 128.0f) + RMS_EPS);
                        f32x4 v0 = acc[ai][bj][m][0] * sc * g0, v1 = acc[ai][bj][m][1] * sc * g1;
                        if (wc == 0) { const f32x4 x1 = v0, x2 = v1, cs = cos4(cw[ai][m]), sn = sin4(cw[ai][m]); v0 = x1 * cs - x2 * sn; v1 = x2 * cs + x1 * sn; }
                        u32x2 w0, w1; w0.x = cvt_pk_bf16(v0[0], v0[1]); w0.y = cvt_pk_bf16(v0[2], v0[3]); w1.x = cvt_pk_bf16(v1[0], v1[1]); w1.y = cvt_pk_bf16(v1[2], v1[3]);
                        *(u32x2*)(dst + bj * HALF) = w0; *(u32x2*)(dst + bj * HALF + 16) = w1; } }
        } else if (pn < 12) {
            asm volatile("" ::: "memory");
#pragma unroll
            for (int ai = 0; ai < 2; ++ai)
#pragma unroll
                for (int m = 0; m < 4; ++m) { const int row = row0 + ai * HALF + m * 16; const float rs = rstd_of(sq[ai][m]);
                    bf16_t* dst = V + (size_t)row * 512 + (pn - 10) * BM + wc * 32 + 4 * fq;
#pragma unroll
                    for (int bj = 0; bj < 2; ++bj) { const f32x4 v0 = acc[ai][bj][m][0] * rs, v1 = acc[ai][bj][m][1] * rs;
                        u32x2 w0, w1; w0.x = cvt_pk_bf16(v0[0], v0[1]); w0.y = cvt_pk_bf16(v0[2], v0[3]); w1.x = cvt_pk_bf16(v1[0], v1[1]); w1.y = cvt_pk_bf16(v1[2], v1[3]);
                        *(u32x2*)(dst + bj * HALF) = w0; *(u32x2*)(dst + bj * HALF + 16) = w1; } }
        } else {
            const bool rot = ((wc & 1) == 0) && fq < 2;
            const int d0 = (wc & 1) ? 32 + 4 * fq : (fq < 2 ? 4 * fq : 16 + 4 * (fq - 2)), d1 = (wc & 1) ? 48 + 4 * fq : (fq < 2 ? 8 + 4 * fq : 24 + 4 * (fq - 2));
            const bool iski = pn == 16;
            u32x4 cw[2][4];
#pragma unroll
            for (int ai = 0; ai < 2; ++ai)
#pragma unroll
                for (int m = 0; m < 4; ++m) { const int row = row0 + ai * HALF + m * 16; cw[ai][m] = (u32x4){0x3c00u, 0x3c00u, 0x3c00u, 0x3c00u};
                    if (rot) cw[ai][m] = *(const u32x4*)(ropeI + (size_t)row * 8 + 4 * fq); }
            asm volatile("" ::: "memory");
#pragma unroll
            for (int ai = 0; ai < 2; ++ai)
#pragma unroll
                for (int m = 0; m < 4; ++m) { const int row = row0 + ai * HALF + m * 16; const float rs = rstd_of(sq[ai][m]);
#pragma unroll
                    for (int bj = 0; bj < 2; ++bj) {
                        f32x4 v0 = acc[ai][bj][m][0] * rs, v1 = acc[ai][bj][m][1] * rs;
                        if (iski) {
                            if (bj == 0) {
                                if (wc < 2) { if (rot) { const f32x4 x1 = v0, x2 = v1, cs = cos4(cw[ai][m]), sn = sin4(cw[ai][m]); v0 = x1 * cs - x2 * sn; v1 = x2 * cs + x1 * sn; }
                                    u32x2 w0, w1; w0.x = cvt_pk_bf16(v0[0], v0[1]); w0.y = cvt_pk_bf16(v0[2], v0[3]); w1.x = cvt_pk_bf16(v1[0], v1[1]); w1.y = cvt_pk_bf16(v1[2], v1[3]);
                                    bf16_t* dst = KI + (size_t)row * 64; *(u32x2*)(dst + d0) = w0; *(u32x2*)(dst + d1) = w1; }
                                else if (wc == 2) { *(f32x4*)(WI + (size_t)row * 16 + 4 * fq) = v0 * 0.03125f; }
                            }
                        } else {
                            if (rot) { const f32x4 x1 = v0, x2 = v1, cs = cos4(cw[ai][m]), sn = sin4(cw[ai][m]); v0 = x1 * cs - x2 * sn; v1 = x2 * cs + x1 * sn; }
                            u32x2 w0, w1; w0.x = cvt_pk_bf16(v0[0], v0[1]); w0.y = cvt_pk_bf16(v0[2], v0[3]); w1.x = cvt_pk_bf16(v1[0], v1[1]); w1.y = cvt_pk_bf16(v1[2], v1[3]);
                            bf16_t* dst = QI + (size_t)row * 1024 + ((pn - 12) * 4 + 2 * bj + (wc >> 1)) * 64; *(u32x2*)(dst + d0) = w0; *(u32x2*)(dst + d1) = w1; }
                    } }
        }
    }
};
template <class T> struct EpiTag { static constexpr int id = 0; };
template <> struct EpiTag<EpiA1> { static constexpr int id = 1; };
template <> struct EpiTag<EpiC1> { static constexpr int id = 2; };
template <> struct EpiTag<EpiM1<false>> { static constexpr int id = 3; };
template <> struct EpiTag<EpiM1<true>> { static constexpr int id = 4; };
template <class Epi, class Sched, bool ALIGN_EPI = false, bool SP2 = false, bool FP8 = false>
__device__ __forceinline__ void gemm_phase(PG8_LAS unsigned char* lds, const Gemm g, const Sched& S, const Epi& E) {
    int tid = threadIdx.x; asm volatile("" : "+v"(tid));
    const int wid = __builtin_amdgcn_readfirstlane(tid >> 6), lane = tid & 63, wr = wid >> 2, wc = wid & 3, fr = lane & 15, fq = lane >> 4;
    const int K = g.K, nt = K / BK;
    unsigned voffA[2], voffB[2];
#pragma unroll
    for (int i = 0; i < 2; ++i) { int R, C; stage_rc(tid * 16 + i * 8192, R, C); const int Rb = Epi::PERM ? ((R & ~31) + perm32(R & 31)) : R;
        voffA[i] = (unsigned)(R * K + C) * 2u; voffB[i] = (unsigned)(Rb * K + C) * 2u; }
    const size_t kstep = (size_t)(BK * 2);
    const size_t hstep = (size_t)HALF * K * 2;
    const size_t tstep = 2 * hstep;
    const unsigned ldsw = (unsigned)wid * 1024u;
    const int aoff = FP8 ? lds_byte(wr * 64 + fr, 16 * (fq & 1)) + (fq >> 1) * 1024 : lds_byte(wr * 64 + fr, fq * 8), boff = FP8 ? lds_byte(wc * 32 + fr, 16 * (fq & 1)) + (fq >> 1) * 1024 : lds_byte(wc * 32 + fr, fq * 8);
#define PG8_SA(b, h) (((b) * 2 + (h)) * HTB)
#define PG8_SB(b, h) ((4 + (b) * 2 + (h)) * HTB)
#define PG8_STAGE(bufoff, gbase, voff) do { _Pragma("unroll") for (int _i = 0; _i < 2; ++_i) \
        __builtin_amdgcn_global_load_lds((const unsigned*)((const char*)(gbase) + (voff)[_i]), (PG8_LAS unsigned*)(lds + (bufoff) + ldsw + _i * 8192), 16, 0, 0); } while (0)
#define PG8_LDA(dst, b, h) do { if constexpr (FP8) { _Pragma("unroll") for (int m = 0; m < 4; ++m) dst##8[m] = cat8(*(const PG8_LAS bf16x8*)(lds + PG8_SA(b, h) + aoff + m * 2048), *(const PG8_LAS bf16x8*)(lds + PG8_SA(b, h) + aoff + m * 2048 + 16)); } \
    else { _Pragma("unroll") for (int m = 0; m < 4; ++m) _Pragma("unroll") for (int k = 0; k < 2; ++k) dst[m][k] = *(const PG8_LAS bf16x8*)(lds + PG8_SA(b, h) + aoff + m * 2048 + k * 1024); } } while (0)
#define PG8_LDB(dst, b, h) do { if constexpr (FP8) { _Pragma("unroll") for (int n = 0; n < 2; ++n) dst##8[n] = cat8(*(const PG8_LAS bf16x8*)(lds + PG8_SB(b, h) + boff + n * 2048), *(const PG8_LAS bf16x8*)(lds + PG8_SB(b, h) + boff + n * 2048 + 16)); } \
    else { _Pragma("unroll") for (int n = 0; n < 2; ++n) _Pragma("unroll") for (int k = 0; k < 2; ++k) dst[n][k] = *(const PG8_LAS bf16x8*)(lds + PG8_SB(b, h) + boff + n * 2048 + k * 1024); } } while (0)
#define PG8_MMA(ai, bj, At, Bt) do { __builtin_amdgcn_s_setprio(1); if constexpr (FP8) { _Pragma("unroll") for (int m = 0; m < 4; ++m) _Pragma("unroll") for (int n = 0; n < 2; ++n) \
        asm volatile("v_mfma_scale_f32_16x16x128_f8f6f4 %0, %1, %2, %0, %3, %3 op_sel_hi:[0,0,0]" : "+v"(acc[ai][bj][m][n]) : "v"(Bt##8[n]), "v"(At##8[m]), "v"(sc1)); } \
    else { _Pragma("unroll") for (int m = 0; m < 4; ++m) _Pragma("unroll") for (int n = 0; n < 2; ++n) _Pragma("unroll") for (int k = 0; k < 2; ++k) \
        acc[ai][bj][m][n] = __builtin_amdgcn_mfma_f32_16x16x32_bf16(Bt[n][k], At[m][k], acc[ai][bj][m][n], 0, 0, 0); } __builtin_amdgcn_s_setprio(0); } while (0)
#define PG8_WAIT_V(n) asm volatile("s_waitcnt vmcnt(" #n ")" ::: "memory")
#define PG8_WAIT_L(n) asm volatile("s_waitcnt lgkmcnt(" #n ")" ::: "memory")
#define PG8_BAR __builtin_amdgcn_s_barrier()
#define PG8_SCHED __builtin_amdgcn_sched_barrier(0)
    Unit cur, nxt; int ui = 0;
    if (!S.next(0, cur)) return;
    f32x4 acc[2][2][4][2];
#pragma unroll
    for (int a = 0; a < 2; ++a)
#pragma unroll
        for (int b = 0; b < 2; ++b)
#pragma unroll
            for (int m = 0; m < 4; ++m)
#pragma unroll
                for (int n = 0; n < 2; ++n) acc[a][b][m][n] = (f32x4){0.f, 0.f, 0.f, 0.f};
    const int sc1 = 0x7f7f7f7f;
    bf16x8 At[4][2], B0[2][2], B1[2][2]; v8i_t At8[4], B08[2], B18[2];
    const char* cA = (const char*)g.A + (size_t)cur.pm * tstep; const char* cB = (const char*)g.Bt + (size_t)cur.pn * tstep;
    S.a_ready(cur);
    if constexpr (SP2) {
        PG8_STAGE(PG8_SB(0, 0), cB, voffB); PG8_STAGE(PG8_SB(0, 1), cB + hstep, voffB); PG8_STAGE(PG8_SA(0, 0), cA, voffA); PG8_STAGE(PG8_SA(0, 1), cA + hstep, voffA);
        if (wr == 1) PG8_BAR;
        PG8_WAIT_V(2); PG8_BAR;
        PG8_STAGE(PG8_SB(1, 0), cB + kstep, voffB); PG8_STAGE(PG8_SA(1, 0), cA + kstep, voffA); PG8_STAGE(PG8_SB(1, 1), cB + hstep + kstep, voffB);
        PG8_WAIT_V(6); PG8_BAR;
    } else {
        PG8_STAGE(PG8_SB(0, 0), cB, voffB); PG8_STAGE(PG8_SA(0, 0), cA, voffA); PG8_STAGE(PG8_SB(0, 1), cB + hstep, voffB); PG8_STAGE(PG8_SA(0, 1), cA + hstep, voffA);
        if (wr == 1) PG8_BAR;
        PG8_WAIT_V(4); PG8_BAR;
        PG8_STAGE(PG8_SB(1, 0), cB + kstep, voffB); PG8_STAGE(PG8_SA(1, 0), cA + kstep, voffA); PG8_STAGE(PG8_SB(1, 1), cB + hstep + kstep, voffB);
        PG8_WAIT_V(6); PG8_BAR;
    }
    for (;;) {
        const bool has_next = S.next(ui + 1, nxt);
        const char* nA = has_next ? (const char*)g.A + (size_t)nxt.pm * tstep : cA; const char* nB = has_next ? (const char*)g.Bt + (size_t)nxt.pn * tstep : cB;
        for (int t = 0; t < nt; t += 2) {
            const bool last = (t == nt - 2);
            const char* a1 = cA + (size_t)(t + 1) * kstep;
            const char* a2 = last ? nA : cA + (size_t)(t + 2) * kstep; const char* b2 = last ? nB : cB + (size_t)(t + 2) * kstep;
            const char* a3 = a2 + kstep; const char* b3 = b2 + kstep;
            if (last && has_next) S.a_ready(nxt);
            if constexpr (SP2) {
            PG8_LDB(B0, 0, 0); PG8_LDB(B1, 0, 1); PG8_SCHED; PG8_LDA(At, 0, 0); PG8_STAGE(PG8_SA(1, 1), a1 + hstep, voffA);
            PG8_WAIT_V(8); PG8_WAIT_L(0); PG8_BAR; PG8_MMA(0, 0, At, B0); PG8_MMA(0, 1, At, B1); PG8_BAR; PG8_SCHED;
            PG8_LDA(At, 0, 1); PG8_STAGE(PG8_SB(0, 0), b2, voffB); PG8_STAGE(PG8_SB(0, 1), b2 + hstep, voffB); PG8_STAGE(PG8_SA(0, 0), a2, voffA);
            PG8_WAIT_V(8); PG8_WAIT_L(0); PG8_BAR; PG8_MMA(1, 0, At, B0); PG8_MMA(1, 1, At, B1); PG8_BAR; PG8_SCHED;
            PG8_LDB(B0, 1, 0); PG8_LDB(B1, 1, 1); PG8_SCHED; PG8_LDA(At, 1, 0); PG8_STAGE(PG8_SA(0, 1), a2 + hstep, voffA);
            PG8_WAIT_V(8); PG8_WAIT_L(0); PG8_BAR; PG8_MMA(0, 0, At, B0); PG8_MMA(0, 1, At, B1); PG8_BAR; PG8_SCHED;
            PG8_LDA(At, 1, 1); PG8_STAGE(PG8_SB(1, 0), b3, voffB); PG8_STAGE(PG8_SB(1, 1), b3 + hstep, voffB); PG8_STAGE(PG8_SA(1, 0), a3, voffA);
            PG8_WAIT_V(8); PG8_WAIT_L(0); PG8_BAR; PG8_MMA(1, 0, At, B0); PG8_MMA(1, 1, At, B1); PG8_BAR; PG8_SCHED;
            } else {
            PG8_LDB(B0, 0, 0); PG8_SCHED; PG8_LDA(At, 0, 0); PG8_STAGE(PG8_SA(1, 1), a1 + hstep, voffA);
            PG8_WAIT_L(8); PG8_BAR; PG8_WAIT_L(0); PG8_MMA(0, 0, At, B0); PG8_BAR; PG8_SCHED;
            PG8_LDB(B1, 0, 1); PG8_STAGE(PG8_SB(0, 0), b2, voffB);
            PG8_BAR; PG8_WAIT_L(0); PG8_MMA(0, 1, At, B1); PG8_BAR;
            PG8_LDA(At, 0, 1); PG8_STAGE(PG8_SA(0, 0), a2, voffA);
            PG8_BAR; PG8_WAIT_L(0); PG8_MMA(1, 0, At, B0); PG8_BAR; PG8_SCHED;
            PG8_STAGE(PG8_SB(0, 1), b2 + hstep, voffB);
            PG8_WAIT_V(6); PG8_BAR; PG8_MMA(1, 1, At, B1); PG8_BAR;
            PG8_LDB(B0, 1, 0); PG8_SCHED; PG8_LDA(At, 1, 0); PG8_STAGE(PG8_SA(0, 1), a2 + hstep, voffA);
            PG8_WAIT_L(8); PG8_BAR; PG8_WAIT_L(0); PG8_MMA(0, 0, At, B0); PG8_BAR; PG8_SCHED;
            PG8_LDB(B1, 1, 1); PG8_STAGE(PG8_SB(1, 0), b3, voffB);
            PG8_BAR; PG8_WAIT_L(0); PG8_MMA(0, 1, At, B1); PG8_BAR;
            PG8_LDA(At, 1, 1); PG8_STAGE(PG8_SA(1, 0), a3, voffA);
            PG8_BAR; PG8_WAIT_L(0); PG8_MMA(1, 0, At, B0); PG8_BAR; PG8_SCHED;
            PG8_STAGE(PG8_SB(1, 1), b3 + hstep, voffB);
            PG8_WAIT_V(6); PG8_BAR; PG8_MMA(1, 1, At, B1); PG8_BAR;
            }
        }
        if constexpr (ALIGN_EPI) { if (wr == 0) PG8_BAR; }
#if defined(DBG_EPI_TYPE)
        unsigned long long et_ = 0; if (EpiTag<Epi>::id == DBG_EPI_TYPE && blockIdx.x == 0 && threadIdx.x == 0) et_ = __builtin_amdgcn_s_memrealtime();
#endif
        if constexpr (!Epi::AFTER_DRAIN) { E(acc, cur, wr, wc, fr, fq); S.done(cur); }
#if defined(DBG_EPI_TYPE)
        if (EpiTag<Epi>::id == DBG_EPI_TYPE && blockIdx.x == 0 && threadIdx.x == 0) { asm volatile("s_waitcnt vmcnt(0)" ::: "memory"); *(volatile PG8_LAS unsigned*)(lds + 150016 + 80) += (unsigned)(__builtin_amdgcn_s_memrealtime() - et_); }
#endif
        if (!has_next) break;
#pragma unroll
        for (int a = 0; a < 2; ++a)
#pragma unroll
            for (int b = 0; b < 2; ++b)
#pragma unroll
                for (int m = 0; m < 4; ++m)
#pragma unroll
                    for (int n = 0; n < 2; ++n) acc[a][b][m][n] = (f32x4){0.f, 0.f, 0.f, 0.f};
        cur = nxt; cA = nA; cB = nB; ++ui;
        if constexpr (ALIGN_EPI) { if (wr == 1) PG8_BAR; }
    }
    PG8_WAIT_V(0);
    if constexpr (!ALIGN_EPI) { if (wr == 0) PG8_BAR; }
    PG8_BAR;
    if constexpr (Epi::AFTER_DRAIN) { E.fused(acc, cur, wr, wc, fr, fq, lds, wid, lane); S.done(cur); }
#undef PG8_SA
#undef PG8_SB
#undef PG8_STAGE
#undef PG8_LDA
#undef PG8_LDB
#undef PG8_MMA
#undef PG8_WAIT_V
#undef PG8_WAIT_L
#undef PG8_BAR
#undef PG8_SCHED
}
}
#ifndef ATT_THR
#define ATT_THR 16.f
#endif
namespace att {
typedef unsigned short bf16;
typedef short bf16x8 __attribute__((ext_vector_type(8)));
typedef short s16x4 __attribute__((ext_vector_type(4)));
typedef float f32x16 __attribute__((ext_vector_type(16)));
typedef float f32x4 __attribute__((ext_vector_type(4)));
typedef unsigned u32x4 __attribute__((ext_vector_type(4)));
typedef unsigned long long u64;
constexpr int D = 128, SEQ = 4096, QP = 2048, KP = 512;
constexpr float SCALE = 0.08838834764831845f;
constexpr float THR = ATT_THR;
constexpr int NW = 8, QBLK = 32, KVBLK = 64, QB = NW * QBLK;
constexpr int SHM_V = KVBLK * D * 2, SHM_K = KVBLK * D * 2;
constexpr int LDS_BYTES = 2 * SHM_V + 2 * SHM_K + NW * 64 * 4;

#define KSWZ(row, colB) ((row) * 256 + ((colB) ^ (((row) & 7) << 4)))
#define SBAR() __builtin_amdgcn_sched_barrier(0)
__device__ __forceinline__ int v_st(int k, int c) { const int kk = (k & ~0xC) | ((k & 4) << 1) | ((k & 8) >> 1); return ((kk >> 3) * 4 + (c >> 5)) * 512 + ((kk & 7) * 32 + (c & 31)) * 2; }
__device__ __forceinline__ int v_rd_base(int lane) { return ((lane & 3) << 3) | (((lane >> 2) & 3) << 6) | (((lane >> 4) & 1) << 5) | (((lane >> 5) & 1) << 8); }
constexpr int v_rd_off(int d0, int ks, int half) { return d0 * 512 + ks * 4096 + half * 2048; }
__device__ __forceinline__ int crow(int r, int hi) { return (r & 3) + 8 * (r >> 2) + 4 * hi; }
__device__ __forceinline__ unsigned cvtpk(float lo, float hi) { unsigned r; asm volatile("v_cvt_pk_bf16_f32 %0, %1, %2" : "=v"(r) : "v"(lo), "v"(hi)); return r; }
__device__ __forceinline__ bf16x8 load8(const bf16* p) { return *reinterpret_cast<const bf16x8*>(p); }
template <bool NOP> __device__ __forceinline__ void mask_tile(f32x16& p0, f32x16& p1, u64 mk, int hi) {
    const unsigned m0 = (unsigned)mk >> (4 * hi), m1 = (unsigned)(mk >> 32) >> (4 * hi);
    const unsigned NEGINF = 0xFF800000u;
    if (NOP) asm volatile("s_nop 15\n\ts_nop 7" ::: "memory");
#pragma unroll
    for (int r = 0; r < 16; ++r) {
        const int c = (r & 3) + 8 * (r >> 2);
        unsigned t0, t1;
        asm volatile("v_bfe_i32 %0, %1, %2, 1" : "=v"(t0) : "v"(m0), "n"(c));
        asm volatile("v_bfi_b32 %0, %1, %0, %2" : "+v"(p0[r]) : "v"(t0), "s"(NEGINF));
        asm volatile("v_bfe_i32 %0, %1, %2, 1" : "=v"(t1) : "v"(m1), "n"(c));
        asm volatile("v_bfi_b32 %0, %1, %0, %2" : "+v"(p1[r]) : "v"(t1), "s"(NEGINF));
    }
}
__device__ __forceinline__ void partialSM(f32x16& p0, f32x16& p1, float& m_reg, float& mn, float& alpha) {
    float pmax = p0[0]; for (int r = 1; r < 16; ++r) pmax = fmaxf(pmax, p0[r]); for (int r = 0; r < 16; ++r) pmax = fmaxf(pmax, p1[r]);
    { auto rr = __builtin_amdgcn_permlane32_swap(__float_as_uint(pmax), __float_as_uint(pmax), false, false);
      pmax = fmaxf(__uint_as_float(rr[0]), __uint_as_float(rr[1])); }
    constexpr float C2 = 1.4426950408889634f * SCALE;
    if (__builtin_expect(__all((pmax - m_reg) * SCALE <= THR), 1)) { mn = m_reg; alpha = 1.f; }
    else { mn = fmaxf(m_reg, pmax); alpha = __builtin_amdgcn_exp2f((m_reg - mn) * C2); m_reg = mn; }
    const float mnL = -mn * C2;
    for (int r = 0; r < 16; ++r) p0[r] = fmaf(p0[r], C2, mnL); for (int r = 0; r < 16; ++r) p1[r] = fmaf(p1[r], C2, mnL);
    for (int r = 0; r < 16; ++r) p0[r] = __builtin_amdgcn_exp2f(p0[r]);
}
__device__ __forceinline__ void finishSM(f32x16& p0, f32x16& p1, float alpha, float& l_reg, bf16x8& pa0, bf16x8& pa1, bf16x8& pa2, bf16x8& pa3) {
    for (int r = 0; r < 16; ++r) p1[r] = __builtin_amdgcn_exp2f(p1[r]);
    float ps = 0; for (int r = 0; r < 16; ++r) ps += p0[r]; for (int r = 0; r < 16; ++r) ps += p1[r];
    { auto rr = __builtin_amdgcn_permlane32_swap(__float_as_uint(ps), __float_as_uint(ps), false, false);
      ps = __uint_as_float(rr[0]) + __uint_as_float(rr[1]); }
    l_reg = l_reg * alpha + ps;
#define PK4(P, B_, OUT) do { unsigned a0 = cvtpk(P[B_+0], P[B_+1]), a1 = cvtpk(P[B_+2], P[B_+3]);                          \
        unsigned b0 = cvtpk(P[B_+4], P[B_+5]), b1 = cvtpk(P[B_+6], P[B_+7]);                                             \
        auto r0 = __builtin_amdgcn_permlane32_swap(a0, b0, false, false); auto r1 = __builtin_amdgcn_permlane32_swap(a1, b1, false, false); \
        u32x4 w = {r0[0], r1[0], r0[1], r1[1]}; OUT = *reinterpret_cast<bf16x8*>(&w); } while (0)
    PK4(p0, 0, pa0); PK4(p0, 8, pa1); PK4(p1, 0, pa2); PK4(p1, 8, pa3);
#undef PK4
}
template <int KB>
__device__ __forceinline__ void qkt(f32x16& p0, f32x16& p1, const char* K_lds, int r32, int hi, const bf16x8* qr) {
    p0 = f32x16{}; p1 = f32x16{};
    const char* kb[4];
#pragma unroll
    for (int dd = 0; dd < 4; ++dd) kb[dd] = K_lds + KB * SHM_K + KSWZ(r32, (dd * 16 + hi * 8) * 2);
#pragma unroll
    for (int d0 = 0; d0 < 8; ++d0) { const char* a = kb[d0 & 3] + (d0 >> 2) * 128;
        bf16x8 b0 = *reinterpret_cast<const bf16x8*>(a);
        bf16x8 b1 = *reinterpret_cast<const bf16x8*>(a + 32 * 256);
        p0 = __builtin_amdgcn_mfma_f32_32x32x16_bf16(b0, qr[d0], p0, 0, 0, 0);
        p1 = __builtin_amdgcn_mfma_f32_32x32x16_bf16(b1, qr[d0], p1, 0, 0, 0); }
}
template <int VB>
__device__ __forceinline__ void pv_tile(f32x16* o, int vb0, bf16x8 pa0, bf16x8 pa1, bf16x8 pa2, bf16x8 pa3) {
#define TRRD(dst, off) asm volatile("ds_read_b64_tr_b16 %0, %1 offset:%2" : "=&v"(dst) : "v"(vb0), "i"(off) : "memory")
#define PV_D0(d0) do { s16x4 l0, l1, l2, l3, h0, h1, h2, h3; constexpr int b_ = VB * SHM_V + v_rd_off(d0, 0, 0); \
        TRRD(l0, b_); TRRD(h0, b_ + 2048); TRRD(l1, b_ + 4096); TRRD(h1, b_ + 6144); TRRD(l2, b_ + 8192); TRRD(h2, b_ + 10240); TRRD(l3, b_ + 12288); TRRD(h3, b_ + 14336); \
        asm volatile("s_waitcnt lgkmcnt(0)" ::: "memory"); SBAR();   \
        o[d0] = __builtin_amdgcn_mfma_f32_32x32x16_bf16(pa0, (bf16x8){l0[0], l0[1], l0[2], l0[3], h0[0], h0[1], h0[2], h0[3]}, o[d0], 0, 0, 0);   \
        o[d0] = __builtin_amdgcn_mfma_f32_32x32x16_bf16(pa1, (bf16x8){l1[0], l1[1], l1[2], l1[3], h1[0], h1[1], h1[2], h1[3]}, o[d0], 0, 0, 0);   \
        o[d0] = __builtin_amdgcn_mfma_f32_32x32x16_bf16(pa2, (bf16x8){l2[0], l2[1], l2[2], l2[3], h2[0], h2[1], h2[2], h2[3]}, o[d0], 0, 0, 0);   \
        o[d0] = __builtin_amdgcn_mfma_f32_32x32x16_bf16(pa3, (bf16x8){l3[0], l3[1], l3[2], l3[3], h3[0], h3[1], h3[2], h3[3]}, o[d0], 0, 0, 0); } while (0)
    PV_D0(0); PV_D0(1); PV_D0(2); PV_D0(3);
#undef PV_D0
#undef TRRD
}
__device__ __forceinline__ u64 causal_word(int n) { return n >= 64 ? ~0ull : (n <= 0 ? 0ull : ((1ull << n) - 1ull)); }
struct BlockRef { const bf16* Q; const bf16* K; const bf16* V; bf16* O; const u64* M; int P0; };
struct Seam { bf16x8 qr[8]; bf16x8 st_v0, st_v1, st_k0, st_k1; };
#define ROW(p, k0, rr) ((p) + (unsigned)(((k0) + (rr)) * KP + sc))
#define VMW() asm volatile("s_waitcnt vmcnt(0)" ::: "memory")
#define VMWN(n) asm volatile("s_waitcnt vmcnt(%0)" :: "i"(n) : "memory")
#define SLOAD_H(Kp, Vp, k0) do { S.st_v0 = load8(ROW(Vp, k0, sr)); S.st_v1 = load8(ROW(Vp, k0, 32 + sr));              \
                         S.st_k0 = load8(ROW(Kp, k0, sr)); S.st_k1 = load8(ROW(Kp, k0, 32 + sr)); } while (0)
#define SWRITE_HK(bf) do { *(bf16x8*)(K_lds + (bf) * SHM_K + kws) = S.st_k0; *(bf16x8*)(K_lds + (bf) * SHM_K + kws + 32 * 256) = S.st_k1; } while (0)
#define SWRITE_HV(bf) do { *(bf16x8*)(V_lds + (bf) * SHM_V + vst0) = S.st_v0; *(bf16x8*)(V_lds + (bf) * SHM_V + vst1) = S.st_v1; } while (0)
#define SWRITE_H(bf) do { SWRITE_HV(bf); SWRITE_HK(bf); } while (0)
__device__ __forceinline__ void attn_prime(const BlockRef& cur, char* lds, Seam& S) {
    int tid = threadIdx.x; asm volatile("" : "+v"(tid));
    const int wid = __builtin_amdgcn_readfirstlane(tid >> 6), lane = tid & 63, r32 = lane & 31, hi = lane >> 5;
    const int sr = tid >> 4, sc = (tid & 15) * 8, kws = KSWZ(sr, sc * 2); char* K_lds = lds + 2 * SHM_V;
    for (int d0 = 0; d0 < 8; ++d0) S.qr[d0] = load8(cur.Q + (unsigned)((wid * QBLK + r32) * QP + d0 * 16 + hi * 8));
    SLOAD_H(cur.K, cur.V, 0); VMW(); SWRITE_HK(0);
    __syncthreads();
}
__device__ __forceinline__ void attn_block(const BlockRef& cur, const BlockRef& nxt, char* lds, Seam& S) {
    int tid = threadIdx.x; asm volatile("" : "+v"(tid));
    const int wid = __builtin_amdgcn_readfirstlane(tid >> 6), lane = tid & 63, r32 = lane & 31, hi = lane >> 5;
    const int NT = (cur.P0 + QB - 1) / KVBLK + 1;
    char* V_lds = lds; char* K_lds = lds + 2 * SHM_V;
    float* ws = (float*)(lds + 2 * SHM_V + 2 * SHM_K) + wid * 64; float* li_l = ws, * al_l = ws + 32;
    float m_reg = -1e30f, l_reg = 0; f32x16 o[4] = {};
    const int sr = tid >> 4, sc = (tid & 15) * 8, vst0 = v_st(sr, sc), vst1 = v_st(32 + sr, sc), kws = KSWZ(sr, sc * 2);
    const int vb0 = (int)(uintptr_t)V_lds + v_rd_base(lane);
    const bf16* Kh = cur.K; const bf16* Vh = cur.V;
    const u64* Mb = cur.M; const unsigned mo = (unsigned)(cur.P0 + wid * QBLK + r32);
#if defined(DBG_CAUSAL_ONLY)
#define LOADMK(t) causal_word((int)mo - 64 * (t) + 1)
#else
#define LOADMK(t) Mb[mo + (unsigned)((t) * SEQ)]
#endif
#define RESC(a) do { if (__any((a) < 1.f)) { if (hi == 0) al_l[r32] = (a); asm volatile("s_waitcnt lgkmcnt(0)" ::: "memory");              \
                     for (int d_ = 0; d_ < 4; ++d_) for (int r = 0; r < 16; ++r) o[d_][r] *= al_l[crow(r, hi)]; } } while (0)
#define KBASE(t) ((t) * KVBLK)
#define SEAM_K0() do { VMWN(8); SWRITE_HK(0); SBAR(); } while (0)
    f32x16 pA0, pA1, pB0, pB1; float mnA, mnB, alA, alB; bf16x8 pa0, pa1, pa2, pa3; u64 mk;
    SWRITE_HV(0); SBAR();
    mk = LOADMK(0);
    if (NT > 1) { SLOAD_H(Kh, Vh, KBASE(1)); }
    SBAR(); qkt<0>(pA0, pA1, K_lds, r32, hi, S.qr); SBAR();
    VMW();
    mask_tile<true>(pA0, pA1, mk, hi); partialSM(pA0, pA1, m_reg, mnA, alA);
    if (NT > 1) { SWRITE_H(1); }
    __syncthreads();
#define HALF_STEP(PX0, PX1, mnX, alX, PY0, PY1, alY, t, KB, VB, SB) do {                                                     \
        mk = LOADMK(t);                                                                                           \
        SBAR(); qkt<KB>(PX0, PX1, K_lds, r32, hi, S.qr);                                                                      \
        finishSM(PY0, PY1, alY, l_reg, pa0, pa1, pa2, pa3); SBAR();                                                           \
        if ((t) + 1 < NT) { SLOAD_H(Kh, Vh, KBASE((t) + 1)); SBAR(); }                                                        \
        pv_tile<VB>(o, vb0, pa0, pa1, pa2, pa3);                                                                              \
        if ((t) + 1 < NT) VMWN(4); else VMW();                                                                                \
        mask_tile<false>(PX0, PX1, mk, hi); partialSM(PX0, PX1, m_reg, mnX, alX);                                                    \
        __syncthreads();                                                                                                      \
        if ((t) + 1 < NT) { VMW(); SWRITE_H(SB); }                                                                            \
        RESC(alX); __syncthreads(); } while (0)
    for (int t = 1; t + 1 < NT; t += 2) {
        HALF_STEP(pB0, pB1, mnB, alB, pA0, pA1, alA, t, 1, 0, 0);
        HALF_STEP(pA0, pA1, mnA, alA, pB0, pB1, alB, t + 1, 0, 1, 1);
    }
    const bool even = (NT & 1) == 0;
    if (even) { mk = LOADMK(NT - 1); SBAR(); qkt<1>(pB0, pB1, K_lds, r32, hi, S.qr); SBAR(); }
    SLOAD_H(nxt.K, nxt.V, 0); SBAR();
#pragma unroll
    for (int d0 = 0; d0 < 8; ++d0) S.qr[d0] = load8(nxt.Q + (unsigned)((wid * QBLK + r32) * QP + d0 * 16 + hi * 8));
    SBAR();
    finishSM(pA0, pA1, alA, l_reg, pa0, pa1, pa2, pa3); SBAR();
    pv_tile<0>(o, vb0, pa0, pa1, pa2, pa3);
    if (even) { VMWN(12); mask_tile<false>(pB0, pB1, mk, hi); partialSM(pB0, pB1, m_reg, mnB, alB); __syncthreads(); RESC(alB);
        finishSM(pB0, pB1, alB, l_reg, pa0, pa1, pa2, pa3); SBAR(); pv_tile<1>(o, vb0, pa0, pa1, pa2, pa3); }
    SBAR(); SEAM_K0();
    if (hi == 0) li_l[r32] = l_reg; asm volatile("s_waitcnt lgkmcnt(0)" ::: "memory");
    float rli[16];
#pragma unroll
    for (int r = 0; r < 16; ++r) rli[r] = __builtin_amdgcn_rcpf(li_l[crow(r, hi)]);
    bf16* Ow = cur.O + (unsigned)((wid * QBLK) * QP);
#pragma unroll
    for (int r = 0; r < 16; ++r) { const int orow = crow(r, hi);
#pragma unroll
        for (int d0 = 0; d0 < 4; ++d0) { const float v = o[d0][r] * rli[r];
            const float vn = __shfl_xor(v, 1);
            if ((r32 & 1) == 0) *(unsigned*)(Ow + (unsigned)(orow * QP + d0 * 32 + r32)) = cvtpk(v, vn); } }
    __syncthreads();
#undef RESC
#undef KBASE
#undef SEAM_K0
#undef HALF_STEP
}
#undef ROW
#undef VMW
#undef VMWN
#undef SLOAD_H
#undef SWRITE_HK
#undef SWRITE_HV
#undef SWRITE_H
struct Item { int bh, qb0, qb1; };
__device__ __forceinline__ Item decode(int L) {
    constexpr int G = 4, nx = 8, per = G * nx; Item it;
    const int xcd = L & 7, k = L >> 3, gi = k / per, r = k - gi * per;
    it.bh = (gi * 8 + xcd) * G + r / nx; const int x = r % nx;
    it.qb0 = x; it.qb1 = 15 - x; return it;
}
struct Tensors { const bf16* Q; const bf16* K; const bf16* V; bf16* O; const u64* M; };
__device__ __forceinline__ BlockRef make_ref(const Item& it, int pass, const Tensors& T) {
    const int qb = pass ? it.qb1 : it.qb0, b = it.bh >> 4, h = it.bh & 15, kvh = h >> 2;
    BlockRef r;
    r.Q = T.Q + ((size_t)b * SEQ + (size_t)qb * QB) * QP + h * D; r.O = T.O + ((size_t)b * SEQ + (size_t)qb * QB) * QP + h * D;
    r.K = T.K + (size_t)b * SEQ * KP + kvh * D; r.V = T.V + (size_t)b * SEQ * KP + kvh * D; r.M = T.M + (size_t)b * 64 * SEQ; r.P0 = qb * QB;
    return r;
}
__device__ __forceinline__ void attn_phase(char* lds, const Tensors& T, int wg, int nwg) {
    constexpr int total = 512;
    int L = wg; if (L >= total) return;
    Item it = decode(L); int pass = 0;
    BlockRef cur = make_ref(it, 0, T);
    Seam S;
    attn_prime(cur, lds, S);
    for (;;) {
        const bool more_pass = pass == 0 && it.qb1 != it.qb0, more_item = L + nwg < total, last = !more_pass && !more_item;
        Item itn = it; int passn = pass + 1, Ln = L;
        if (!more_pass) { passn = 0; Ln = more_item ? L + nwg : L; itn = decode(Ln); }
        const BlockRef nxt = last ? cur : make_ref(itn, passn, T);
        attn_block(cur, nxt, lds, S);
        if (last) break;
        cur = nxt; it = itn; pass = passn; L = Ln;
    }
}
#undef KSWZ
#undef SBAR
}
constexpr int NWAVES = 8;
#ifndef DBG_P0_TIME
#define DBG_P0_TIME 0
#endif
#define P0T_BEGIN(k) unsigned long long p0t##k = 0; if (DBG_P0_TIME == (k) && blockIdx.x == 0 && threadIdx.x == 0) p0t##k = __builtin_amdgcn_s_memrealtime()
#define P0T_END(k) do { if (DBG_P0_TIME == (k) && blockIdx.x == 0 && threadIdx.x == 0) { asm volatile("s_waitcnt vmcnt(0)" ::: "memory"); F.MISC[20] += (unsigned)(__builtin_amdgcn_s_memrealtime() - p0t##k); } } while (0)
#ifndef P0_NT
#define P0_NT 1
#endif
#if P0_NT
#define P0_LOAD(p) __builtin_nontemporal_load(p)
#else
#define P0_LOAD(p) (*(p))
#endif
#ifndef DBG_IDX_TID
#define DBG_IDX_TID 0
#endif
#ifndef DBG_IDX_TIME
#define DBG_IDX_TIME 0
#endif
#define IDXT_BEGIN(k) unsigned long long idxt_ = 0; if (DBG_IDX_TIME == (k) && blockIdx.x == 0 && threadIdx.x == DBG_IDX_TID) idxt_ = __builtin_amdgcn_s_memrealtime()
#define IDXT_END(k) do { if (DBG_IDX_TIME == (k) && blockIdx.x == 0 && threadIdx.x == DBG_IDX_TID) { const unsigned long long d_ = __builtin_amdgcn_s_memrealtime() - idxt_; F.MISC[20] += (unsigned)d_; } } while (0)
#ifndef C2_FP8
#define C2_FP8 0x8
#endif
#ifndef C1_FP8
#define C1_FP8 0x8
#endif
#ifndef M1_FP8
#define M1_FP8 0xC
#endif
#ifndef MLP_FP8
#define MLP_FP8 0xE
#endif
#ifndef DBG_TIME_PHASE
#define DBG_TIME_PHASE -1
#endif
#ifndef DBG_TIME_TO
#define DBG_TIME_TO (DBG_TIME_PHASE + 1)
#endif
#ifndef DBG_CLK_PHASE
#define DBG_CLK_PHASE -1
#endif
#define CLKSTAMP(k) do { if (DBG_CLK_PHASE >= 0 && (DBG_CLK_PHASE == (k) || DBG_CLK_PHASE + 1 == (k)) && blockIdx.x == 0 && threadIdx.x == 0) { const unsigned long long c_ = __builtin_readcyclecounter(), r_ = __builtin_amdgcn_s_memrealtime(); \
    volatile LAS unsigned* m_ = F.MISC + (DBG_CLK_PHASE == (k) ? 32 : 36); m_[0] = (unsigned)c_; m_[1] = (unsigned)(c_ >> 32); m_[2] = (unsigned)r_; m_[3] = (unsigned)(r_ >> 32); } } while (0)
#define STAMP(k) do { CLKSTAMP(k); if (DBG_TIME_PHASE >= 0 && (DBG_TIME_PHASE == (k) || DBG_TIME_TO == (k)) && blockIdx.x == 0 && threadIdx.x == 0) { const unsigned long long ts_ = __builtin_amdgcn_s_memrealtime(); volatile LAS unsigned* m_ = F.MISC + (DBG_TIME_PHASE == (k) ? 16 : 18); m_[0] = (unsigned)ts_; m_[1] = (unsigned)(ts_ >> 32); } } while (0)
#ifndef DBG_IDX_REP_SCORE
#define DBG_IDX_REP_SCORE 0
#endif
#ifndef DBG_IDX_REP_SEL
#define DBG_IDX_REP_SEL 0
#endif
#ifndef PG8_ALIGN_X
#define PG8_ALIGN_X true
#endif
#ifndef PG8_SP2_F8
#define PG8_SP2_F8 true
#endif
#ifndef PG8_SP2_X
#define PG8_SP2_X true
#endif
#ifndef DBG_A4_SRC
#define DBG_A4_SRC WS_O
#endif
#ifndef MK_PER_PHASE
#define MK_PER_PHASE 0
#endif
constexpr int BATCH = 4, SEQ = 4096, DM = 2048, M = BATCH * SEQ, DFF = 8192, DEPTH = 4;
constexpr int NA1 = 4352, NA1_SRC = 4176, NC1 = 6144;
constexpr int TOPK = 256;
constexpr size_t MiB = 1u << 20;
constexpr size_t WS_CTL = 0, CTL_ZERO_BYTES = 3 * MiB;
constexpr int CW_P0Q = 8192;
constexpr int CW_BAR = 4096;
constexpr size_t WS_SSQ = 1 * MiB;
constexpr size_t WS_ROPEM = 3 * MiB;
constexpr size_t WS_ROPEI = 5 * MiB;
constexpr size_t WS_SMALL = WS_ROPEI + 512 * 1024;
constexpr size_t WS_QG = WS_SMALL, WS_KG = WS_SMALL + 1024, WS_CONVW = WS_SMALL + 4096, WS_INPTR = WS_SMALL + 65536;
constexpr size_t WS_WA1 = 6 * MiB;  static_assert(WS_SSQ + 9 * (size_t)M * 8 <= CTL_ZERO_BYTES, "ssq inside memset");
constexpr size_t SZ_WA1 = (size_t)NA1 * DM * 2;
constexpr size_t WS_WA4 = WS_WA1 + 2 * SZ_WA1;
constexpr size_t SZ_WSQ = (size_t)DM * DM * 2;
constexpr size_t WS_WC1 = WS_WA4 + 2 * SZ_WSQ;
constexpr size_t SZ_WC1 = (size_t)NC1 * DM * 2;
constexpr size_t WS_WC2 = WS_WC1 + 2 * SZ_WC1;
constexpr size_t WS_WM1 = WS_WC2 + 2 * SZ_WSQ;
constexpr size_t SZ_WM = (size_t)DFF * DM * 2;
constexpr size_t WS_WM2 = WS_WM1 + 4 * SZ_WM;
constexpr size_t WS_XB = WS_WM2 + 4 * SZ_WM;
constexpr size_t WS_ACT = WS_XB + (size_t)M * DM * 2;
constexpr size_t SZ_MD = (size_t)M * DM * 2;
constexpr size_t WS_H = WS_ACT;
constexpr size_t WS_Q = WS_ACT, WS_O = WS_ACT + SZ_MD, WS_K = WS_ACT + 2 * SZ_MD, WS_V = WS_K + 16 * MiB, WS_QI = WS_V + 16 * MiB, WS_KI = WS_QI + 32 * MiB,
                 WS_WI = WS_KI + 2 * MiB, WS_MASK = WS_WI + 1 * MiB;
constexpr size_t WS_BG = WS_ACT, WS_Z = WS_ACT + SZ_MD, WS_G = WS_ACT + 2 * SZ_MD;
constexpr size_t WS_END = WS_ACT + 256 * MiB;
constexpr size_t WS_XB8 = WS_END;
static_assert(WS_MASK + 8 * MiB <= WS_END && WS_G + SZ_MD <= WS_END && WS_H + (size_t)M * DFF * 2 <= WS_END, "d_ws map");
constexpr int RING_OFF = 0, RING_BYTES = 131072;
constexpr int AUX_OFF = RING_BYTES, AUX_BYTES = 16384 + 2048 + 512;
constexpr int MISC_OFF = AUX_OFF + AUX_BYTES;
constexpr int WQ_OFF = MISC_OFF + 256;
constexpr int LDS_BYTES = WQ_OFF + 512;
static_assert(LDS_BYTES <= 160 * 1024 && MISC_OFF == 150016, "LDS map");

#define GAS __attribute__((address_space(1)))
#define LAS __attribute__((address_space(3)))
typedef unsigned short bf16;
typedef unsigned v4u __attribute__((ext_vector_type(4)));
typedef unsigned v2u __attribute__((ext_vector_type(2)));
typedef float f32x4 __attribute__((ext_vector_type(4)));
typedef short bf16x8 __attribute__((ext_vector_type(8)));
typedef float f32x16 __attribute__((ext_vector_type(16)));
typedef GAS unsigned gu32;
#define RLX_AGENT __ATOMIC_RELAXED, __HIP_MEMORY_SCOPE_AGENT
#define LDS_WAIT() asm volatile("s_waitcnt lgkmcnt(0)" ::: "memory")
#define VM_WAIT() asm volatile("s_waitcnt vmcnt(0)" ::: "memory")
__device__ __forceinline__ unsigned f2bf(float f) { unsigned u = __builtin_bit_cast(unsigned, f); return (u + 0x7fffu + ((u >> 16) & 1u)) >> 16; }
__device__ __forceinline__ unsigned pk2(float lo, float hi) { return f2bf(lo) | (f2bf(hi) << 16); }
__device__ __forceinline__ float bf2f(unsigned short b) { return __uint_as_float((unsigned)b << 16); }
__device__ __forceinline__ float wave_sum(float v) {
#pragma unroll
    for (int o = 1; o < 64; o <<= 1) v += __shfl_xor(v, o);
    return v;
}
__device__ __forceinline__ float wave_min(float v) {
#pragma unroll
    for (int o = 1; o < 64; o <<= 1) v = fminf(v, __shfl_xor(v, o));
    return v;
}
__device__ __forceinline__ float wave_max(float v) {
#pragma unroll
    for (int o = 1; o < 64; o <<= 1) v = fmaxf(v, __shfl_xor(v, o));
    return v;
}

#define XB_TMO      128
#define XB_XCNT(j)  (256  + 64 * (j))
#define XB_XSUB(j)  (1280 + 64 * (j))
#define XB_XGEN(j)  (2304 + 64 * (j))
#define XB_TOP      3328
#define XB_TOPGEN   3392
#define XCD_BAR_WORDS 3456
#define XB_SPIN_CAP (1u << 18)

__device__ __forceinline__ unsigned xb_ld(unsigned* p)              { return __hip_atomic_load(p, __ATOMIC_RELAXED, __HIP_MEMORY_SCOPE_AGENT); }
__device__ __forceinline__ unsigned xb_add(unsigned* p, unsigned v) { return __hip_atomic_fetch_add(p, v, __ATOMIC_RELAXED, __HIP_MEMORY_SCOPE_AGENT); }
__device__ __forceinline__ unsigned xb_xcc_id() { return (unsigned)__builtin_amdgcn_s_getreg((3 << 11) | 20) & 0xFu; }
#define XB_SPIN(cond, bar) do { unsigned _sp = 0; while (cond) { __builtin_amdgcn_s_sleep(1); \
    if ((++_sp & 255u) == 0u) { if (xb_ld(&(bar)[XB_TMO])) break; if (_sp > XB_SPIN_CAP) { atomicAdd(&(bar)[XB_TMO], 1u); break; } } } } while (0)

struct XcdBarrier {
    unsigned* bar; unsigned x;
    volatile LAS unsigned* st;
};

__device__ __forceinline__ XcdBarrier xcd_barrier_post(unsigned* bar, volatile LAS unsigned* st) {
    XcdBarrier b; b.bar = bar; b.x = xb_xcc_id(); b.st = st;
    if (threadIdx.x == 0) (void)xb_add(&bar[XB_XCNT(b.x)], 1u);
    return b;
}
__device__ __forceinline__ void xcd_barrier_complete(unsigned* bar, unsigned x, unsigned& nloc, unsigned& nx) {
    const unsigned G = gridDim.x * gridDim.y * gridDim.z;
    unsigned sum, cnt, mine, sp = 0u;
    for (;;) {
        sum = 0u; cnt = 0u; mine = 0u;
#pragma unroll
        for (unsigned j = 0; j < 16; ++j) { const unsigned c = xb_ld(&bar[XB_XCNT(j)]); sum += c; cnt += (c > 0u) ? 1u : 0u; mine = (j == x) ? c : mine; }
        if (sum == G) break;
        __builtin_amdgcn_s_sleep(1);
        if ((++sp & 255u) == 0u) { if (xb_ld(&bar[XB_TMO])) break; if (sp > XB_SPIN_CAP) { atomicAdd(&bar[XB_TMO], 1u); break; } }
    }
    nloc = mine > 0u ? mine : 1u; nx = cnt > 0u ? cnt : 1u;
}

__device__ __forceinline__ void xcd_barrier(const XcdBarrier& b) {
    asm volatile("s_waitcnt vmcnt(0)" ::: "memory");
    __syncthreads();
    if (threadIdx.x == 0) {
        unsigned* bar = b.bar;
        __builtin_amdgcn_s_waitcnt(0);
        unsigned nloc = b.st[0], nx = b.st[1];
        if (nloc == 0u) { xcd_barrier_complete(bar, b.x, nloc, nx); b.st[0] = nloc; b.st[1] = nx; }
        const unsigned old = xb_add(&bar[XB_XSUB(b.x)], 1u);
        const unsigned gen = old / nloc;
        if (old + 1u == (gen + 1u) * nloc) {
            __builtin_amdgcn_fence(__ATOMIC_RELEASE, "agent");
            asm volatile("s_waitcnt vmcnt(0)" ::: "memory");
            const unsigned og = xb_add(&bar[XB_TOP], 1u);
            const unsigned tg = og / nx;
            if (og + 1u == (tg + 1u) * nx) xb_add(&bar[XB_TOPGEN], 1u);
            else XB_SPIN(xb_ld(&bar[XB_TOPGEN]) == tg, bar);
            __builtin_amdgcn_fence(__ATOMIC_ACQUIRE, "agent");
            xb_add(&bar[XB_XGEN(b.x)], 1u);
            asm volatile("s_waitcnt vmcnt(0)" ::: "memory");
        } else {
            XB_SPIN(xb_ld(&bar[XB_XGEN(b.x)]) == gen, bar);
            __builtin_amdgcn_fence(__ATOMIC_ACQUIRE, "agent");
            asm volatile("s_waitcnt vmcnt(0)" ::: "memory");
        }
    }
    __syncthreads();
}

struct Frame {
    LAS unsigned char* lds;
    volatile LAS unsigned* MISC;
    gu32* ctl;
    int tid, lane, wave, vcu, G;
    unsigned char* ws;
};

__device__ __forceinline__ int dmap64(int s) { if (s >= 32) return s; const int nn = s >> 4, fq = (s >> 2) & 3, j = s & 3; return fq < 2 ? 8 * nn + 4 * fq + j : 16 + 8 * nn + 4 * (fq - 2) + j; }
__device__ __forceinline__ int src_col(int kind, int n) {
    if (kind == 0) return n;
    const int pn = n >> 8, p = n & 255;
    if (kind == 1) {
        if (pn < 12) return n;
        if (pn < 16) return 3072 + (pn - 12) * 256 + (p >> 6) * 64 + dmap64(p & 63);
        if (p < 64) return 4096 + dmap64(p);
        if (p < 80) return 4160 + (p - 64);
        return -1;
    }
    if (pn < 8) return n;
    const int i = pn - 8; return p < 128 ? 2048 + 128 * i + p : 4096 + 128 * i + (p - 128);
}
struct P0Desc { const float* src; const float* g; bf16* dst; int Nsrc, K, fp8, hasg; };
__device__ __forceinline__ void p0_desc(const float* W, const float* g, int K, int Nsrc, int Npad, int kind, bf16* WT, int item, int lane, P0Desc& d, int fp8 = 0) {
    const int nblk = Npad / 32, kb = item / nblk, nb = item % nblk, kg = lane >> 3, ng = lane & 7, k0 = 64 * kb + 8 * kg, n0 = 32 * nb + 4 * ng;
    const int col = src_col(kind, n0);
    d.src = col >= 0 ? W + (size_t)k0 * Nsrc + col : nullptr; d.g = g ? g + k0 : nullptr; d.dst = fp8 ? (bf16*)((unsigned char*)WT + (size_t)n0 * K + k0) : WT + (size_t)n0 * K + k0; d.Nsrc = Nsrc; d.K = K; d.fp8 = fp8; d.hasg = g != nullptr;
}
__device__ __forceinline__ void p0_load(const P0Desc& d, f32x4 (&v)[8], f32x4& ga, f32x4& gb) {
#pragma unroll
    for (int i = 0; i < 8; ++i) v[i] = d.src ? P0_LOAD((const f32x4*)(d.src + (size_t)i * d.Nsrc)) : (f32x4){0.f, 0.f, 0.f, 0.f};
    if (d.g) { ga = *(const f32x4*)d.g; gb = *(const f32x4*)(d.g + 4); } else { ga = (f32x4){1.f, 1.f, 1.f, 1.f}; gb = ga; }
}
#ifndef P0_HWPK
#define P0_HWPK 1
#endif
#if P0_HWPK
#define P0_PK(a, b) pg8::cvt_pk_bf16(a, b)
#else
#define P0_PK(a, b) pk2(a, b)
#endif
__device__ __forceinline__ void p0_load_nn(const P0Desc& d, f32x4 (&v)[8], f32x4& ga, f32x4& gb) {
    const GAS float* sp = (const GAS float*)d.src;
#pragma unroll
    for (int i = 0; i < 8; ++i) v[i] = P0_LOAD((const GAS f32x4*)(sp + (size_t)i * d.Nsrc));
    if (d.hasg) { const GAS float* gp = (const GAS float*)d.g; ga = *(const GAS f32x4*)gp; gb = *(const GAS f32x4*)(gp + 4); } else { ga = (f32x4){1.f, 1.f, 1.f, 1.f}; gb = ga; }
}
template <bool NT = false> __device__ __forceinline__ void p0_store(const P0Desc& d, const f32x4 (&v)[8], const f32x4& ga, const f32x4& gb) {
    if (d.fp8) {
        const float s = d.fp8 == 2 ? pg8::FP8_SWC : pg8::FP8_SW; float gs[8];
#pragma unroll
        for (int i = 0; i < 8; ++i) gs[i] = (i < 4 ? ga[i & 3] : gb[i & 3]) * s;
#pragma unroll
        for (int q = 0; q < 4; ++q) { int w0 = 0, w1 = 0;
            float e[8];
#pragma unroll
            for (int i = 0; i < 8; ++i) e[i] = __builtin_amdgcn_fmed3f(v[i][q] * gs[i], -448.f, 448.f);
            w0 = __builtin_amdgcn_cvt_pk_fp8_f32(e[0], e[1], w0, false); w0 = __builtin_amdgcn_cvt_pk_fp8_f32(e[2], e[3], w0, true);
            w1 = __builtin_amdgcn_cvt_pk_fp8_f32(e[4], e[5], w1, false); w1 = __builtin_amdgcn_cvt_pk_fp8_f32(e[6], e[7], w1, true);
            v2u o; o.x = (unsigned)w0; o.y = (unsigned)w1; if (NT) __builtin_nontemporal_store(o, (GAS v2u*)((unsigned char*)d.dst + (size_t)q * d.K)); else *(GAS v2u*)((unsigned char*)d.dst + (size_t)q * d.K) = o; }
        return; }
    if (!d.hasg) {
#pragma unroll
        for (int q = 0; q < 4; ++q) { v4u o; o.x = P0_PK(v[0][q], v[1][q]); o.y = P0_PK(v[2][q], v[3][q]); o.z = P0_PK(v[4][q], v[5][q]); o.w = P0_PK(v[6][q], v[7][q]);
            if (NT) __builtin_nontemporal_store(o, (GAS v4u*)(d.dst + (size_t)q * d.K)); else *(GAS v4u*)(d.dst + (size_t)q * d.K) = o; }
        return; }
#pragma unroll
    for (int q = 0; q < 4; ++q) { v4u o; o.x = P0_PK(v[0][q] * ga[0], v[1][q] * ga[1]); o.y = P0_PK(v[2][q] * ga[2], v[3][q] * ga[3]); o.z = P0_PK(v[4][q] * gb[0], v[5][q] * gb[1]); o.w = P0_PK(v[6][q] * gb[2], v[7][q] * gb[3]);
        if (NT) __builtin_nontemporal_store(o, (GAS v4u*)(d.dst + (size_t)q * d.K)); else *(GAS v4u*)(d.dst + (size_t)q * d.K) = o; }
}
struct Inputs { const float* x; const int* pos; const float *attn_norm_g, *attn_w_in, *attn_q_g, *attn_k_g, *attn_w_out, *conv_norm_g, *conv_w_in, *conv_w, *conv_w_out, *mlp_norm_g, *mlp_w1, *mlp_w2; };
constexpr int I_A1 = (DM / 64) * (NA1 / 32), I_SQ = (DM / 64) * (DM / 32), I_C1 = (DM / 64) * (NC1 / 32), I_M1 = (DM / 64) * (DFF / 32), I_M2 = (DFF / 64) * (DM / 32);
constexpr int PER_J = I_A1 + I_SQ + I_C1 + I_SQ, PER_I = I_M1 + I_M2, NITEMS = 2 * PER_J + 4 * PER_I;
__device__ __forceinline__ void p0_item_desc(Frame& F, const Inputs& I, int it, P0Desc& d, int lane_ = -1) {
    int r = it; const int ln_ = lane_ >= 0 ? lane_ : F.lane;
    if (r < 2 * PER_J) { const int j = r / PER_J; r -= j * PER_J;
        if (r < I_A1) { p0_desc(I.attn_w_in + (size_t)j * DM * NA1_SRC, I.attn_norm_g + j * DM, DM, NA1_SRC, NA1, 1, (bf16*)(F.ws + WS_WA1 + j * SZ_WA1), r, ln_, d); return; } r -= I_A1;
        if (r < I_SQ) { p0_desc(I.attn_w_out + (size_t)j * DM * DM, nullptr, DM, DM, DM, 0, (bf16*)(F.ws + WS_WA4 + j * SZ_WSQ), r, ln_, d); return; } r -= I_SQ;
        if (r < I_C1) { p0_desc(I.conv_w_in + (size_t)j * DM * NC1, I.conv_norm_g + j * DM, DM, NC1, NC1, 2, (bf16*)(F.ws + WS_WC1 + j * SZ_WC1), r, ln_, d, ((C1_FP8 >> (2 * j + 1)) & 1) ? 2 : 0); return; } r -= I_C1;
        p0_desc(I.conv_w_out + (size_t)j * DM * DM, nullptr, DM, DM, DM, 0, (bf16*)(F.ws + WS_WC2 + j * SZ_WSQ), r, ln_, d, ((C2_FP8 >> (2 * j + 1)) & 1) ? 2 : 0); return; }
    r -= 2 * PER_J; const int i = r / PER_I; r -= i * PER_I;
    if (r < I_M1) { p0_desc(I.mlp_w1 + (size_t)i * DM * DFF, I.mlp_norm_g + i * DM, DM, DFF, DFF, 0, (bf16*)(F.ws + WS_WM1 + i * SZ_WM), r, ln_, d, ((M1_FP8 >> i) & 1) ? 2 : 0); return; } r -= I_M1;
    p0_desc(I.mlp_w2 + (size_t)i * DFF * DM, nullptr, DFF, DM, DM, 0, (bf16*)(F.ws + WS_WM2 + i * SZ_WM), r, ln_, d, (MLP_FP8 >> i) & 1);
}
struct ItemRanges { int lo[4], hi[4]; };
__device__ __forceinline__ int range_item(const ItemRanges& R, int c) {
#pragma unroll
    for (int k = 0; k < 4; ++k) { const int len = R.hi[k] - R.lo[k]; if (c < len) return R.lo[k] + c; c -= len; }
    return -1;
}
__device__ __forceinline__ void convert_ranges(Frame& F, const Inputs& I, const ItemRanges& R, int gw, int nw) {
    const int total = (R.hi[0] - R.lo[0]) + (R.hi[1] - R.lo[1]) + (R.hi[2] - R.lo[2]) + (R.hi[3] - R.lo[3]);
    f32x4 va[8], vb[8], gaa, gab, gba, gbb; P0Desc da, db;
    int c = gw; bool ha = c < total;
    if (ha) { p0_item_desc(F, I, range_item(R, c), da); p0_load(da, va, gaa, gab); }
    while (ha) {
        const int cn = c + nw; const bool hb = cn < total;
        if (hb) { p0_item_desc(F, I, range_item(R, cn), db); p0_load(db, vb, gba, gbb); }
        p0_store(da, va, gaa, gab);
        c = cn; ha = hb; da = db; gaa = gba; gab = gbb;
#pragma unroll
        for (int i = 0; i < 8; ++i) va[i] = vb[i];
    }
}
#ifndef DEFER_CONV
#define DEFER_CONV 2
#endif
#ifndef IDX_PF2
#define IDX_PF2 1
#endif
#ifndef A2_NT_STORE
#define A2_NT_STORE 0
#endif
#ifndef A2_STORE_MID
#define A2_STORE_MID 0
#endif
#ifndef A2_NOASSERT
#define A2_NOASSERT 0
#endif
#ifndef A2_NCV
#define A2_NCV 2
#endif
#ifndef A2_SPLIT
#define A2_SPLIT 4096
#endif
__device__ __forceinline__ const float* in_ptr(const unsigned char* ws, const int field) {
    unsigned long long p_; asm volatile("s_load_dwordx2 %0, %1, %2\n\ts_waitcnt lgkmcnt(0)" : "=s"(p_) : "s"(ws + WS_INPTR), "n"(field * 8) : "memory"); return (const float*)p_; }
__device__ __forceinline__ void a2_item_desc(Frame& F, int j, int c, int lane, P0Desc& d) {
    if (c < I_SQ) { p0_desc(in_ptr(F.ws, 6) + (size_t)j * DM * DM, nullptr, DM, DM, DM, 0, (bf16*)(F.ws + WS_WA4 + j * SZ_WSQ), c, lane, d); return; }
    c -= I_SQ; int i = 2 * j;
    if (c >= PER_I) { c += A2_SPLIT - PER_I; i += 1; }
    if (c < I_M1) { p0_desc(in_ptr(F.ws, 12) + (size_t)i * DM * DFF, in_ptr(F.ws, 11) + i * DM, DM, DFF, DFF, 0, (bf16*)(F.ws + WS_WM1 + (size_t)i * SZ_WM), c, lane, d, ((M1_FP8 >> i) & 1) ? 2 : 0); return; }
    c -= I_M1;
    p0_desc(in_ptr(F.ws, 13) + (size_t)i * DFF * DM, nullptr, DFF, DM, DM, 0, (bf16*)(F.ws + WS_WM2 + (size_t)i * SZ_WM), c, lane, d, (MLP_FP8 >> i) & 1);
}
__device__ __forceinline__ ItemRanges ranges_a2(int j) {
    return ItemRanges{{j * PER_J + I_A1, 2 * PER_J + 2 * j * PER_I, 2 * PER_J + (2 * j + 1) * PER_I + A2_SPLIT, 0}, {j * PER_J + I_A1 + I_SQ, 2 * PER_J + (2 * j + 1) * PER_I, 2 * PER_J + (2 * j + 2) * PER_I, 0}}; }
constexpr int A2_ITEMS = I_SQ + PER_I + (PER_I - A2_SPLIT);
__device__ __forceinline__ ItemRanges ranges_p0() { if (DEFER_CONV == 2) return ItemRanges{{0, PER_J, 0, 0}, {I_A1, PER_J + I_A1, 0, 0}};
    if (DEFER_CONV) return ItemRanges{{0, PER_J, 2 * PER_J, 2 * PER_J + 2 * PER_I}, {I_A1 + I_SQ, PER_J + I_A1 + I_SQ, 2 * PER_J + PER_I, 2 * PER_J + 3 * PER_I}}; return ItemRanges{{0, 0, 0, 0}, {NITEMS, 0, 0, 0}}; }
__device__ __forceinline__ ItemRanges ranges_deferred(int j) {
    if (DEFER_CONV == 2) return ItemRanges{{j * PER_J + I_A1 + I_SQ, 2 * PER_J + (2 * j + 1) * PER_I, 0, 0}, {(j + 1) * PER_J, 2 * PER_J + (2 * j + 1) * PER_I + A2_SPLIT, 0, 0}};
    return ItemRanges{{j * PER_J + I_A1 + I_SQ, 2 * PER_J + (2 * j + 1) * PER_I, 0, 0}, {(j + 1) * PER_J, 2 * PER_J + (2 * j + 2) * PER_I, 0, 0}}; }
__device__ __forceinline__ void p0_prologue(Frame& F, const Inputs& I, float* out) {
    const int gw = F.vcu * NWAVES + F.wave, NGW = F.G * NWAVES;
    if (blockIdx.x == 0 && F.tid == 0) {
        Inputs* d_ = (Inputs*)(F.ws + WS_INPTR);
        d_->x = I.x; d_->pos = I.pos; d_->attn_norm_g = I.attn_norm_g; d_->attn_w_in = I.attn_w_in; d_->attn_q_g = I.attn_q_g; d_->attn_k_g = I.attn_k_g; d_->attn_w_out = I.attn_w_out;
        d_->conv_norm_g = I.conv_norm_g; d_->conv_w_in = I.conv_w_in; d_->conv_w = I.conv_w; d_->conv_w_out = I.conv_w_out; d_->mlp_norm_g = I.mlp_norm_g; d_->mlp_w1 = I.mlp_w1; d_->mlp_w2 = I.mlp_w2; }
    P0T_BEGIN(2);
    bf16* xb = (bf16*)(F.ws + WS_XB); pg8::ssq_t* ssq0 = (pg8::ssq_t*)(F.ws + WS_SSQ);
    {
        f32x4 va[8], vb[8]; int m = gw; bool ha = m < M;
        if (ha) { const GAS f32x4* xr = (const GAS f32x4*)(I.x + (size_t)m * DM) + F.lane;
#pragma unroll
            for (int j = 0; j < 8; ++j) va[j] = __builtin_nontemporal_load(xr + 64 * j); }
        while (ha) {
            const int mn = m + NGW; const bool hb = mn < M;
            if (hb) { const GAS f32x4* xr = (const GAS f32x4*)(I.x + (size_t)mn * DM) + F.lane;
#pragma unroll
                for (int j = 0; j < 8; ++j) vb[j] = __builtin_nontemporal_load(xr + 64 * j); }
            GAS unsigned long long* o8 = (GAS unsigned long long*)(xb + (size_t)m * DM) + F.lane; float s = 0.f;
#pragma unroll
            for (int j = 0; j < 8; ++j) { const f32x4 v = va[j]; s += (v.x * v.x + v.y * v.y) + (v.z * v.z + v.w * v.w);
                o8[64 * j] = (unsigned long long)pk2(v.x, v.y) | ((unsigned long long)pk2(v.z, v.w) << 32); }
            s = wave_sum(s); if (F.lane == 0) ssq0[m] = pg8::ssq_fix(s);
            m = mn; ha = hb;
#pragma unroll
            for (int j = 0; j < 8; ++j) va[j] = vb[j];
        }
    }
    P0T_END(2); P0T_BEGIN(3);
    unsigned* ropeM = (unsigned*)(F.ws + WS_ROPEM); unsigned* ropeI = (unsigned*)(F.ws + WS_ROPEI);
    for (int e = F.vcu * 512 + F.tid; e < M * 24; e += F.G * 512) {
        const int row = e / 24, d = e % 24; const float p = (float)I.pos[row];
        const float ex = d < 16 ? -(float)d * (1.0f / 16.0f) : -(float)(d - 16) * (1.0f / 8.0f);
        const float inv = __builtin_amdgcn_exp2f(ex * 18.931568569324174f);
        const float ang = p * inv;
        double rev = (double)ang * 0.15915494309189535; rev -= __builtin_floor(rev); const float rf = (float)rev;
        const float c = __builtin_amdgcn_cosf(rf), s = __builtin_amdgcn_sinf(rf);
        const unsigned pk = (unsigned)__builtin_bit_cast(unsigned short, (_Float16)c) | ((unsigned)__builtin_bit_cast(unsigned short, (_Float16)s) << 16);
        if (d < 16) ropeM[(size_t)row * 16 + d] = pk; else ropeI[(size_t)row * 8 + (d - 16)] = pk;
    }
    { float* qg = (float*)(F.ws + WS_QG); float* kg = (float*)(F.ws + WS_KG); float* cw = (float*)(F.ws + WS_CONVW);
      for (int e = F.vcu * 512 + F.tid; e < 2 * 3 * DM; e += F.G * 512) { cw[e] = I.conv_w[e]; if (e < 256) { qg[e] = I.attn_q_g[e]; kg[e] = I.attn_k_g[e]; } } }
    P0T_END(3); P0T_BEGIN(1);
    convert_ranges(F, I, ranges_p0(), gw, NGW);
    P0T_END(1);
    (void)out;
}

__device__ __forceinline__ float relu_i(float x) { const int i = __float_as_int(x); return __int_as_float(i > 0 ? i : 0); }
struct IdxTensors { const bf16* QI; const bf16* KI; const float* WI; unsigned long long* MASK; float* dbg; };
#define DBG_OUT T.dbg
__device__ __forceinline__ void idx_phase(Frame& F, const IdxTensors& T, const int cj) {
    static_assert(DEFER_CONV != 2 || A2_NOASSERT || A2_ITEMS <= A2_NCV * 2048 * NWAVES, "the indexer's conversion slots do not cover its items");
    typedef float f32x2 __attribute__((ext_vector_type(2)));
    LAS float* scores = (LAS float*)(F.lds + RING_OFF);
    LAS unsigned* hist = (LAS unsigned*)(F.lds + AUX_OFF) + F.wave * 512;
    LAS float* cand = (LAS float*)(F.lds + AUX_OFF + 16384) + F.wave * 64;
    LAS float* mm = (LAS float*)(F.lds + AUX_OFF + 16384 + 2048);
    int tid_ = threadIdx.x; asm volatile("" : "+v"(tid_));
    const int lane = tid_ & 63, w = F.wave, c32 = lane & 31, hi = lane >> 5;
    const float INF = __builtin_inff();
    const int qsel = (c32 >> 2) & 1, hh = (c32 & 3) + 4 * (c32 >> 3);
    bf16x8 afr[4][4]; bf16x8 bcur[4];
#define IDX_DECODE(uu_, b_, t0_) const int idx_ = (uu_) & 255, rr_ = (uu_) >> 8; b_ = rr_ >> 1; t0_ = ((rr_ & 1) ? 511 - idx_ : idx_) * 8
    const int qrow_w = 16 * w + (lane >> 2), qch = 2 * (lane & 3);
    LAS unsigned char* const qlds = F.lds + AUX_OFF;
#define QI_FETCH(b_, t0_) do { const bf16* qp_ = T.QI + ((size_t)((b_) * SEQ + (t0_) + w) * 1024 + lane * 16); qpre0 = *(const bf16x8*)qp_; qpre1 = *(const bf16x8*)(qp_ + 8); } while (0)
#define QI_PARK() do { *(LAS bf16x8*)(qlds + qrow_w * 128 + (((qch) ^ (qrow_w & 7)) << 4)) = qpre0; *(LAS bf16x8*)(qlds + qrow_w * 128 + (((qch + 1) ^ (qrow_w & 7)) << 4)) = qpre1; } while (0)
#define QI_READ() do { _Pragma("unroll") for (int p = 0; p < 4; ++p) _Pragma("unroll") for (int kk = 0; kk < 4; ++kk) { const int r_ = (qsel + 2 * p) * 16 + hh; \
            afr[p][kk] = *(const LAS bf16x8*)(qlds + r_ * 128 + (((hi + 2 * kk) ^ (r_ & 7)) << 4)); } } while (0)
#define IDX_LOAD(b_, t0_) do { \
        const int nt_ = ((t0_) + 7) / 32 + 1; const int j0_ = w < nt_ ? w : 0; \
        const bf16* kb_ = T.KI + (size_t)(b_) * SEQ * 64 + (size_t)c32 * 64 + 8 * hi + (size_t)j0_ * 32 * 64; \
        _Pragma("unroll") for (int kk = 0; kk < 4; ++kk) bcur[kk] = *(const bf16x8*)(kb_ + 16 * kk); } while (0)
    int uu = blockIdx.x; int b = 0, t0 = 0;
    if (uu < 2048) { IDX_DECODE(uu, b, t0); if (tid_ < 128) ((LAS float*)(F.lds + WQ_OFF))[tid_] = T.WI[(size_t)(b * SEQ + t0) * 16 + tid_]; bf16x8 qpre0, qpre1; QI_FETCH(b, t0); IDX_LOAD(b, t0); QI_PARK(); }
    LDS_WAIT(); __syncthreads();
    for (; uu < 2048; uu += F.G) {
        { IDXT_BEGIN(1);
        for (int srep = 0; srep < 1 + DBG_IDX_REP_SCORE; ++srep) {
            QI_READ();
            const LAS float* wrow_ = (const LAS float*)(F.lds + WQ_OFF) + hi * 16; (void)wrow_;
#if !IDX_PF2
            f32x2 wq[4][8];
            { const LAS float* wrow = (const LAS float*)(F.lds + WQ_OFF) + hi * 16;
#pragma unroll
              for (int p = 0; p < 4; ++p)
#pragma unroll
                  for (int i = 0; i < 4; ++i) { const f32x4 t4 = *(const LAS f32x4*)(wrow + p * 32 + 4 * i); wq[p][2 * i] = (f32x2){t4[0], t4[1]}; wq[p][2 * i + 1] = (f32x2){t4[2], t4[3]}; } }
#endif
            const int ntile = (t0 + 7) / 32 + 1;
            const bf16* kbase = T.KI + (size_t)b * SEQ * 64 + (size_t)c32 * 64 + 8 * hi;
            LAS float* srow = scores + hi * 4096 + c32;
            float vmax[4], vmin[4];
#pragma unroll
            for (int p = 0; p < 4; ++p) { vmax[p] = -INF; vmin[p] = INF; }
            bf16x8 bnxt[4];
#if IDX_PF2
            bf16x8 bnn[4];
            { const int j1 = w + 8 < ntile ? w + 8 : (w < ntile ? w : 0);
#pragma unroll
              for (int kk = 0; kk < 4; ++kk) bnxt[kk] = *(const bf16x8*)(kbase + (size_t)j1 * 32 * 64 + 16 * kk); }
#endif
            for (int jt = w; jt < ntile; jt += 8) {
#if IDX_PF2
                const int jn = jt + 16 < ntile ? jt + 16 : jt;
#pragma unroll
                for (int kk = 0; kk < 4; ++kk) bnn[kk] = *(const bf16x8*)(kbase + (size_t)jn * 32 * 64 + 16 * kk);
                unsigned wb_ = (unsigned)(uintptr_t)wrow_; asm volatile("" : "+v"(wb_));
                const LAS float* wrow_t = (const LAS float*)(uintptr_t)wb_;
#else
                const int jn = jt + 8 < ntile ? jt + 8 : jt;
#pragma unroll
                for (int kk = 0; kk < 4; ++kk) bnxt[kk] = *(const bf16x8*)(kbase + (size_t)jn * 32 * 64 + 16 * kk);
#endif
                const int krel = jt * 32 + c32 - t0 - hi;
#pragma unroll
                for (int ph = 0; ph < 2; ++ph) {
                    f32x16 acc0 = {}, acc1 = {};
#pragma unroll
                    for (int kk = 0; kk < 4; ++kk) { acc0 = __builtin_amdgcn_mfma_f32_32x32x16_bf16(afr[2 * ph][kk], bcur[kk], acc0, 0, 0, 0);
                                                     acc1 = __builtin_amdgcn_mfma_f32_32x32x16_bf16(afr[2 * ph + 1][kk], bcur[kk], acc1, 0, 0, 0); }
#pragma unroll
                    for (int q = 0; q < 2; ++q) { const int p = 2 * ph + q; const f32x16& acc = q ? acc1 : acc0;
                        f32x2 s2 = {0.f, 0.f};
#if IDX_PF2
                        f32x2 wl[8];
#pragma unroll
                        for (int i = 0; i < 4; ++i) { const f32x4 t4 = *(const LAS f32x4*)(wrow_t + p * 32 + 4 * i); wl[2 * i] = (f32x2){t4[0], t4[1]}; wl[2 * i + 1] = (f32x2){t4[2], t4[3]}; }
#pragma unroll
                        for (int r = 0; r < 8; ++r) { f32x2 a2 = {relu_i(acc[2 * r]), relu_i(acc[2 * r + 1])}; s2 = __builtin_elementwise_fma(wl[r], a2, s2); }
#else
#pragma unroll
                        for (int r = 0; r < 8; ++r) { f32x2 a2 = {relu_i(acc[2 * r]), relu_i(acc[2 * r + 1])}; s2 = __builtin_elementwise_fma(wq[p][r], a2, s2); }
#endif
                        const bool valid = krel <= 2 * p;
                        const float s = valid ? s2[0] + s2[1] : -INF;
                        vmax[p] = fmaxf(vmax[p], s); vmin[p] = fminf(vmin[p], valid ? s : INF);
                        srow[p * 2 * 4096 + jt * 32] = s; }
                }
#pragma unroll
                for (int kk = 0; kk < 4; ++kk) bcur[kk] = bnxt[kk];
#if IDX_PF2
#pragma unroll
                for (int kk = 0; kk < 4; ++kk) bnxt[kk] = bnn[kk];
#endif
            }
#pragma unroll
            for (int o = 1; o < 32; o <<= 1)
#pragma unroll
                for (int p = 0; p < 4; ++p) { vmax[p] = fmaxf(vmax[p], __shfl_xor(vmax[p], o)); vmin[p] = fminf(vmin[p], __shfl_xor(vmin[p], o)); }
            if (c32 == 0) {
#pragma unroll
                for (int p = 0; p < 4; ++p) { mm[(w * 8 + 2 * p + hi) * 2] = vmin[p]; mm[(w * 8 + 2 * p + hi) * 2 + 1] = vmax[p]; } }
        }
        IDXT_END(1); }
        const int b_cur = b, t0_cur = t0;
        float wpre = 0.f; const bool has_next = uu + F.G < 2048; bf16x8 qpre0 = {}, qpre1 = {};
        if (has_next) { IDX_DECODE(uu + F.G, b, t0); if (tid_ < 128) wpre = T.WI[(size_t)(b * SEQ + t0) * 16 + tid_]; QI_FETCH(b, t0); IDX_LOAD(b, t0); }
        IDXT_BEGIN(5);
        P0Desc cd[A2_NCV] = {}; f32x4 cv[A2_NCV][8] = {}, cga[A2_NCV] = {}, cgb[A2_NCV] = {}; bool ch[A2_NCV];
#pragma unroll
        for (int k = 0; k < A2_NCV; ++k) { const int c = uu * NWAVES + w + k * 2048 * NWAVES; ch[k] = DEFER_CONV == 2 && c < A2_ITEMS;
            if (ch[k]) { int ln = lane; asm volatile("" : "+v"(ln)); a2_item_desc(F, cj, c, ln, cd[k]); p0_load_nn(cd[k], cv[k], cga[k], cgb[k]); } }
        IDXT_END(5);
        { IDXT_BEGIN(3); LDS_WAIT(); __builtin_amdgcn_s_barrier(); asm volatile("" ::: "memory"); IDXT_END(3); }
        bool cdone = false;
#define CONV_STORE() do { if (!cdone) { _Pragma("unroll") for (int k_ = 0; k_ < A2_NCV; ++k_) if (ch[k_]) p0_store<A2_NT_STORE != 0>(cd[k_], cv[k_], cga[k_], cgb[k_]); cdone = true; } } while (0)
        { IDXT_BEGIN(2);
        for (int lrep = 0; lrep < 1 + DBG_IDX_REP_SEL; ++lrep) {
            const int t = t0_cur + w, n = t + 1;
            const LAS float* sc = scores + w * 4096;
            const int nch = (n + 63) >> 6;
            unsigned long long myword = 0ull;
            if (n <= TOPK) {
#pragma unroll 4
                for (int j = 0; j < nch; ++j) { const int i = 64 * j + lane; const unsigned long long mk = __ballot(i < n); if (lane == j) myword = mk; }
            } else {
                float lo = INF, hv = -INF;
#pragma unroll
                for (int k = 0; k < 8; ++k) { lo = fminf(lo, mm[(k * 8 + w) * 2]); hv = fmaxf(hv, mm[(k * 8 + w) * 2 + 1]); }
                int need = TOPK; bool done = false;
                for (int level = 0; level < 6 && !done; ++level) {
                    if (!(hv > lo)) break;
                    const float scale = fminf(511.9f / (hv - lo), 3.0e37f), off = -lo * scale;
#pragma unroll
                    for (int k = 0; k < 8; ++k) hist[k * 64 + lane] = 0u;
                    LDS_WAIT();
                    for (int j0 = 0; j0 < nch; j0 += 8) {
                        float vb[8];
#pragma unroll
                        for (int k = 0; k < 8; ++k) vb[k] = sc[64 * ((j0 + k) & 63) + lane];
#pragma unroll
                        for (int k = 0; k < 8; ++k) { const int i = 64 * (j0 + k) + lane; const float v = vb[k];
                            if (i < n && v >= lo && v <= hv) { int bin = (int)fmaf(v, scale, off); bin = bin > 511 ? 511 : bin; __hip_atomic_fetch_add(hist + bin, 1u, __ATOMIC_RELAXED, __HIP_MEMORY_SCOPE_WORKGROUP); } } }
                    if (A2_STORE_MID) CONV_STORE();
                    LDS_WAIT();
                    unsigned h[8]; unsigned ssum = 0;
                    { const v4u a = *(const LAS v4u*)(hist + 8 * lane), bq = *(const LAS v4u*)(hist + 8 * lane + 4); h[0] = a.x; h[1] = a.y; h[2] = a.z; h[3] = a.w; h[4] = bq.x; h[5] = bq.y; h[6] = bq.z; h[7] = bq.w; }
#pragma unroll
                    for (int k = 0; k < 8; ++k) ssum += h[k];
                    unsigned S = ssum;
#pragma unroll
                    for (int o = 1; o < 64; o <<= 1) { const unsigned tt = __shfl_down(S, o); if (lane + o < 64) S += tt; }
                    const unsigned long long bal = __ballot(S >= (unsigned)need);
                    const int L = __popcll(bal) - 1;
                    const int Lc = L < 0 ? 0 : L;
                    unsigned cum = (Lc < 63) ? (unsigned)__shfl(S, Lc + 1) : 0u; if (Lc >= 63) cum = 0u;
                    int bstar = 8 * Lc; unsigned cstar = 0, abv = cum; bool found = false;
#pragma unroll
                    for (int k = 7; k >= 0; --k) { const unsigned hk = (unsigned)__shfl(h[k], Lc);
                        if (!found && cum + hk >= (unsigned)need) { bstar = 8 * Lc + k; cstar = hk; abv = cum; found = true; }
                        cum += hk; }
                    need -= (int)abv;
                    float nlo = INF, nhv = -INF; int base = 0; const bool few = cstar <= 64u;
                    for (int j0 = 0; j0 < nch; j0 += 8) {
                        float vb[8];
#pragma unroll
                        for (int k = 0; k < 8; ++k) vb[k] = sc[64 * ((j0 + k) & 63) + lane];
#pragma unroll
                        for (int k = 0; k < 8; ++k) { const int j = j0 + k, i = 64 * j + lane; const float v = vb[k]; const bool valid = i < n;
                            int bin = (int)fmaf(v, scale, off); bin = bin > 511 ? 511 : bin;
                            const bool member = valid && v >= lo && v <= hv, inb = member && bin == bstar, sure = valid && (v > hv || (member && bin > bstar));
                            const unsigned long long ms = __ballot(sure); if (lane == j) myword = ms;
                            if (inb) { nlo = fminf(nlo, v); nhv = fmaxf(nhv, v); }
                            if (few) { const unsigned long long mk = __ballot(inb);
                                if (inb) { const int pos = base + __popcll(mk & ((1ull << lane) - 1ull)); if (pos < 64) { cand[pos] = v; ((LAS int*)hist)[pos] = i; } }
                                base += __popcll(mk); } } }
                    if (few) {
                        LDS_WAIT();
                        const int nc = base < 64 ? base : 64;
                        const float myv = lane < nc ? cand[lane] : -INF; const int myi = lane < nc ? ((const LAS int*)hist)[lane] : 0; int cnt = 0;
                        for (int i = 0; i < nc; ++i) cnt += (__shfl(myv, i) > myv) ? 1 : 0;
                        unsigned long long msel = __ballot(lane < nc && cnt < need);
                        while (msel) { const int src = __builtin_ctzll(msel); msel &= msel - 1ull; const int ki = __shfl(myi, src);
                            if (lane == (ki >> 6)) myword |= 1ull << (ki & 63); }
                        done = true;
                    } else { lo = wave_min(nlo); hv = wave_max(nhv); }
                }
                if (!done) {
#pragma unroll 4
                    for (int j = 0; j < nch; ++j) { const int i = 64 * j + lane; const float v = sc[i]; const unsigned long long mk = __ballot(i < n && v >= lo); if (lane == j) myword = mk; }
                }
            }
            const int nwords = ((t | 255) + 1) >> 6;
            if (lane < nwords) T.MASK[((size_t)b_cur * 64 + lane) * SEQ + t] = myword;
        }
        IDXT_END(2); }
        { IDXT_BEGIN(6); CONV_STORE(); IDXT_END(6); }
#undef CONV_STORE
        if (has_next && tid_ < 128) ((LAS float*)(F.lds + WQ_OFF))[tid_] = wpre;
        if (has_next) QI_PARK();
        { IDXT_BEGIN(4); LDS_WAIT(); __builtin_amdgcn_s_barrier(); asm volatile("" ::: "memory"); IDXT_END(4); }
    }
#undef IDX_DECODE
#undef IDX_LOAD
#undef QI_FETCH
#undef QI_PARK
#undef QI_READ
}

template <bool FP8OUT> __device__ __forceinline__ void conv_phase(Frame& F, const bf16* Bg, const bf16* Z, const float* cw, bf16* Gout) {
    const int nunit = (M / 32) * 4;
    for (int uu = (blockIdx.x * NWAVES + F.wave); uu < nunit; uu += F.G * NWAVES) {
        const int run = uu >> 2, cb = (uu & 3) * 512 + F.lane * 8, r0 = run * 32;
        float w0[8], w1[8], w2[8];
#pragma unroll
        for (int j = 0; j < 8; ++j) { w0[j] = cw[cb + j]; w1[j] = cw[DM + cb + j]; w2[j] = cw[2 * DM + cb + j]; }
        float zm2[8], zm1[8];
        const bool first = (r0 % SEQ) == 0;
        { v4u a = {0, 0, 0, 0}, bq = {0, 0, 0, 0};
          if (!first) { a = *(const v4u*)(Z + (size_t)(r0 - 2) * DM + cb); bq = *(const v4u*)(Z + (size_t)(r0 - 1) * DM + cb); }
          const unsigned aw[4] = {a.x, a.y, a.z, a.w}, bw[4] = {bq.x, bq.y, bq.z, bq.w};
#pragma unroll
          for (int j = 0; j < 4; ++j) { zm2[2 * j] = __uint_as_float(aw[j] << 16); zm2[2 * j + 1] = __uint_as_float(aw[j] & 0xffff0000u); zm1[2 * j] = __uint_as_float(bw[j] << 16); zm1[2 * j + 1] = __uint_as_float(bw[j] & 0xffff0000u); } }
#pragma unroll 4
        for (int r = 0; r < 32; ++r) {
            const v4u zz = *(const v4u*)(Z + (size_t)(r0 + r) * DM + cb), bb = *(const v4u*)(Bg + (size_t)(r0 + r) * DM + cb);
            const unsigned zw[4] = {zz.x, zz.y, zz.z, zz.w}, bw[4] = {bb.x, bb.y, bb.z, bb.w};
            float z0[8], o[8];
#pragma unroll
            for (int j = 0; j < 4; ++j) { z0[2 * j] = __uint_as_float(zw[j] << 16); z0[2 * j + 1] = __uint_as_float(zw[j] & 0xffff0000u); }
#pragma unroll
            for (int j = 0; j < 8; ++j) { const float bv = (j & 1) ? __uint_as_float(bw[j >> 1] & 0xffff0000u) : __uint_as_float(bw[j >> 1] << 16);
                o[j] = bv * (w0[j] * zm2[j] + w1[j] * zm1[j] + w2[j] * z0[j]); zm2[j] = zm1[j]; zm1[j] = z0[j]; }
            if (FP8OUT) {
#pragma unroll
                for (int j = 0; j < 8; ++j) o[j] = fminf(fmaxf(o[j] * pg8::FP8_SG, -448.f), 448.f);
                int w0 = 0, w1 = 0; w0 = __builtin_amdgcn_cvt_pk_fp8_f32(o[0], o[1], w0, false); w0 = __builtin_amdgcn_cvt_pk_fp8_f32(o[2], o[3], w0, true);
                w1 = __builtin_amdgcn_cvt_pk_fp8_f32(o[4], o[5], w1, false); w1 = __builtin_amdgcn_cvt_pk_fp8_f32(o[6], o[7], w1, true);
                v2u ov; ov.x = (unsigned)w0; ov.y = (unsigned)w1; *(v2u*)((unsigned char*)Gout + (size_t)(r0 + r) * DM + cb) = ov;
            } else {
            v4u ov; ov.x = pk2(o[0], o[1]); ov.y = pk2(o[2], o[3]); ov.z = pk2(o[4], o[5]); ov.w = pk2(o[6], o[7]);
            *(v4u*)(Gout + (size_t)(r0 + r) * DM + cb) = ov; }
        }
    }
}

#ifndef PH_P0
#define PH_P0 1
#endif
#ifndef PH_A1
#define PH_A1 1
#endif
#ifndef PH_A2
#define PH_A2 1
#endif
#ifndef PH_A3
#define PH_A3 1
#endif
#ifndef PH_A4
#define PH_A4 1
#endif
#ifndef PH_C1
#define PH_C1 1
#endif
#ifndef PH_C1B
#define PH_C1B 1
#endif
#ifndef PH_C2
#define PH_C2 1
#endif
#ifndef PH_M1
#define PH_M1 1
#endif
#ifndef PH_M2
#define PH_M2 1
#endif
struct Args { Inputs in; float* out; unsigned char* ws; int ph_lo, ph_hi; };
#ifndef DBG_REP_LAYER
#define DBG_REP_LAYER -1
#endif
#ifndef DBG_REP_P0
#define DBG_REP_P0 0
#endif
#ifndef DBG_REP_A1
#define DBG_REP_A1 0
#endif
#ifndef DBG_REP_A2
#define DBG_REP_A2 0
#endif
#ifndef DBG_REP_A3
#define DBG_REP_A3 0
#endif
#ifndef DBG_REP_A4
#define DBG_REP_A4 0
#endif
#ifndef DBG_REP_C1
#define DBG_REP_C1 0
#endif
#ifndef DBG_REP_C1B
#define DBG_REP_C1B 0
#endif
#ifndef DBG_REP_C2
#define DBG_REP_C2 0
#endif
#ifndef DBG_REP_M1
#define DBG_REP_M1 0
#endif
#ifndef DBG_REP_M2
#define DBG_REP_M2 0
#endif
constexpr size_t WS_DUMMY_OUT = WS_END + 32 * MiB, WS_DUMMY_XB = WS_END + 160 * MiB, WS_DUMMY_SSQ = WS_END + 224 * MiB;
#define REPEAT(n) _Pragma("unroll") for (int rep = 0, nrep = ((li == DBG_REP_LAYER) ? 1 + (n) : 1); rep < nrep; ++rep)
#define REPBAR do { if (rep) { if (!MK_PER_PHASE) xcd_barrier(bar); } } while (0)
#define IN(k) (lo <= (k) && (k) < hi)
#define SEAM(k) do { if (IN(k) && IN((k) + 1)) { if (!MK_PER_PHASE) xcd_barrier(bar); } } while (0)
template <int li> __device__ __forceinline__ void layer_body(Frame& F, const Args& args, const XcdBarrier& bar, const int lo, const int hi, unsigned char* lds) {
    const Inputs& I = args.in; unsigned char* ws = args.ws;
    bf16* const XB = (bf16*)(ws + WS_XB); pg8::ssq_t* const SSQ = (pg8::ssq_t*)(ws + WS_SSQ);
    const unsigned* const ropeM = (const unsigned*)(ws + WS_ROPEM); const unsigned* const ropeI = (const unsigned*)(ws + WS_ROPEI);

        const int j = li >> 1, pb = 1 + 6 * li;
        if ((li & 1) == 0) {
            STAMP(pb + 0);
            if (PH_A1 && IN(pb + 0)) REPEAT(DBG_REP_A1) { REPBAR;
                pg8::Gemm g{XB, (const bf16*)(ws + WS_WA1 + j * SZ_WA1), M, NA1, DM}; pg8::StaticOrder S; S.init(M, NA1, F.G, (int)blockIdx.x);
                pg8::EpiA1 E{SSQ + (size_t)(2 * li) * M, (bf16*)(ws + WS_Q), (bf16*)(ws + WS_K), (bf16*)(ws + WS_V), (bf16*)(ws + WS_QI), (bf16*)(ws + WS_KI), (float*)(ws + WS_WI),
                             (const float*)(ws + WS_QG) + j * 128, (const float*)(ws + WS_KG) + j * 128, ropeM, ropeI, (PG8_LAS float*)(F.lds + AUX_OFF)};
                pg8::gemm_phase<pg8::EpiA1, pg8::StaticOrder, true, true>(F.lds + RING_OFF, g, S, E);
                if (DEFER_CONV) {
                    const bool part = F.G == 256; const int bx = (int)blockIdx.x;
                    if (!part || bx >= 64) { const Inputs Iw = *(const Inputs*)(ws + WS_INPTR);
                        convert_ranges(F, Iw, ranges_deferred(j), (part ? bx - 64 : bx) * NWAVES + F.wave, (part ? 192 : F.G) * NWAVES); } }
            } SEAM(pb + 0);
            STAMP(pb + 1);
            if (PH_A2 && IN(pb + 1)) REPEAT(DBG_REP_A2) { REPBAR; IdxTensors T{(const bf16*)(ws + WS_QI), (const bf16*)(ws + WS_KI), (const float*)(ws + WS_WI), (unsigned long long*)(ws + WS_MASK), args.out};
#if defined(DBG_DUMP)
                for (size_t e = (size_t)blockIdx.x * 512 + F.tid; e < (size_t)M * DM; e += (size_t)F.G * 512) { const int row = (int)(e / DM), c = (int)(e % DM); float v = 0.f;
                    if (c < 1024) v = bf2f(T.QI[(size_t)row * 1024 + c]); else if (c < 1088) v = bf2f(T.KI[(size_t)row * 64 + c - 1024]); else if (c < 1104) v = T.WI[(size_t)row * 16 + c - 1088];
                    args.out[e] = v; }
#else
                idx_phase(F, T, j);
#endif
                } SEAM(pb + 1);
            STAMP(pb + 2);
            if (PH_A3 && IN(pb + 2)) REPEAT(DBG_REP_A3) { REPBAR; const att::Tensors T{(const att::bf16*)(ws + WS_Q), (const att::bf16*)(ws + WS_K), (const att::bf16*)(ws + WS_V), (att::bf16*)(ws + WS_O), (const att::u64*)(ws + WS_MASK)};
                att::attn_phase((char*)lds + RING_OFF, T, (int)blockIdx.x, F.G); } SEAM(pb + 2);
            STAMP(pb + 3);
            if (PH_A4 && IN(pb + 3)) REPEAT(DBG_REP_A4) { REPBAR; const bool dummy = rep + 1 < nrep;
                pg8::Gemm g{(const bf16*)(ws + DBG_A4_SRC), (const bf16*)(ws + WS_WA4 + j * SZ_WSQ), M, DM, DM}; pg8::StaticOrder S; S.init(M, DM, F.G, (int)blockIdx.x);
                pg8::EpiRes<false, ((M1_FP8 >> li) & 1) != 0> E{XB, dummy ? (bf16*)(ws + WS_DUMMY_XB) : XB, nullptr, dummy ? (pg8::ssq_t*)(ws + WS_DUMMY_SSQ) : SSQ + (size_t)(2 * li + 1) * M, 1.0f, ws + WS_XB8};
                pg8::gemm_phase<pg8::EpiRes<false, ((M1_FP8 >> li) & 1) != 0>, pg8::StaticOrder, PG8_ALIGN_X, PG8_SP2_X>(F.lds + RING_OFF, g, S, E);
            } SEAM(pb + 3);
        } else {
            STAMP(pb + 0);
            if (PH_C1 && IN(pb + 0)) REPEAT(DBG_REP_C1) { REPBAR;
                constexpr bool c1f8 = ((C1_FP8 >> li) & 1) != 0;
                pg8::Gemm g{c1f8 ? (const bf16*)(ws + WS_XB8) : XB, (const bf16*)(ws + WS_WC1 + j * SZ_WC1), M, NC1, c1f8 ? DM / 2 : DM}; pg8::StaticOrder S; S.init(M, NC1, F.G, (int)blockIdx.x);
                pg8::EpiC1 E{(bf16*)(ws + WS_BG), (bf16*)(ws + WS_Z), SSQ + (size_t)(2 * li) * M, c1f8 ? 1.0f / (pg8::FP8_SX * pg8::FP8_SWI) : 1.0f};
                pg8::gemm_phase<pg8::EpiC1, pg8::StaticOrder, PG8_ALIGN_X, PG8_SP2_X, c1f8>(F.lds + RING_OFF, g, S, E);
            } SEAM(pb + 0);
            STAMP(pb + 1);
            if (PH_C1B && IN(pb + 1)) REPEAT(DBG_REP_C1B) { REPBAR; conv_phase<((C2_FP8 >> li) & 1) != 0>(F, (const bf16*)(ws + WS_BG), (const bf16*)(ws + WS_Z), (const float*)(ws + WS_CONVW) + (size_t)j * 3 * DM, (bf16*)(ws + WS_G)); } SEAM(pb + 1);
            STAMP(pb + 2);
            if (PH_C2 && IN(pb + 2)) REPEAT(DBG_REP_C2) { REPBAR; const bool dummy = rep + 1 < nrep;
                pg8::Gemm g{(const bf16*)(ws + WS_G), (const bf16*)(ws + WS_WC2 + j * SZ_WSQ), M, DM, ((C2_FP8 >> li) & 1) ? DM / 2 : DM}; pg8::StaticOrder S; S.init(M, DM, F.G, (int)blockIdx.x);
                pg8::EpiRes<false, ((M1_FP8 >> li) & 1) != 0> E{XB, dummy ? (bf16*)(ws + WS_DUMMY_XB) : XB, nullptr, dummy ? (pg8::ssq_t*)(ws + WS_DUMMY_SSQ) : SSQ + (size_t)(2 * li + 1) * M, ((C2_FP8 >> li) & 1) ? 1.0f / (pg8::FP8_SG * pg8::FP8_SWC) : 1.0f, ws + WS_XB8};
                pg8::gemm_phase<pg8::EpiRes<false, ((M1_FP8 >> li) & 1) != 0>, pg8::StaticOrder, PG8_ALIGN_X, PG8_SP2_X, ((C2_FP8 >> li) & 1) != 0>(F.lds + RING_OFF, g, S, E);
            } SEAM(pb + 2);
            STAMP(pb + 3);
        }
        STAMP(pb + 4);
        if (PH_M1 && IN(pb + 4)) REPEAT(DBG_REP_M1) { REPBAR;
            constexpr bool m1f8 = ((M1_FP8 >> li) & 1) != 0;
            pg8::Gemm g{m1f8 ? (const bf16*)(ws + WS_XB8) : XB, (const bf16*)(ws + WS_WM1 + li * SZ_WM), M, DFF, m1f8 ? DM / 2 : DM}; pg8::StaticOrder S; S.init(M, DFF, F.G, (int)blockIdx.x);
            pg8::EpiM1<((MLP_FP8 >> li) & 1) != 0> E{(bf16*)(ws + WS_H), SSQ + (size_t)(2 * li + 1) * M, m1f8 ? 1.0f / (pg8::FP8_SX * pg8::FP8_SWI) : 1.0f};
            pg8::gemm_phase<pg8::EpiM1<((MLP_FP8 >> li) & 1) != 0>, pg8::StaticOrder, PG8_ALIGN_X, PG8_SP2_X, m1f8>(F.lds + RING_OFF, g, S, E);
        } SEAM(pb + 4);
        STAMP(pb + 5);
        if (PH_M2 && IN(pb + 5)) REPEAT(DBG_REP_M2) { REPBAR; const bool dummy = rep + 1 < nrep;
            pg8::Gemm g{(const bf16*)(ws + WS_H), (const bf16*)(ws + WS_WM2 + li * SZ_WM), M, DM, ((MLP_FP8 >> li) & 1) ? DFF / 2 : DFF}; pg8::StaticOrder S; S.init(M, DM, F.G, (int)blockIdx.x);
            constexpr bool nx8 = li + 1 < DEPTH && ((C1_FP8 >> (li + 1)) & 1) != 0;
            pg8::EpiRes<li == DEPTH - 1, nx8> E{XB, dummy ? (bf16*)(ws + WS_DUMMY_XB) : XB, dummy ? (float*)(ws + WS_DUMMY_OUT) : args.out, dummy ? (pg8::ssq_t*)(ws + WS_DUMMY_SSQ) : SSQ + (size_t)(2 * li + 2) * M, ((MLP_FP8 >> li) & 1) ? 1.0f / (pg8::FP8_SA * pg8::FP8_SW) : 1.0f, ws + WS_XB8};
            pg8::gemm_phase<pg8::EpiRes<li == DEPTH - 1, nx8>, pg8::StaticOrder, PG8_ALIGN_X, (((MLP_FP8 >> li) & 1) ? PG8_SP2_F8 : PG8_SP2_X), ((MLP_FP8 >> li) & 1) != 0>(F.lds + RING_OFF, g, S, E);
        } SEAM(pb + 5);
    }
#undef IN
#undef SEAM
__global__ void __launch_bounds__(NWAVES * 64, 2) trunk_fwd(Args args) {
    extern __shared__ __attribute__((aligned(16))) unsigned char lds[];
    Frame F;
    F.lds = (LAS unsigned char*)lds;
    F.MISC = (volatile LAS unsigned*)(F.lds + MISC_OFF);
    F.tid = threadIdx.x; F.lane = F.tid & 63; F.wave = __builtin_amdgcn_readfirstlane(F.tid >> 6);
    F.G = gridDim.x; { const int bx = blockIdx.x; F.vcu = (F.G % 8 == 0) ? (bx % 8) * (F.G / 8) + bx / 8 : bx; }
    F.ws = args.ws; F.ctl = (gu32*)(args.ws + WS_CTL);
    for (int u = F.tid; u < 64; u += NWAVES * 64) ((LAS unsigned*)(F.lds + MISC_OFF))[u] = 0u;
    __syncthreads();
    XcdBarrier bar; bar.bar = (unsigned*)(F.ctl + CW_BAR); bar.x = 0; bar.st = nullptr;
    if (!MK_PER_PHASE) bar = xcd_barrier_post((unsigned*)(F.ctl + CW_BAR), F.MISC + 8);
    const int lo = args.ph_lo, hi = args.ph_hi;
    const Inputs& I = args.in;
    unsigned char* ws = args.ws;
#define IN(k) (lo <= (k) && (k) < hi)
#define SEAM(k) do { if (IN(k) && IN((k) + 1)) { if (!MK_PER_PHASE) xcd_barrier(bar); } } while (0)
    bf16* const XB = (bf16*)(ws + WS_XB);
    pg8::ssq_t* const SSQ = (pg8::ssq_t*)(ws + WS_SSQ);
    const unsigned* const ropeM = (const unsigned*)(ws + WS_ROPEM); const unsigned* const ropeI = (const unsigned*)(ws + WS_ROPEI);

    STAMP(0);
    if (PH_P0 && IN(0)) { for (int rep = 0; rep < 1 + DBG_REP_P0; ++rep) { if (rep) xcd_barrier(bar); p0_prologue(F, I, args.out); } } SEAM(0);

    layer_body<0>(F, args, bar, lo, hi, lds); layer_body<1>(F, args, bar, lo, hi, lds); layer_body<2>(F, args, bar, lo, hi, lds); layer_body<3>(F, args, bar, lo, hi, lds);
    STAMP(1 + 6 * DEPTH);
#if defined(DBG_EPI_TYPE)
    if (blockIdx.x == 0 && threadIdx.x == 0) { const unsigned long long dt = (unsigned long long)F.MISC[20] * 9ull, t0 = __builtin_amdgcn_s_memrealtime(); while (__builtin_amdgcn_s_memrealtime() - t0 < dt) __builtin_amdgcn_s_sleep(8); }
#endif
    if ((DBG_IDX_TIME > 0 || DBG_P0_TIME > 0) && blockIdx.x == 0 && threadIdx.x == 0) { const unsigned long long dt = (unsigned long long)F.MISC[20] * 9ull, t0 = __builtin_amdgcn_s_memrealtime(); while (__builtin_amdgcn_s_memrealtime() - t0 < dt) __builtin_amdgcn_s_sleep(8); }
    if (DBG_CLK_PHASE >= 0 && blockIdx.x == 0 && threadIdx.x == 0) {
        const unsigned long long c0 = (unsigned long long)F.MISC[32] | ((unsigned long long)F.MISC[33] << 32), r0 = (unsigned long long)F.MISC[34] | ((unsigned long long)F.MISC[35] << 32);
        const unsigned long long c1 = (unsigned long long)F.MISC[36] | ((unsigned long long)F.MISC[37] << 32), r1 = (unsigned long long)F.MISC[38] | ((unsigned long long)F.MISC[39] << 32);
        const unsigned long long dt = (r1 > r0) ? ((c1 - c0) * 1000ull) / (r1 - r0) : 0ull, t0 = __builtin_amdgcn_s_memrealtime(); while (__builtin_amdgcn_s_memrealtime() - t0 < dt) __builtin_amdgcn_s_sleep(8); }
    if (DBG_TIME_PHASE >= 0 && blockIdx.x == 0 && threadIdx.x == 0) { const unsigned long long tsA = (unsigned long long)F.MISC[16] | ((unsigned long long)F.MISC[17] << 32), tsB = (unsigned long long)F.MISC[18] | ((unsigned long long)F.MISC[19] << 32); const unsigned long long dt = (tsB - tsA) * 9ull, t0 = __builtin_amdgcn_s_memrealtime(); while (__builtin_amdgcn_s_memrealtime() - t0 < dt) __builtin_amdgcn_s_sleep(8); }
#undef IN
#undef SEAM
}

#ifndef DBG_NPH
#define DBG_NPH (1 + 6 * DEPTH)
#endif
constexpr int N_PHASES = DBG_NPH;
extern "C" void kernel_launch(void* const* d_in, const int* in_sizes, int n_in, void* d_out, int out_size, void* d_ws, size_t ws_size, hipStream_t stream) {
    static int grid = 0;
    if (grid == 0) {
        if (n_in != 14 || in_sizes[0] != M * DM || out_size != M * DM || ws_size < WS_END + 32 * MiB + (DBG_REP_LAYER >= 0 ? 232 * MiB : 0)) { fprintf(stderr, "kernel_launch: shape/workspace mismatch (n_in %d, in0 %d, out %d, ws %zu, need %zu)\n", n_in, n_in > 0 ? in_sizes[0] : -1, out_size, ws_size, (size_t)WS_END); grid = -1; return; }
        int dev = 0, cus = 0, per_cu = 0;
        if (hipGetDevice(&dev) != hipSuccess || hipDeviceGetAttribute(&cus, hipDeviceAttributeMultiprocessorCount, dev) != hipSuccess) { grid = -1; return; }
        if (hipFuncSetAttribute((const void*)trunk_fwd, hipFuncAttributeMaxDynamicSharedMemorySize, LDS_BYTES) != hipSuccess) { fprintf(stderr, "kernel_launch: hipFuncSetAttribute failed\n"); grid = -1; return; }
        if (hipOccupancyMaxActiveBlocksPerMultiprocessor(&per_cu, (const void*)trunk_fwd, NWAVES * 64, LDS_BYTES) != hipSuccess || per_cu < 1) fprintf(stderr, "kernel_launch: occupancy query reports %d\n", per_cu);
        (void)hipGetLastError();
        grid = cus;
    }
    if (grid < 0) return;
    if (hipMemsetAsync((char*)d_ws + WS_CTL, 0, CTL_ZERO_BYTES, stream) != hipSuccess) { fprintf(stderr, "kernel_launch: memset failed\n"); return; }
    Args a{};
    a.in.x = (const float*)d_in[0]; a.in.pos = (const int*)d_in[1]; a.in.attn_norm_g = (const float*)d_in[2]; a.in.attn_w_in = (const float*)d_in[3]; a.in.attn_q_g = (const float*)d_in[4];
    a.in.attn_k_g = (const float*)d_in[5]; a.in.attn_w_out = (const float*)d_in[6]; a.in.conv_norm_g = (const float*)d_in[7]; a.in.conv_w_in = (const float*)d_in[8]; a.in.conv_w = (const float*)d_in[9];
    a.in.conv_w_out = (const float*)d_in[10]; a.in.mlp_norm_g = (const float*)d_in[11]; a.in.mlp_w1 = (const float*)d_in[12]; a.in.mlp_w2 = (const float*)d_in[13];
    a.out = (float*)d_out; a.ws = (unsigned char*)d_ws;
#if MK_PER_PHASE
    for (int ph = 0; ph < N_PHASES; ++ph) {
        const int li = (ph - 1) / 6, k = (ph - 1) % 6;
        if (ph > 0 && (li & 1) == 1 && k == 3) continue;
        a.ph_lo = ph; a.ph_hi = ph + 1;
        hipLaunchKernelGGL(trunk_fwd, dim3(grid), dim3(NWAVES * 64), LDS_BYTES, stream, a);
    }
#else
    a.ph_lo = 0; a.ph_hi = N_PHASES;
    hipLaunchKernelGGL(trunk_fwd, dim3(grid), dim3(NWAVES * 64), LDS_BYTES, stream, a);
#endif
    const hipError_t le = hipPeekAtLastError();
    if (le != hipSuccess) fprintf(stderr, "kernel_launch: launch failed: %s\n", hipGetErrorName(le));
}
```

```cpp
#define MK_PER_PHASE 0
#include <hip/hip_runtime.h>
#include <cstdio>
#include <cstdint>
__device__ __forceinline__ int hw_lane() { int l_; asm volatile("v_mbcnt_lo_u32_b32 %0, -1, 0\n\tv_mbcnt_hi_u32_b32 %0, -1, %0" : "=v"(l_)); return l_; }
#ifndef PG8_WGM
#define PG8_WGM 4
#endif
namespace pg8 {
#define PG8_LAS __attribute__((address_space(3)))
typedef unsigned short bf16_t;
typedef short bf16x8 __attribute__((ext_vector_type(8)));
typedef float f32x4 __attribute__((ext_vector_type(4)));
typedef unsigned u32x4 __attribute__((ext_vector_type(4)));
constexpr int BM = 256, BK = 64, HALF = 128, HTB = HALF * BK * 2  , STAGE_BYTES = 8 * HTB, NXCD = 8, WGM = PG8_WGM;

__host__ __device__ __forceinline__ int lds_byte(int r, int c) { const int st = (r >> 4) * 2 + (c >> 5), rr = r & 15, cc = c & 31, ob = rr * 64 + cc * 2; return st * 1024 + (ob ^ (((ob >> 9) & 1) << 5)); }
__host__ __device__ __forceinline__ void stage_rc(int b, int& R, int& C) { const int st = b / 1024, sb = b % 1024, swz = sb ^ (((sb >> 9) & 1) << 5); R = (st >> 1) * 16 + swz / 64; C = (st & 1) * 32 + (swz % 64) / 2; }
__host__ __device__ __forceinline__ int perm32(int rho) { const int n = rho >> 4, i = rho & 15; return 8 * (i >> 2) + 4 * n + (i & 3); }

typedef int v8i_t __attribute__((ext_vector_type(8)));
typedef int v4i_t __attribute__((ext_vector_type(4)));
__device__ __forceinline__ v8i_t cat8(bf16x8 a, bf16x8 b) { const v4i_t x = __builtin_bit_cast(v4i_t, a), y = __builtin_bit_cast(v4i_t, b); return __builtin_shufflevector(x, y, 0, 1, 2, 3, 4, 5, 6, 7); }
struct Unit { int pm, pn; };
struct Gemm { const bf16_t* A; const bf16_t* Bt; int M, N, K; };

struct StaticOrder {
    int nM, nN, nwg, G, c;
    __host__ __device__ void init(int M, int N, int G_, int c_) { nM = M / BM; nN = N / BM; nwg = nM * nN; G = G_; c = c_; }
    __host__ __device__ bool next(int i, Unit& u) const {
        const long L = (long)i * G + c; if (L >= nwg) return false;
        int wgid = (int)L; { const int q = nwg / NXCD, r = nwg % NXCD, xcd = wgid % NXCD, off = wgid / NXCD; wgid = (xcd < r ? xcd * (q + 1) : r * (q + 1) + (xcd - r) * q) + off; }
        const int nig = WGM * nN, gid = wgid / nig, fm = gid * WGM, gsz = (nM - fm) < WGM ? (nM - fm) : WGM;
        u.pm = fm + ((wgid % nig) % gsz); u.pn = (wgid % nig) / gsz; return true;
    }
    __device__ __forceinline__ void a_ready(const Unit&) const {}
    __device__ __forceinline__ void done(const Unit&) const {}
};
__device__ __forceinline__ unsigned cvt_pk_bf16(float lo, float hi) { unsigned r; asm volatile("v_cvt_pk_bf16_f32 %0, %1, %2" : "=v"(r) : "v"(lo), "v"(hi)); return r; }
typedef unsigned u32x2 __attribute__((ext_vector_type(2)));
constexpr float RMS_EPS = 1e-6f;
typedef unsigned long long ssq_t;
__device__ __forceinline__ float rstd_of(ssq_t ssq) { return __builtin_amdgcn_rsqf((float)ssq * (1.0f / (2048.0f * 1048576.0f)) + RMS_EPS); }
__device__ __forceinline__ ssq_t ssq_fix(float s) { return (ssq_t)(s * 1048576.0f + 0.5f); }

constexpr float FP8_SX = 2.0f, FP8_SWI = 1024.0f;
template <bool FINAL, bool XB8 = false> struct EpiRes {
    static constexpr bool PERM = true, AFTER_DRAIN = false;
    const bf16_t* base; bf16_t* xb; float* out; ssq_t* ssq; float scale; unsigned char* xb8;
    __device__ __forceinline__ void operator()(const f32x4 (&acc)[2][2][4][2], const Unit& u, int wr, int wc, int fr, int fq) const {
        const int row0 = u.pm * BM + wr * 64 + fr, col0 = u.pn * BM + wc * 32 + 8 * fq;
        u32x4 bw[2][4][2];
#pragma unroll
        for (int ai = 0; ai < 2; ++ai)
#pragma unroll
            for (int m = 0; m < 4; ++m)
#pragma unroll
                for (int bj = 0; bj < 2; ++bj) bw[ai][m][bj] = *(const u32x4*)(base + (size_t)(row0 + ai * HALF + m * 16) * 2048 + col0 + bj * HALF);
        asm volatile("" ::: "memory");
#pragma unroll
        for (int ai = 0; ai < 2; ++ai)
#pragma unroll
            for (int m = 0; m < 4; ++m) {
                const int row = row0 + ai * HALF + m * 16; const size_t off = (size_t)row * 2048 + col0; float s = 0.f;
#pragma unroll
                for (int bj = 0; bj < 2; ++bj) {
                    const u32x4 b = bw[ai][m][bj];
                    const f32x4 b0 = {__uint_as_float(b.x << 16), __uint_as_float(b.x & 0xffff0000u), __uint_as_float(b.y << 16), __uint_as_float(b.y & 0xffff0000u)};
                    const f32x4 b1 = {__uint_as_float(b.z << 16), __uint_as_float(b.z & 0xffff0000u), __uint_as_float(b.w << 16), __uint_as_float(b.w & 0xffff0000u)};
                    const f32x4 o0 = b0 + acc[ai][bj][m][0] * scale, o1 = b1 + acc[ai][bj][m][1] * scale;
                    if (FINAL) { *(f32x4*)(out + off + bj * HALF) = o0; *(f32x4*)(out + off + bj * HALF + 4) = o1; }
                    else {
                        s += ((o0[0] * o0[0] + o0[1] * o0[1]) + (o0[2] * o0[2] + o0[3] * o0[3])) + ((o1[0] * o1[0] + o1[1] * o1[1]) + (o1[2] * o1[2] + o1[3] * o1[3]));
                        u32x4 w; w.x = cvt_pk_bf16(o0[0], o0[1]); w.y = cvt_pk_bf16(o0[2], o0[3]); w.z = cvt_pk_bf16(o1[0], o1[1]); w.w = cvt_pk_bf16(o1[2], o1[3]);
                        *(u32x4*)(xb + off + bj * HALF) = w;
                        if (XB8) { f32x4 e0 = o0 * FP8_SX, e1 = o1 * FP8_SX;
#pragma unroll
                            for (int j = 0; j < 4; ++j) { e0[j] = fminf(fmaxf(e0[j], -448.f), 448.f); e1[j] = fminf(fmaxf(e1[j], -448.f), 448.f); }
                            int w0 = 0, w1 = 0; w0 = __builtin_amdgcn_cvt_pk_fp8_f32(e0[0], e0[1], w0, false); w0 = __builtin_amdgcn_cvt_pk_fp8_f32(e0[2], e0[3], w0, true);
                            w1 = __builtin_amdgcn_cvt_pk_fp8_f32(e1[0], e1[1], w1, false); w1 = __builtin_amdgcn_cvt_pk_fp8_f32(e1[2], e1[3], w1, true);
                            u32x2 w8; w8.x = (unsigned)w0; w8.y = (unsigned)w1; *(u32x2*)(xb8 + off + bj * HALF) = w8; } }
                }
                if (!FINAL) { s += __shfl_xor(s, 16); s += __shfl_xor(s, 32);
                    if (fq == 0) __hip_atomic_fetch_add(ssq + row, ssq_fix(s), __ATOMIC_RELAXED, __HIP_MEMORY_SCOPE_AGENT); }
            }
    }
};

constexpr float FP8_SG = 16.0f, FP8_SWC = 1024.0f;
constexpr float FP8_SA = 8.0f, FP8_SW = 2048.0f;
template <bool FP8OUT> struct EpiM1 {
    static constexpr bool PERM = true, AFTER_DRAIN = false;
    bf16_t* H; const ssq_t* ssq; float iscale;
    __device__ __forceinline__ void operator()(const f32x4 (&acc)[2][2][4][2], const Unit& u, int wr, int wc, int fr, int fq) const {
        const int row0 = u.pm * BM + wr * 64 + fr, col0 = u.pn * BM + wc * 32 + 8 * fq;
        ssq_t sq[2][4];
#pragma unroll
        for (int ai = 0; ai < 2; ++ai)
#pragma unroll
            for (int m = 0; m < 4; ++m) sq[ai][m] = ssq[row0 + ai * HALF + m * 16];
        asm volatile("" ::: "memory");
#pragma unroll
        for (int ai = 0; ai < 2; ++ai)
#pragma unroll
            for (int m = 0; m < 4; ++m) {
                const int row = row0 + ai * HALF + m * 16; const float r = rstd_of(sq[ai][m]) * iscale;
#pragma unroll
                for (int bj = 0; bj < 2; ++bj) {
                    f32x4 v0 = acc[ai][bj][m][0] * r, v1 = acc[ai][bj][m][1] * r;
#pragma unroll
                    for (int j = 0; j < 4; ++j) { v0[j] = fmaxf(v0[j], 0.f); v1[j] = fmaxf(v1[j], 0.f); }
                    v0 = v0 * v0; v1 = v1 * v1;
                    if (FP8OUT) { v0 = v0 * FP8_SA; v1 = v1 * FP8_SA;
#pragma unroll
                        for (int j = 0; j < 4; ++j) { v0[j] = fminf(v0[j], 448.f); v1[j] = fminf(v1[j], 448.f); }
                        int w0 = 0, w1 = 0; w0 = __builtin_amdgcn_cvt_pk_fp8_f32(v0[0], v0[1], w0, false); w0 = __builtin_amdgcn_cvt_pk_fp8_f32(v0[2], v0[3], w0, true);
                        w1 = __builtin_amdgcn_cvt_pk_fp8_f32(v1[0], v1[1], w1, false); w1 = __builtin_amdgcn_cvt_pk_fp8_f32(v1[2], v1[3], w1, true);
                        u32x2 w; w.x = (unsigned)w0; w.y = (unsigned)w1;
                        *(u32x2*)((unsigned char*)H + (size_t)row * 8192 + col0 + bj * HALF) = w; }
                    else { u32x4 w; w.x = cvt_pk_bf16(v0[0], v0[1]); w.y = cvt_pk_bf16(v0[2], v0[3]); w.z = cvt_pk_bf16(v1[0], v1[1]); w.w = cvt_pk_bf16(v1[2], v1[3]);
                        *(u32x4*)(H + (size_t)row * 8192 + col0 + bj * HALF) = w; } }
            }
    }
};

struct EpiC1 {
    static constexpr bool PERM = true, AFTER_DRAIN = false;
    bf16_t* Bg; bf16_t* Z; const ssq_t* ssq; float iscale;
    __device__ __forceinline__ void operator()(const f32x4 (&acc)[2][2][4][2], const Unit& u, int wr, int wc, int fr, int fq) const {
        const int row0 = u.pm * BM + wr * 64 + fr;
        ssq_t sq[2][4];
#pragma unroll
        for (int ai = 0; ai < 2; ++ai)
#pragma unroll
            for (int m = 0; m < 4; ++m) sq[ai][m] = ssq[row0 + ai * HALF + m * 16];
        asm volatile("" ::: "memory");
        if (u.pn < 8) {
            const int col0 = u.pn * BM + wc * 32 + 8 * fq;
#pragma unroll
            for (int ai = 0; ai < 2; ++ai)
#pragma unroll
                for (int m = 0; m < 4; ++m) {
                    const int row = row0 + ai * HALF + m * 16; const float r = rstd_of(sq[ai][m]) * iscale; bf16_t* rowp = Bg + (size_t)row * 2048 + col0;
#pragma unroll
                    for (int bj = 0; bj < 2; ++bj) {
                        const f32x4 v0 = acc[ai][bj][m][0] * r, v1 = acc[ai][bj][m][1] * r;
                        u32x4 w; w.x = cvt_pk_bf16(v0[0], v0[1]); w.y = cvt_pk_bf16(v0[2], v0[3]); w.z = cvt_pk_bf16(v1[0], v1[1]); w.w = cvt_pk_bf16(v1[2], v1[3]);
                        *(u32x4*)(rowp + bj * HALF) = w; }
                }
        } else {
            const int col0 = (u.pn - 8) * HALF + wc * 32 + 8 * fq;
#pragma unroll
            for (int ai = 0; ai < 2; ++ai)
#pragma unroll
                for (int m = 0; m < 4; ++m) {
                    const int row = row0 + ai * HALF + m * 16; const float r = rstd_of(sq[ai][m]) * iscale; const float r2 = r * r;
                    const f32x4 v0 = acc[ai][0][m][0] * acc[ai][1][m][0] * r2, v1 = acc[ai][0][m][1] * acc[ai][1][m][1] * r2;
                    u32x4 w; w.x = cvt_pk_bf16(v0[0], v0[1]); w.y = cvt_pk_bf16(v0[2], v0[3]); w.z = cvt_pk_bf16(v1[0], v1[1]); w.w = cvt_pk_bf16(v1[2], v1[3]);
                    *(u32x4*)(Z + (size_t)row * 2048 + col0) = w;
                }
        }
    }
};

__device__ __forceinline__ float h2f_lo(unsigned w) { return (float)__builtin_bit_cast(_Float16, (unsigned short)(w & 0xffffu)); }
__device__ __forceinline__ float h2f_hi(unsigned w) { return (float)__builtin_bit_cast(_Float16, (unsigned short)(w >> 16)); }
__device__ __forceinline__ f32x4 cos4(u32x4 w) { return (f32x4){h2f_lo(w.x), h2f_lo(w.y), h2f_lo(w.z), h2f_lo(w.w)}; }
__device__ __forceinline__ f32x4 sin4(u32x4 w) { return (f32x4){h2f_hi(w.x), h2f_hi(w.y), h2f_hi(w.z), h2f_hi(w.w)}; }
struct EpiA1 {
    static constexpr bool PERM = false, AFTER_DRAIN = false;
    const ssq_t* ssq; bf16_t *Q, *K, *V, *QI, *KI; float* WI; const float *qg, *kg; const unsigned *ropeM, *ropeI; PG8_LAS float* P;
    __device__ __forceinline__ void operator()(const f32x4 (&acc)[2][2][4][2], const Unit& u, int wr, int wc, int fr, int fq) const {
        const int pn = u.pn, rl0 = wr * 64 + fr, row0 = u.pm * BM + rl0;
        ssq_t sq[2][4];
#pragma unroll
        for (int ai = 0; ai < 2; ++ai)
#pragma unroll
            for (int m = 0; m < 4; ++m) sq[ai][m] = ssq[row0 + ai * HALF + m * 16];
        if (pn < 10) {
            const bool isq = pn < 8; const float* g = isq ? qg : kg;
            const f32x4 g0 = *(const f32x4*)(g + 32 * wc + 4 * fq), g1 = *(const f32x4*)(g + 32 * wc + 16 + 4 * fq);
            u32x4 cw[2][4];
#pragma unroll
            for (int ai = 0; ai < 2; ++ai)
#pragma unroll
                for (int m = 0; m < 4; ++m) { const int row = row0 + ai * HALF + m * 16; cw[ai][m] = (u32x4){0x3c00u, 0x3c00u, 0x3c00u, 0x3c00u};
                    if (wc == 0) cw[ai][m] = *(const u32x4*)(ropeM + (size_t)row * 16 + 4 * fq); }
#pragma unroll
            for (int ai = 0; ai < 2; ++ai)
#pragma unroll
                for (int m = 0; m < 4; ++m) { const int rl = rl0 + ai * HALF + m * 16;
#pragma unroll
                    for (int bj = 0; bj < 2; ++bj) { const f32x4 a = acc[ai][bj][m][0], b = acc[ai][bj][m][1];
                        float s = ((a[0] * a[0] + a[1] * a[1]) + (a[2] * a[2] + a[3] * a[3])) + ((b[0] * b[0] + b[1] * b[1]) + (b[2] * b[2] + b[3] * b[3]));
                        s += __shfl_xor(s, 16); s += __shfl_xor(s, 32);
                        if (fq == 0) P[(rl * 2 + bj) * 4 + wc] = s; } }
            asm volatile("s_waitcnt lgkmcnt(0)" ::: "memory"); __builtin_amdgcn_s_barrier(); asm volatile("" ::: "memory");
#pragma unroll
            for (int ai = 0; ai < 2; ++ai)
#pragma unroll
                for (int m = 0; m < 4; ++m) { const int rl = rl0 + ai * HALF + m * 16, row = row0 + ai * HALF + m * 16; const float rs = rstd_of(sq[ai][m]);
                    bf16_t* dst = isq ? Q + (size_t)row * 2048 + pn * BM + wc * 32 + 4 * fq : K + (size_t)row * 512 + (pn - 8) * BM + wc * 32 + 4 * fq;
#pragma unroll
                    for (int bj = 0; bj < 2; ++bj) { const f32x4 pp = *(const PG8_LAS f32x4*)(P + (rl * 2 + bj) * 4);
                        const float tot = (pp[0] + pp[1]) + (pp[2] + pp[3]);
                        const float sc = rs * __builtin_amdgcn_rsqf(rs * rs * tot * (1.0f / 128.0f) + RMS_EPS);
                        f32x4 v0 = acc[ai][bj][m][0] * sc * g0, v1 = acc[ai][bj][m][1] * sc * g1;
                        if (wc == 0) { const f32x4 x1 = v0, x2 = v1, cs = cos4(cw[ai][m]), sn = sin4(cw[ai][m]); v0 = x1 * cs - x2 * sn; v1 = x2 * cs + x1 * sn; }
                        u32x2 w0, w1; w0.x = cvt_pk_bf16(v0[0], v0[1]); w0.y = cvt_pk_bf16(v0[2], v0[3]); w1.x = cvt_pk_bf16(v1[0], v1[1]); w1.y = cvt_pk_bf16(v1[2], v1[3]);
                        *(u32x2*)(dst + bj * HALF) = w0; *(u32x2*)(dst + bj * HALF + 16) = w1; } }
        } else if (pn < 12) {
            asm volatile("" ::: "memory");
#pragma unroll
            for (int ai = 0; ai < 2; ++ai)
#pragma unroll
                for (int m = 0; m < 4; ++m) { const int row = row0 + ai * HALF + m * 16; const float rs = rstd_of(sq[ai][m]);
                    bf16_t* dst = V + (size_t)row * 512 + (pn - 10) * BM + wc * 32 + 4 * fq;
#pragma unroll
                    for (int bj = 0; bj < 2; ++bj) { const f32x4 v0 = acc[ai][bj][m][0] * rs, v1 = acc[ai][bj][m][1] * rs;
                        u32x2 w0, w1; w0.x = cvt_pk_bf16(v0[0], v0[1]); w0.y = cvt_pk_bf16(v0[2], v0[3]); w1.x = cvt_pk_bf16(v1[0], v1[1]); w1.y = cvt_pk_bf16(v1[2], v1[3]);
                        *(u32x2*)(dst + bj * HALF) = w0; *(u32x2*)(dst + bj * HALF + 16) = w1; } }
        } else {
            const bool rot = ((wc & 1) == 0) && fq < 2;
            const int d0 = (wc & 1) ? 32 + 4 * fq : (fq < 2 ? 4 * fq : 16 + 4 * (fq - 2)), d1 = (wc & 1) ? 48 + 4 * fq : (fq < 2 ? 8 + 4 * fq : 24 + 4 * (fq - 2));
            const bool iski = pn == 16;
            u32x4 cw[2][4];
#pragma unroll
            for (int ai = 0; ai < 2; ++ai)
#pragma unroll
                for (int m = 0; m < 4; ++m) { const int row = row0 + ai * HALF + m * 16; cw[ai][m] = (u32x4){0x3c00u, 0x3c00u, 0x3c00u, 0x3c00u};
                    if (rot) cw[ai][m] = *(const u32x4*)(ropeI + (size_t)row * 8 + 4 * fq); }
            asm volatile("" ::: "memory");
#pragma unroll
            for (int ai = 0; ai < 2; ++ai)
#pragma unroll
                for (int m = 0; m < 4; ++m) { const int row = row0 + ai * HALF + m * 16; const float rs = rstd_of(sq[ai][m]);
#pragma unroll
                    for (int bj = 0; bj < 2; ++bj) {
                        f32x4 v0 = acc[ai][bj][m][0] * rs, v1 = acc[ai][bj][m][1] * rs;
                        if (iski) {
                            if (bj == 0) {
                                if (wc < 2) { if (rot) { const f32x4 x1 = v0, x2 = v1, cs = cos4(cw[ai][m]), sn = sin4(cw[ai][m]); v0 = x1 * cs - x2 * sn; v1 = x2 * cs + x1 * sn; }
                                    u32x2 w0, w1; w0.x = cvt_pk_bf16(v0[0], v0[1]); w0.y = cvt_pk_bf16(v0[2], v0[3]); w1.x = cvt_pk_bf16(v1[0], v1[1]); w1.y = cvt_pk_bf16(v1[2], v1[3]);
                                    bf16_t* dst = KI + (size_t)row * 64; *(u32x2*)(dst + d0) = w0; *(u32x2*)(dst + d1) = w1; }
                                else if (wc == 2) { *(f32x4*)(WI + (size_t)row * 16 + 4 * fq) = v0 * 0.03125f; }
                            }
                        } else {
                            if (rot) { const f32x4 x1 = v0, x2 = v1, cs = cos4(cw[ai][m]), sn = sin4(cw[ai][m]); v0 = x1 * cs - x2 * sn; v1 = x2 * cs + x1 * sn; }
                            u32x2 w0, w1; w0.x = cvt_pk_bf16(v0[0], v0[1]); w0.y = cvt_pk_bf16(v0[2], v0[3]); w1.x = cvt_pk_bf16(v1[0], v1[1]); w1.y = cvt_pk_bf16(v1[2], v1[3]);
                            bf16_t* dst = QI + (size_t)row * 1024 + ((pn - 12) * 4 + 2 * bj + (wc >> 1)) * 64; *(u32x2*)(dst + d0) = w0; *(u32x2*)(dst + d1) = w1; }
                    } }
        }
    }
};
template <class T> struct EpiTag { static constexpr int id = 0; };
template <> struct EpiTag<EpiA1> { static constexpr int id = 1; };
template <> struct EpiTag<EpiC1> { static constexpr int id = 2; };
template <> struct EpiTag<EpiM1<false>> { static constexpr int id = 3; };
template <> struct EpiTag<EpiM1<true>> { static constexpr int id = 4; };
template <class Epi, class Sched, bool ALIGN_EPI = false, bool SP2 = false, bool FP8 = false>
__device__ __forceinline__ void gemm_phase(PG8_LAS unsigned char* lds, const Gemm g, const Sched& S, const Epi& E, const int wv) {
    int tid = wv * 64 + hw_lane(); asm volatile("" : "+v"(tid));
    const int wid = __builtin_amdgcn_readfirstlane(tid >> 6), lane = tid & 63, wr = wid >> 2, wc = wid & 3, fr = lane & 15, fq = lane >> 4;
    const int K = g.K, nt = K / BK;
    unsigned voffA[2], voffB[2];
#pragma unroll
    for (int i = 0; i < 2; ++i) { int R, C; stage_rc(tid * 16 + i * 8192, R, C); const int Rb = Epi::PERM ? ((R & ~31) + perm32(R & 31)) : R;
        voffA[i] = (unsigned)(R * K + C) * 2u; voffB[i] = (unsigned)(Rb * K + C) * 2u; }
    const size_t kstep = (size_t)(BK * 2);
    const size_t hstep = (size_t)HALF * K * 2;
    const size_t tstep = 2 * hstep;
    const unsigned ldsw = (unsigned)wid * 1024u;
    const int aoff = FP8 ? lds_byte(wr * 64 + fr, 16 * (fq & 1)) + (fq >> 1) * 1024 : lds_byte(wr * 64 + fr, fq * 8), boff = FP8 ? lds_byte(wc * 32 + fr, 16 * (fq & 1)) + (fq >> 1) * 1024 : lds_byte(wc * 32 + fr, fq * 8);
#define PG8_SA(b, h) (((b) * 2 + (h)) * HTB)
#define PG8_SB(b, h) ((4 + (b) * 2 + (h)) * HTB)
#define PG8_STAGE(bufoff, gbase, voff) do { _Pragma("unroll") for (int _i = 0; _i < 2; ++_i) \
        __builtin_amdgcn_global_load_lds((const unsigned*)((const char*)(gbase) + (voff)[_i]), (PG8_LAS unsigned*)(lds + (bufoff) + ldsw + _i * 8192), 16, 0, 0); } while (0)
#define PG8_LDA(dst, b, h) do { if constexpr (FP8) { _Pragma("unroll") for (int m = 0; m < 4; ++m) dst##8[m] = cat8(*(const PG8_LAS bf16x8*)(lds + PG8_SA(b, h) + aoff + m * 2048), *(const PG8_LAS bf16x8*)(lds + PG8_SA(b, h) + aoff + m * 2048 + 16)); } \
    else { _Pragma("unroll") for (int m = 0; m < 4; ++m) _Pragma("unroll") for (int k = 0; k < 2; ++k) dst[m][k] = *(const PG8_LAS bf16x8*)(lds + PG8_SA(b, h) + aoff + m * 2048 + k * 1024); } } while (0)
#define PG8_LDB(dst, b, h) do { if constexpr (FP8) { _Pragma("unroll") for (int n = 0; n < 2; ++n) dst##8[n] = cat8(*(const PG8_LAS bf16x8*)(lds + PG8_SB(b, h) + boff + n * 2048), *(const PG8_LAS bf16x8*)(lds + PG8_SB(b, h) + boff + n * 2048 + 16)); } \
    else { _Pragma("unroll") for (int n = 0; n < 2; ++n) _Pragma("unroll") for (int k = 0; k < 2; ++k) dst[n][k] = *(const PG8_LAS bf16x8*)(lds + PG8_SB(b, h) + boff + n * 2048 + k * 1024); } } while (0)
#define PG8_MMA(ai, bj, At, Bt) do { __builtin_amdgcn_s_setprio(1); if constexpr (FP8) { _Pragma("unroll") for (int m = 0; m < 4; ++m) _Pragma("unroll") for (int n = 0; n < 2; ++n) \
        asm volatile("v_mfma_scale_f32_16x16x128_f8f6f4 %0, %1, %2, %0, %3, %3 op_sel_hi:[0,0,0]" : "+v"(acc[ai][bj][m][n]) : "v"(Bt##8[n]), "v"(At##8[m]), "v"(sc1)); } \
    else { _Pragma("unroll") for (int m = 0; m < 4; ++m) _Pragma("unroll") for (int n = 0; n < 2; ++n) _Pragma("unroll") for (int k = 0; k < 2; ++k) \
        acc[ai][bj][m][n] = __builtin_amdgcn_mfma_f32_16x16x32_bf16(Bt[n][k], At[m][k], acc[ai][bj][m][n], 0, 0, 0); } __builtin_amdgcn_s_setprio(0); } while (0)
#define PG8_WAIT_V(n) asm volatile("s_waitcnt vmcnt(" #n ")" ::: "memory")
#define PG8_WAIT_L(n) asm volatile("s_waitcnt lgkmcnt(" #n ")" ::: "memory")
#define PG8_BAR __builtin_amdgcn_s_barrier()
#define PG8_SCHED __builtin_amdgcn_sched_barrier(0)
    Unit cur, nxt; int ui = 0;
    if (!S.next(0, cur)) return;
    f32x4 acc[2][2][4][2];
#pragma unroll
    for (int a = 0; a < 2; ++a)
#pragma unroll
        for (int b = 0; b < 2; ++b)
#pragma unroll
            for (int m = 0; m < 4; ++m)
#pragma unroll
                for (int n = 0; n < 2; ++n) acc[a][b][m][n] = (f32x4){0.f, 0.f, 0.f, 0.f};
    const int sc1 = 0x7f7f7f7f;
    bf16x8 At[4][2], B0[2][2], B1[2][2]; v8i_t At8[4], B08[2], B18[2];
    const char* cA = (const char*)g.A + (size_t)cur.pm * tstep; const char* cB = (const char*)g.Bt + (size_t)cur.pn * tstep;
    S.a_ready(cur);
    if constexpr (SP2) {
        PG8_STAGE(PG8_SB(0, 0), cB, voffB); PG8_STAGE(PG8_SB(0, 1), cB + hstep, voffB); PG8_STAGE(PG8_SA(0, 0), cA, voffA); PG8_STAGE(PG8_SA(0, 1), cA + hstep, voffA);
        if (wr == 1) PG8_BAR;
        PG8_WAIT_V(2); PG8_BAR;
        PG8_STAGE(PG8_SB(1, 0), cB + kstep, voffB); PG8_STAGE(PG8_SA(1, 0), cA + kstep, voffA); PG8_STAGE(PG8_SB(1, 1), cB + hstep + kstep, voffB);
        PG8_WAIT_V(6); PG8_BAR;
    } else {
        PG8_STAGE(PG8_SB(0, 0), cB, voffB); PG8_STAGE(PG8_SA(0, 0), cA, voffA); PG8_STAGE(PG8_SB(0, 1), cB + hstep, voffB); PG8_STAGE(PG8_SA(0, 1), cA + hstep, voffA);
        if (wr == 1) PG8_BAR;
        PG8_WAIT_V(4); PG8_BAR;
        PG8_STAGE(PG8_SB(1, 0), cB + kstep, voffB); PG8_STAGE(PG8_SA(1, 0), cA + kstep, voffA); PG8_STAGE(PG8_SB(1, 1), cB + hstep + kstep, voffB);
        PG8_WAIT_V(6); PG8_BAR;
    }
    for (;;) {
        const bool has_next = S.next(ui + 1, nxt);
        const char* nA = has_next ? (const char*)g.A + (size_t)nxt.pm * tstep : cA; const char* nB = has_next ? (const char*)g.Bt + (size_t)nxt.pn * tstep : cB;
        for (int t = 0; t < nt; t += 2) {
            const bool last = (t == nt - 2);
            const char* a1 = cA + (size_t)(t + 1) * kstep;
            const char* a2 = last ? nA : cA + (size_t)(t + 2) * kstep; const char* b2 = last ? nB : cB + (size_t)(t + 2) * kstep;
            const char* a3 = a2 + kstep; const char* b3 = b2 + kstep;
            if (last && has_next) S.a_ready(nxt);
            if constexpr (SP2) {
            PG8_LDB(B0, 0, 0); PG8_LDB(B1, 0, 1); PG8_SCHED; PG8_LDA(At, 0, 0); PG8_STAGE(PG8_SA(1, 1), a1 + hstep, voffA);
            PG8_WAIT_V(8); PG8_WAIT_L(0); PG8_BAR; PG8_MMA(0, 0, At, B0); PG8_MMA(0, 1, At, B1); PG8_BAR; PG8_SCHED;
            PG8_LDA(At, 0, 1); PG8_STAGE(PG8_SB(0, 0), b2, voffB); PG8_STAGE(PG8_SB(0, 1), b2 + hstep, voffB); PG8_STAGE(PG8_SA(0, 0), a2, voffA);
            PG8_WAIT_V(8); PG8_WAIT_L(0); PG8_BAR; PG8_MMA(1, 0, At, B0); PG8_MMA(1, 1, At, B1); PG8_BAR; PG8_SCHED;
            PG8_LDB(B0, 1, 0); PG8_LDB(B1, 1, 1); PG8_SCHED; PG8_LDA(At, 1, 0); PG8_STAGE(PG8_SA(0, 1), a2 + hstep, voffA);
            PG8_WAIT_V(8); PG8_WAIT_L(0); PG8_BAR; PG8_MMA(0, 0, At, B0); PG8_MMA(0, 1, At, B1); PG8_BAR; PG8_SCHED;
            PG8_LDA(At, 1, 1); PG8_STAGE(PG8_SB(1, 0), b3, voffB); PG8_STAGE(PG8_SB(1, 1), b3 + hstep, voffB); PG8_STAGE(PG8_SA(1, 0), a3, voffA);
            PG8_WAIT_V(8); PG8_WAIT_L(0); PG8_BAR; PG8_MMA(1, 0, At, B0); PG8_MMA(1, 1, At, B1); PG8_BAR; PG8_SCHED;
            } else {
            PG8_LDB(B0, 0, 0); PG8_SCHED; PG8_LDA(At, 0, 0); PG8_STAGE(PG8_SA(1, 1), a1 + hstep, voffA);
            PG8_WAIT_L(8); PG8_BAR; PG8_WAIT_L(0); PG8_MMA(0, 0, At, B0); PG8_BAR; PG8_SCHED;
            PG8_LDB(B1, 0, 1); PG8_STAGE(PG8_SB(0, 0), b2, voffB);
            PG8_BAR; PG8_WAIT_L(0); PG8_MMA(0, 1, At, B1); PG8_BAR;
            PG8_LDA(At, 0, 1); PG8_STAGE(PG8_SA(0, 0), a2, voffA);
            PG8_BAR; PG8_WAIT_L(0); PG8_MMA(1, 0, At, B0); PG8_BAR; PG8_SCHED;
            PG8_STAGE(PG8_SB(0, 1), b2 + hstep, voffB);
            PG8_WAIT_V(6); PG8_BAR; PG8_MMA(1, 1, At, B1); PG8_BAR;
            PG8_LDB(B0, 1, 0); PG8_SCHED; PG8_LDA(At, 1, 0); PG8_STAGE(PG8_SA(0, 1), a2 + hstep, voffA);
            PG8_WAIT_L(8); PG8_BAR; PG8_WAIT_L(0); PG8_MMA(0, 0, At, B0); PG8_BAR; PG8_SCHED;
            PG8_LDB(B1, 1, 1); PG8_STAGE(PG8_SB(1, 0), b3, voffB);
            PG8_BAR; PG8_WAIT_L(0); PG8_MMA(0, 1, At, B1); PG8_BAR;
            PG8_LDA(At, 1, 1); PG8_STAGE(PG8_SA(1, 0), a3, voffA);
            PG8_BAR; PG8_WAIT_L(0); PG8_MMA(1, 0, At, B0); PG8_BAR; PG8_SCHED;
            PG8_STAGE(PG8_SB(1, 1), b3 + hstep, voffB);
            PG8_WAIT_V(6); PG8_BAR; PG8_MMA(1, 1, At, B1); PG8_BAR;
            }
        }
        if constexpr (ALIGN_EPI) { if (wr == 0) PG8_BAR; }
#if defined(DBG_EPI_TYPE)
        unsigned long long et_ = 0; if (EpiTag<Epi>::id == DBG_EPI_TYPE && blockIdx.x == 0 && threadIdx.x == 0) et_ = __builtin_amdgcn_s_memrealtime();
#endif
        if constexpr (!Epi::AFTER_DRAIN) { E(acc, cur, wr, wc, fr, fq); S.done(cur); }
#if defined(DBG_EPI_TYPE)
        if (EpiTag<Epi>::id == DBG_EPI_TYPE && blockIdx.x == 0 && threadIdx.x == 0) { asm volatile("s_waitcnt vmcnt(0)" ::: "memory"); *(volatile PG8_LAS unsigned*)(lds + 150016 + 80) += (unsigned)(__builtin_amdgcn_s_memrealtime() - et_); }
#endif
        if (!has_next) break;
#pragma unroll
        for (int a = 0; a < 2; ++a)
#pragma unroll
            for (int b = 0; b < 2; ++b)
#pragma unroll
                for (int m = 0; m < 4; ++m)
#pragma unroll
                    for (int n = 0; n < 2; ++n) acc[a][b][m][n] = (f32x4){0.f, 0.f, 0.f, 0.f};
        cur = nxt; cA = nA; cB = nB; ++ui;
        if constexpr (ALIGN_EPI) { if (wr == 1) PG8_BAR; }
    }
    PG8_WAIT_V(0);
    if constexpr (!ALIGN_EPI) { if (wr == 0) PG8_BAR; }
    PG8_BAR;
    if constexpr (Epi::AFTER_DRAIN) { E.fused(acc, cur, wr, wc, fr, fq, lds, wid, lane); S.done(cur); }
#undef PG8_SA
#undef PG8_SB
#undef PG8_STAGE
#undef PG8_LDA
#undef PG8_LDB
#undef PG8_MMA
#undef PG8_WAIT_V
#undef PG8_WAIT_L
#undef PG8_BAR
#undef PG8_SCHED
}
}
#ifndef ATT_THR
#define ATT_THR 16.f
#endif
namespace att {
typedef unsigned short bf16;
typedef short bf16x8 __attribute__((ext_vector_type(8)));
typedef short s16x4 __attribute__((ext_vector_type(4)));
typedef float f32x16 __attribute__((ext_vector_type(16)));
typedef float f32x4 __attribute__((ext_vector_type(4)));
typedef unsigned u32x4 __attribute__((ext_vector_type(4)));
typedef unsigned long long u64;
constexpr int D = 128, SEQ = 4096, QP = 2048, KP = 512;
constexpr float SCALE = 0.08838834764831845f;
constexpr float THR = ATT_THR;
constexpr int NW = 8, QBLK = 32, KVBLK = 64, QB = NW * QBLK;
constexpr int SHM_V = KVBLK * D * 2, SHM_K = KVBLK * D * 2;
#ifndef ATT_ONE_BAR
#define ATT_ONE_BAR 1
#endif
constexpr int NV = ATT_ONE_BAR ? 3 : 2;
constexpr int LDS_BYTES = NV * SHM_V + 2 * SHM_K + NW * 64 * 4;

#define KSWZ(row, colB) ((row) * 256 + ((colB) ^ (((row) & 7) << 4)))
#define SBAR() __builtin_amdgcn_sched_barrier(0)
__device__ __forceinline__ int v_st(int k, int c) { const int kk = (k & ~0xC) | ((k & 4) << 1) | ((k & 8) >> 1); return ((kk >> 3) * 4 + (c >> 5)) * 512 + ((kk & 7) * 32 + (c & 31)) * 2; }
__device__ __forceinline__ int v_rd_base(int lane) { return ((lane & 3) << 3) | (((lane >> 2) & 3) << 6) | (((lane >> 4) & 1) << 5) | (((lane >> 5) & 1) << 8); }
constexpr int v_rd_off(int d0, int ks, int half) { return d0 * 512 + ks * 4096 + half * 2048; }
__device__ __forceinline__ int crow(int r, int hi) { return (r & 3) + 8 * (r >> 2) + 4 * hi; }
__device__ __forceinline__ unsigned cvtpk(float lo, float hi) { unsigned r; asm volatile("v_cvt_pk_bf16_f32 %0, %1, %2" : "=v"(r) : "v"(lo), "v"(hi)); return r; }
__device__ __forceinline__ bf16x8 load8(const bf16* p) { return *reinterpret_cast<const bf16x8*>(p); }
template <bool NOP> __device__ __forceinline__ void mask_tile(f32x16& p0, f32x16& p1, u64 mk, int hi) {
    const unsigned m0 = (unsigned)mk >> (4 * hi), m1 = (unsigned)(mk >> 32) >> (4 * hi);
    const unsigned NEGINF = 0xFF800000u;
    if (NOP) asm volatile("s_nop 15\n\ts_nop 7" ::: "memory");
#pragma unroll
    for (int r = 0; r < 16; ++r) {
        const int c = (r & 3) + 8 * (r >> 2);
        unsigned t0, t1;
        asm volatile("v_bfe_i32 %0, %1, %2, 1" : "=v"(t0) : "v"(m0), "n"(c));
        asm volatile("v_bfi_b32 %0, %1, %0, %2" : "+v"(p0[r]) : "v"(t0), "s"(NEGINF));
        asm volatile("v_bfe_i32 %0, %1, %2, 1" : "=v"(t1) : "v"(m1), "n"(c));
        asm volatile("v_bfi_b32 %0, %1, %0, %2" : "+v"(p1[r]) : "v"(t1), "s"(NEGINF));
    }
}
__device__ __forceinline__ void partialSM(f32x16& p0, f32x16& p1, float& m_reg, float& mn, float& alpha) {
    float pmax = p0[0]; for (int r = 1; r < 16; ++r) pmax = fmaxf(pmax, p0[r]); for (int r = 0; r < 16; ++r) pmax = fmaxf(pmax, p1[r]);
    { auto rr = __builtin_amdgcn_permlane32_swap(__float_as_uint(pmax), __float_as_uint(pmax), false, false);
      pmax = fmaxf(__uint_as_float(rr[0]), __uint_as_float(rr[1])); }
    constexpr float C2 = 1.4426950408889634f * SCALE;
    if (__builtin_expect(__all((pmax - m_reg) * SCALE <= THR), 1)) { mn = m_reg; alpha = 1.f; }
    else { mn = fmaxf(m_reg, pmax); alpha = __builtin_amdgcn_exp2f((m_reg - mn) * C2); m_reg = mn; }
    const float mnL = -mn * C2;
    for (int r = 0; r < 16; ++r) p0[r] = fmaf(p0[r], C2, mnL); for (int r = 0; r < 16; ++r) p1[r] = fmaf(p1[r], C2, mnL);
    for (int r = 0; r < 16; ++r) p0[r] = __builtin_amdgcn_exp2f(p0[r]);
}
__device__ __forceinline__ void finishSM(f32x16& p0, f32x16& p1, float alpha, float& l_reg, bf16x8& pa0, bf16x8& pa1, bf16x8& pa2, bf16x8& pa3) {
    for (int r = 0; r < 16; ++r) p1[r] = __builtin_amdgcn_exp2f(p1[r]);
    float ps = 0; for (int r = 0; r < 16; ++r) ps += p0[r]; for (int r = 0; r < 16; ++r) ps += p1[r];
    { auto rr = __builtin_amdgcn_permlane32_swap(__float_as_uint(ps), __float_as_uint(ps), false, false);
      ps = __uint_as_float(rr[0]) + __uint_as_float(rr[1]); }
    l_reg = l_reg * alpha + ps;
#define PK4(P, B_, OUT) do { unsigned a0 = cvtpk(P[B_+0], P[B_+1]), a1 = cvtpk(P[B_+2], P[B_+3]);                          \
        unsigned b0 = cvtpk(P[B_+4], P[B_+5]), b1 = cvtpk(P[B_+6], P[B_+7]);                                             \
        auto r0 = __builtin_amdgcn_permlane32_swap(a0, b0, false, false); auto r1 = __builtin_amdgcn_permlane32_swap(a1, b1, false, false); \
        u32x4 w = {r0[0], r1[0], r0[1], r1[1]}; OUT = *reinterpret_cast<bf16x8*>(&w); } while (0)
    PK4(p0, 0, pa0); PK4(p0, 8, pa1); PK4(p1, 0, pa2); PK4(p1, 8, pa3);
#undef PK4
}
template <int KB>
__device__ __forceinline__ void qkt(f32x16& p0, f32x16& p1, const char* K_lds, int r32, int hi, const bf16x8* qr) {
    p0 = f32x16{}; p1 = f32x16{};
    const char* kb[4];
#pragma unroll
    for (int dd = 0; dd < 4; ++dd) kb[dd] = K_lds + KB * SHM_K + KSWZ(r32, (dd * 16 + hi * 8) * 2);
#pragma unroll
    for (int d0 = 0; d0 < 8; ++d0) { const char* a = kb[d0 & 3] + (d0 >> 2) * 128;
        bf16x8 b0 = *reinterpret_cast<const bf16x8*>(a);
        bf16x8 b1 = *reinterpret_cast<const bf16x8*>(a + 32 * 256);
        p0 = __builtin_amdgcn_mfma_f32_32x32x16_bf16(b0, qr[d0], p0, 0, 0, 0);
        p1 = __builtin_amdgcn_mfma_f32_32x32x16_bf16(b1, qr[d0], p1, 0, 0, 0); }
}
template <int VB>
__device__ __forceinline__ void pv_tile(f32x16* o, int vb0, bf16x8 pa0, bf16x8 pa1, bf16x8 pa2, bf16x8 pa3) {
#define TRRD(dst, off) asm volatile("ds_read_b64_tr_b16 %0, %1 offset:%2" : "=&v"(dst) : "v"(vb0), "i"(off) : "memory")
#define PV_D0(d0) do { s16x4 l0, l1, l2, l3, h0, h1, h2, h3; constexpr int b_ = VB * SHM_V + v_rd_off(d0, 0, 0); \
        TRRD(l0, b_); TRRD(h0, b_ + 2048); TRRD(l1, b_ + 4096); TRRD(h1, b_ + 6144); TRRD(l2, b_ + 8192); TRRD(h2, b_ + 10240); TRRD(l3, b_ + 12288); TRRD(h3, b_ + 14336); \
        asm volatile("s_waitcnt lgkmcnt(0)" ::: "memory"); SBAR();   \
        o[d0] = __builtin_amdgcn_mfma_f32_32x32x16_bf16(pa0, (bf16x8){l0[0], l0[1], l0[2], l0[3], h0[0], h0[1], h0[2], h0[3]}, o[d0], 0, 0, 0);   \
        o[d0] = __builtin_amdgcn_mfma_f32_32x32x16_bf16(pa1, (bf16x8){l1[0], l1[1], l1[2], l1[3], h1[0], h1[1], h1[2], h1[3]}, o[d0], 0, 0, 0);   \
        o[d0] = __builtin_amdgcn_mfma_f32_32x32x16_bf16(pa2, (bf16x8){l2[0], l2[1], l2[2], l2[3], h2[0], h2[1], h2[2], h2[3]}, o[d0], 0, 0, 0);   \
        o[d0] = __builtin_amdgcn_mfma_f32_32x32x16_bf16(pa3, (bf16x8){l3[0], l3[1], l3[2], l3[3], h3[0], h3[1], h3[2], h3[3]}, o[d0], 0, 0, 0); } while (0)
    PV_D0(0); PV_D0(1); PV_D0(2); PV_D0(3);
#undef PV_D0
#undef TRRD
}
__device__ __forceinline__ u64 causal_word(int n) { return n >= 64 ? ~0ull : (n <= 0 ? 0ull : ((1ull << n) - 1ull)); }
struct BlockRef { const bf16* Q; const bf16* K; const bf16* V; bf16* O; const u64* M; int P0; };
struct Seam { bf16x8 qr[8]; bf16x8 st_v0, st_v1, st_k0, st_k1; };
#define ROW(p, k0, rr) ((p) + (unsigned)(((k0) + (rr)) * KP + sc))
#define VMW() asm volatile("s_waitcnt vmcnt(0)" ::: "memory")
#define VMWN(n) asm volatile("s_waitcnt vmcnt(%0)" :: "i"(n) : "memory")
#define SLOAD_H(Kp, Vp, k0) do { S.st_v0 = load8(ROW(Vp, k0, sr)); S.st_v1 = load8(ROW(Vp, k0, 32 + sr));              \
                         S.st_k0 = load8(ROW(Kp, k0, sr)); S.st_k1 = load8(ROW(Kp, k0, 32 + sr)); } while (0)
#define SWRITE_HK(bf) do { *(bf16x8*)(K_lds + (bf) * SHM_K + kws) = S.st_k0; *(bf16x8*)(K_lds + (bf) * SHM_K + kws + 32 * 256) = S.st_k1; } while (0)
#define SWRITE_HV(bf) do { *(bf16x8*)(V_lds + (bf) * SHM_V + vst0) = S.st_v0; *(bf16x8*)(V_lds + (bf) * SHM_V + vst1) = S.st_v1; } while (0)
#define SWRITE_H(bf) do { SWRITE_HV(bf); SWRITE_HK(bf); } while (0)
__device__ __forceinline__ void attn_prime(const BlockRef& cur, char* lds, Seam& S, const int wv) {
    int tid = wv * 64 + hw_lane(); asm volatile("" : "+v"(tid));
    const int wid = __builtin_amdgcn_readfirstlane(tid >> 6), lane = tid & 63, r32 = lane & 31, hi = lane >> 5;
    const int sr = tid >> 4, sc = (tid & 15) * 8, kws = KSWZ(sr, sc * 2); char* K_lds = lds;
    for (int d0 = 0; d0 < 8; ++d0) S.qr[d0] = load8(cur.Q + (unsigned)((wid * QBLK + r32) * QP + d0 * 16 + hi * 8));
    SLOAD_H(cur.K, cur.V, 0); VMW(); SWRITE_HK(0);
    __syncthreads();
}
__device__ __forceinline__ void attn_block(const BlockRef& cur, const BlockRef& nxt, char* lds, Seam& S, const int wv) {
    int tid = wv * 64 + hw_lane(); asm volatile("" : "+v"(tid));
    const int wid = __builtin_amdgcn_readfirstlane(tid >> 6), lane = tid & 63, r32 = lane & 31, hi = lane >> 5;
    const int NT = (cur.P0 + QB - 1) / KVBLK + 1;
    char* K_lds = lds; char* V_lds = lds + 2 * SHM_K;
    float* ws = (float*)(lds + NV * SHM_V + 2 * SHM_K) + wid * 64; float* li_l = ws, * al_l = ws + 32;
    float m_reg = -1e30f, l_reg = 0; f32x16 o[4] = {};
    const int sr = tid >> 4, sc = (tid & 15) * 8, vst0 = v_st(sr, sc), vst1 = v_st(32 + sr, sc), kws = KSWZ(sr, sc * 2);
    int vb0 = (int)(uintptr_t)V_lds + v_rd_base(lane); asm volatile("" : "+v"(vb0));
    const bf16* Kh = cur.K; const bf16* Vh = cur.V;
    const u64* Mb = cur.M; unsigned mo = (unsigned)(cur.P0 + wid * QBLK + r32); asm volatile("" : "+v"(mo));
#if defined(DBG_CAUSAL_ONLY)
#define LOADMK(t) causal_word((int)mo - 64 * (t) + 1)
#else
#define LOADMK(t) Mb[mo + (unsigned)((t) * SEQ)]
#endif
#define RESC(a) do { if (__any((a) < 1.f)) { if (hi == 0) al_l[r32] = (a); asm volatile("s_waitcnt lgkmcnt(0)" ::: "memory");              \
                     for (int d_ = 0; d_ < 4; ++d_) for (int r = 0; r < 16; ++r) o[d_][r] *= al_l[crow(r, hi)]; } } while (0)
#define KBASE(t) ((t) * KVBLK)
#define SEAM_K0() do { VMWN(8); SWRITE_HK(0); SBAR(); } while (0)
    f32x16 pA0, pA1, pB0, pB1; float mnA, mnB, alA, alB; bf16x8 pa0, pa1, pa2, pa3; u64 mk;
    SWRITE_HV(0); SBAR();
    mk = LOADMK(0);
    if (NT > 1) { SLOAD_H(Kh, Vh, KBASE(1)); }
    SBAR(); qkt<0>(pA0, pA1, K_lds, r32, hi, S.qr); SBAR();
    VMW();
    mask_tile<true>(pA0, pA1, mk, hi); partialSM(pA0, pA1, m_reg, mnA, alA);
    if (NT > 1) { SWRITE_H(1); }
    __syncthreads();
#define HALF_STEP(PX0, PX1, mnX, alX, PY0, PY1, alY, t, KB, VB, SB) do {                                                     \
        mk = LOADMK(t);                                                                                           \
        SBAR(); qkt<KB>(PX0, PX1, K_lds, r32, hi, S.qr);                                                                      \
        finishSM(PY0, PY1, alY, l_reg, pa0, pa1, pa2, pa3); SBAR();                                                           \
        if ((t) + 1 < NT) { SLOAD_H(Kh, Vh, KBASE((t) + 1)); SBAR(); }                                                        \
        pv_tile<VB>(o, vb0, pa0, pa1, pa2, pa3);                                                                              \
        if ((t) + 1 < NT) VMWN(4); else VMW();                                                                                \
        mask_tile<false>(PX0, PX1, mk, hi); partialSM(PX0, PX1, m_reg, mnX, alX);                                                    \
        __syncthreads();                                                                                                      \
        if ((t) + 1 < NT) { VMW(); SWRITE_H(SB); }                                                                            \
        RESC(alX); __syncthreads(); } while (0)
#if ATT_ONE_BAR
#define HALF_STEP1(PX0, PX1, mnX, alX, PY0, PY1, alY, t, KB, VB, SB, SVB) do {                                               \
        mk = LOADMK(t);                                                                                           \
        SBAR(); qkt<KB>(PX0, PX1, K_lds, r32, hi, S.qr);                                                                      \
        finishSM(PY0, PY1, alY, l_reg, pa0, pa1, pa2, pa3); SBAR();                                                           \
        if ((t) + 1 < NT) { SLOAD_H(Kh, Vh, KBASE((t) + 1)); SBAR(); }                                                        \
        pv_tile<VB>(o, vb0, pa0, pa1, pa2, pa3);                                                                              \
        if ((t) + 1 < NT) VMWN(4); else VMW();                                                                                \
        mask_tile<false>(PX0, PX1, mk, hi); partialSM(PX0, PX1, m_reg, mnX, alX);                                                    \
        SBAR();                                                                                                               \
        if ((t) + 1 < NT) { VMW(); SWRITE_HK(SB); SWRITE_HV(SVB); }                                                           \
        RESC(alX); __syncthreads(); } while (0)
    for (int t = 1; t + 1 < NT; t += 6) {
        HALF_STEP1(pB0, pB1, mnB, alB, pA0, pA1, alA, t, 1, 0, 0, 2); HALF_STEP1(pA0, pA1, mnA, alA, pB0, pB1, alB, t + 1, 0, 1, 1, 0);
        if (t + 3 < NT) {
            HALF_STEP1(pB0, pB1, mnB, alB, pA0, pA1, alA, t + 2, 1, 2, 0, 1); HALF_STEP1(pA0, pA1, mnA, alA, pB0, pB1, alB, t + 3, 0, 0, 1, 2);
            if (t + 5 < NT) {
                HALF_STEP1(pB0, pB1, mnB, alB, pA0, pA1, alA, t + 4, 1, 1, 0, 0); HALF_STEP1(pA0, pA1, mnA, alA, pB0, pB1, alB, t + 5, 0, 2, 1, 1); } }
    }
    const int vtl = (2 * ((NT - 1) >> 1)) % 3;
#undef HALF_STEP1
    const int vbt = vb0 + vtl * SHM_V, vbt2 = vb0 + (vtl == 2 ? 0 : vtl + 1) * SHM_V;
#else
    for (int t = 1; t + 1 < NT; t += 2) {
        HALF_STEP(pB0, pB1, mnB, alB, pA0, pA1, alA, t, 1, 0, 0);
        HALF_STEP(pA0, pA1, mnA, alA, pB0, pB1, alB, t + 1, 0, 1, 1);
    }
    const int vbt = vb0, vbt2 = vb0 + SHM_V;
#endif
    const bool even = (NT & 1) == 0;
    if (even) { mk = LOADMK(NT - 1); SBAR(); qkt<1>(pB0, pB1, K_lds, r32, hi, S.qr); SBAR(); }
    SLOAD_H(nxt.K, nxt.V, 0); SBAR();
#pragma unroll
    for (int d0 = 0; d0 < 8; ++d0) S.qr[d0] = load8(nxt.Q + (unsigned)((mo - (unsigned)cur.P0) * QP + d0 * 16 + hi * 8));
    SBAR();
    finishSM(pA0, pA1, alA, l_reg, pa0, pa1, pa2, pa3); SBAR();
    pv_tile<0>(o, vbt, pa0, pa1, pa2, pa3);
    if (even) { VMWN(12); mask_tile<false>(pB0, pB1, mk, hi); partialSM(pB0, pB1, m_reg, mnB, alB); __syncthreads(); RESC(alB);
        finishSM(pB0, pB1, alB, l_reg, pa0, pa1, pa2, pa3); SBAR(); pv_tile<0>(o, vbt2, pa0, pa1, pa2, pa3); }
    SBAR(); SEAM_K0();
    if (hi == 0) li_l[r32] = l_reg; asm volatile("s_waitcnt lgkmcnt(0)" ::: "memory");
    float rli[16];
#pragma unroll
    for (int r = 0; r < 16; ++r) rli[r] = __builtin_amdgcn_rcpf(li_l[crow(r, hi)]);
    bf16* Ow = cur.O + (unsigned)((wid * QBLK) * QP);
#pragma unroll
    for (int r = 0; r < 16; ++r) { const int orow = crow(r, hi);
#pragma unroll
        for (int d0 = 0; d0 < 4; ++d0) { const float v = o[d0][r] * rli[r];
            const float vn = __builtin_bit_cast(float, __builtin_amdgcn_update_dpp(0, __builtin_bit_cast(int, v), 0xB1, 0xF, 0xF, true));
            if ((r32 & 1) == 0) *(unsigned*)(Ow + (unsigned)(orow * QP + d0 * 32 + r32)) = cvtpk(v, vn); } }
    __syncthreads();
#undef RESC
#undef KBASE
#undef SEAM_K0
#undef HALF_STEP
}
#undef ROW
#undef VMW
#undef VMWN
#undef SLOAD_H
#undef SWRITE_HK
#undef SWRITE_HV
#undef SWRITE_H
struct Item { int bh, qb0, qb1; };
__device__ __forceinline__ Item decode(int L) {
    constexpr int G = 4, nx = 8, per = G * nx; Item it;
    const int xcd = L & 7, k = L >> 3, gi = k / per, r = k - gi * per;
    it.bh = (gi * 8 + xcd) * G + r / nx; const int x = r % nx;
    it.qb0 = x; it.qb1 = 15 - x; return it;
}
struct Tensors { const bf16* Q; const bf16* K; const bf16* V; bf16* O; const u64* M; };
__device__ __forceinline__ BlockRef make_ref(const Item& it, int pass, const Tensors& T) {
    const int qb = pass ? it.qb1 : it.qb0, b = it.bh >> 4, h = it.bh & 15, kvh = h >> 2;
    BlockRef r;
    r.Q = T.Q + ((size_t)b * SEQ + (size_t)qb * QB) * QP + h * D; r.O = T.O + ((size_t)b * SEQ + (size_t)qb * QB) * QP + h * D;
    r.K = T.K + (size_t)b * SEQ * KP + kvh * D; r.V = T.V + (size_t)b * SEQ * KP + kvh * D; r.M = T.M + (size_t)b * 64 * SEQ; r.P0 = qb * QB;
    return r;
}
__device__ __forceinline__ void attn_phase(char* lds, const Tensors& T, int wg, int nwg, const int wv) {
    constexpr int total = 512;
    int L = wg; if (L >= total) return;
    Item it = decode(L); int pass = 0;
    BlockRef cur = make_ref(it, 0, T);
    Seam S;
    attn_prime(cur, lds, S, wv);
    for (;;) {
        const bool more_pass = pass == 0 && it.qb1 != it.qb0, more_item = L + nwg < total, last = !more_pass && !more_item;
        Item itn = it; int passn = pass + 1, Ln = L;
        if (!more_pass) { passn = 0; Ln = more_item ? L + nwg : L; itn = decode(Ln); }
        const BlockRef nxt = last ? cur : make_ref(itn, passn, T);
        attn_block(cur, nxt, lds, S, wv);
        if (last) break;
        cur = nxt; it = itn; pass = passn; L = Ln;
    }
}
#undef KSWZ
#undef SBAR
}
constexpr int NWAVES = 8;
#ifndef DBG_P0_TIME
#define DBG_P0_TIME 0
#endif
#define P0T_BEGIN(k) unsigned long long p0t##k = 0; if (DBG_P0_TIME == (k) && blockIdx.x == 0 && threadIdx.x == 0) p0t##k = __builtin_amdgcn_s_memrealtime()
#define P0T_END(k) do { if (DBG_P0_TIME == (k) && blockIdx.x == 0 && threadIdx.x == 0) { asm volatile("s_waitcnt vmcnt(0)" ::: "memory"); F.MISC[20] += (unsigned)(__builtin_amdgcn_s_memrealtime() - p0t##k); } } while (0)
#ifndef P0_NT
#define P0_NT 1
#endif
#if P0_NT
#define P0_LOAD(p) __builtin_nontemporal_load(p)
#else
#define P0_LOAD(p) (*(p))
#endif
#ifndef DBG_IDX_TID
#define DBG_IDX_TID 0
#endif
#ifndef DBG_IDX_TIME
#define DBG_IDX_TIME 0
#endif
#define IDXT_BEGIN(k) unsigned long long idxt_ = 0; if (DBG_IDX_TIME == (k) && blockIdx.x == 0 && threadIdx.x == DBG_IDX_TID) idxt_ = __builtin_amdgcn_s_memrealtime()
#define IDXT_END(k) do { if (DBG_IDX_TIME == (k) && blockIdx.x == 0 && threadIdx.x == DBG_IDX_TID) { const unsigned long long d_ = __builtin_amdgcn_s_memrealtime() - idxt_; F.MISC[20] += (unsigned)d_; } } while (0)
#ifndef C2_FP8
#define C2_FP8 0x8
#endif
#ifndef C1_FP8
#define C1_FP8 0x8
#endif
#ifndef M1_FP8
#define M1_FP8 0xC
#endif
#ifndef MLP_FP8
#define MLP_FP8 0xE
#endif
#ifndef DBG_TIME_PHASE
#define DBG_TIME_PHASE -1
#endif
#ifndef DBG_TIME_TO
#define DBG_TIME_TO (DBG_TIME_PHASE + 1)
#endif
#ifndef DBG_CLK_PHASE
#define DBG_CLK_PHASE -1
#endif
#define CLKSTAMP(k) do { if (DBG_CLK_PHASE >= 0 && (DBG_CLK_PHASE == (k) || DBG_CLK_PHASE + 1 == (k)) && blockIdx.x == 0 && threadIdx.x == 0) { const unsigned long long c_ = __builtin_readcyclecounter(), r_ = __builtin_amdgcn_s_memrealtime(); \
    volatile LAS unsigned* m_ = F.MISC + (DBG_CLK_PHASE == (k) ? 32 : 36); m_[0] = (unsigned)c_; m_[1] = (unsigned)(c_ >> 32); m_[2] = (unsigned)r_; m_[3] = (unsigned)(r_ >> 32); } } while (0)
#define STAMP(k) do { CLKSTAMP(k); if (DBG_TIME_PHASE >= 0 && (DBG_TIME_PHASE == (k) || DBG_TIME_TO == (k)) && blockIdx.x == 0 && threadIdx.x == 0) { const unsigned long long ts_ = __builtin_amdgcn_s_memrealtime(); volatile LAS unsigned* m_ = F.MISC + (DBG_TIME_PHASE == (k) ? 16 : 18); m_[0] = (unsigned)ts_; m_[1] = (unsigned)(ts_ >> 32); } } while (0)
#ifndef DBG_IDX_REP_SCORE
#define DBG_IDX_REP_SCORE 0
#endif
#ifndef DBG_IDX_REP_SEL
#define DBG_IDX_REP_SEL 0
#endif
#ifndef PG8_ALIGN_X
#define PG8_ALIGN_X true
#endif
#ifndef PG8_SP2_F8
#define PG8_SP2_F8 true
#endif
#ifndef PG8_SP2_X
#define PG8_SP2_X true
#endif
#ifndef DBG_A4_SRC
#define DBG_A4_SRC WS_O
#endif
#ifndef MK_PER_PHASE
#define MK_PER_PHASE 0
#endif
constexpr int BATCH = 4, SEQ = 4096, DM = 2048, M = BATCH * SEQ, DFF = 8192, DEPTH = 4;
constexpr int NA1 = 4352, NA1_SRC = 4176, NC1 = 6144;
constexpr int TOPK = 256;
constexpr size_t MiB = 1u << 20;
constexpr size_t WS_CTL = 0, CTL_ZERO_BYTES = 3 * MiB;
constexpr int CW_P0Q = 8192;
constexpr int CW_BAR = 4096;
constexpr size_t WS_SSQ = 1 * MiB;
constexpr size_t WS_ROPEM = 3 * MiB;
constexpr size_t WS_ROPEI = 5 * MiB;
constexpr size_t WS_SMALL = WS_ROPEI + 512 * 1024;
constexpr size_t WS_QG = WS_SMALL, WS_KG = WS_SMALL + 1024, WS_CONVW = WS_SMALL + 4096, WS_INPTR = WS_SMALL + 65536;
constexpr size_t WS_WA1 = 6 * MiB;  static_assert(WS_SSQ + 9 * (size_t)M * 8 <= CTL_ZERO_BYTES, "ssq inside memset");
constexpr size_t SZ_WA1 = (size_t)NA1 * DM * 2;
constexpr size_t WS_WA4 = WS_WA1 + 2 * SZ_WA1;
constexpr size_t SZ_WSQ = (size_t)DM * DM * 2;
constexpr size_t WS_WC1 = WS_WA4 + 2 * SZ_WSQ;
constexpr size_t SZ_WC1 = (size_t)NC1 * DM * 2;
constexpr size_t WS_WC2 = WS_WC1 + 2 * SZ_WC1;
constexpr size_t WS_WM1 = WS_WC2 + 2 * SZ_WSQ;
constexpr size_t SZ_WM = (size_t)DFF * DM * 2;
constexpr size_t WS_WM2 = WS_WM1 + 4 * SZ_WM;
constexpr size_t WS_XB = WS_WM2 + 4 * SZ_WM;
constexpr size_t WS_ACT = WS_XB + (size_t)M * DM * 2;
constexpr size_t SZ_MD = (size_t)M * DM * 2;
constexpr size_t WS_H = WS_ACT;
constexpr size_t WS_Q = WS_ACT, WS_O = WS_ACT + SZ_MD, WS_K = WS_ACT + 2 * SZ_MD, WS_V = WS_K + 16 * MiB, WS_QI = WS_V + 16 * MiB, WS_KI = WS_QI + 32 * MiB,
                 WS_WI = WS_KI + 2 * MiB, WS_MASK = WS_WI + 1 * MiB;
constexpr size_t WS_BG = WS_ACT, WS_Z = WS_ACT + SZ_MD, WS_G = WS_ACT + 2 * SZ_MD;
constexpr size_t WS_END = WS_ACT + 256 * MiB;
constexpr size_t WS_XB8 = WS_END;
static_assert(WS_MASK + 8 * MiB <= WS_END && WS_G + SZ_MD <= WS_END && WS_H + (size_t)M * DFF * 2 <= WS_END, "d_ws map");
constexpr int RING_OFF = 0, RING_BYTES = 131072;
constexpr int AUX_OFF = RING_BYTES, AUX_BYTES = 16384 + 2048 + 512;
constexpr int MISC_OFF = AUX_OFF + AUX_BYTES;
constexpr int WQ_OFF = MISC_OFF + 256;
constexpr int LDS_BYTES = WQ_OFF + 512;
static_assert(LDS_BYTES <= 160 * 1024 && MISC_OFF == 150016, "LDS map");

#define GAS __attribute__((address_space(1)))
#define LAS __attribute__((address_space(3)))
typedef unsigned short bf16;
typedef unsigned v4u __attribute__((ext_vector_type(4)));
typedef unsigned v2u __attribute__((ext_vector_type(2)));
typedef float f32x4 __attribute__((ext_vector_type(4)));
typedef short bf16x8 __attribute__((ext_vector_type(8)));
typedef float f32x16 __attribute__((ext_vector_type(16)));
typedef GAS unsigned gu32;
#define RLX_AGENT __ATOMIC_RELAXED, __HIP_MEMORY_SCOPE_AGENT
#define LDS_WAIT() asm volatile("s_waitcnt lgkmcnt(0)" ::: "memory")
#define VM_WAIT() asm volatile("s_waitcnt vmcnt(0)" ::: "memory")
__device__ __forceinline__ unsigned f2bf(float f) { unsigned u = __builtin_bit_cast(unsigned, f); return (u + 0x7fffu + ((u >> 16) & 1u)) >> 16; }
__device__ __forceinline__ unsigned pk2(float lo, float hi) { return f2bf(lo) | (f2bf(hi) << 16); }
__device__ __forceinline__ float bf2f(unsigned short b) { return __uint_as_float((unsigned)b << 16); }
__device__ __forceinline__ float wave_sum(float v) {
#pragma unroll
    for (int o = 1; o < 64; o <<= 1) v += __shfl_xor(v, o);
    return v;
}
__device__ __forceinline__ float wave_min(float v) {
#pragma unroll
    for (int o = 1; o < 64; o <<= 1) v = fminf(v, __shfl_xor(v, o));
    return v;
}
__device__ __forceinline__ float wave_max(float v) {
#pragma unroll
    for (int o = 1; o < 64; o <<= 1) v = fmaxf(v, __shfl_xor(v, o));
    return v;
}

#define XB_TMO      128
#define XB_XCNT(j)  (256  + 64 * (j))
#define XB_XSUB(j)  (1280 + 64 * (j))
#define XB_XGEN(j)  (2304 + 64 * (j))
#define XB_TOP      3328
#define XB_TOPGEN   3392
#define XCD_BAR_WORDS 3456
#define XB_SPIN_CAP (1u << 18)

__device__ __forceinline__ unsigned xb_ld(unsigned* p)              { return __hip_atomic_load(p, __ATOMIC_RELAXED, __HIP_MEMORY_SCOPE_AGENT); }
__device__ __forceinline__ unsigned xb_add(unsigned* p, unsigned v) { return __hip_atomic_fetch_add(p, v, __ATOMIC_RELAXED, __HIP_MEMORY_SCOPE_AGENT); }
__device__ __forceinline__ unsigned xb_xcc_id() { return (unsigned)__builtin_amdgcn_s_getreg((3 << 11) | 20) & 0xFu; }
#define XB_SPIN(cond, bar) do { unsigned _sp = 0; while (cond) { __builtin_amdgcn_s_sleep(1); \
    if ((++_sp & 255u) == 0u) { if (xb_ld(&(bar)[XB_TMO])) break; if (_sp > XB_SPIN_CAP) { atomicAdd(&(bar)[XB_TMO], 1u); break; } } } } while (0)

struct XcdBarrier {
    unsigned* bar; unsigned x; unsigned wv;
    volatile LAS unsigned* st;
};

__device__ __forceinline__ unsigned xb_lane() { return (unsigned)hw_lane(); }
__device__ __forceinline__ XcdBarrier xcd_barrier_post(unsigned* bar, volatile LAS unsigned* st, unsigned wave) {
    XcdBarrier b; b.bar = bar; b.x = xb_xcc_id(); b.st = st; b.wv = wave;
    if (wave == 0u && xb_lane() == 0u) (void)xb_add(&bar[XB_XCNT(b.x)], 1u);
    return b;
}
__device__ __forceinline__ void xcd_barrier_complete(unsigned* bar, unsigned x, unsigned& nloc, unsigned& nx) {
    const unsigned G = gridDim.x * gridDim.y * gridDim.z;
    unsigned sum, cnt, mine, sp = 0u;
    for (;;) {
        sum = 0u; cnt = 0u; mine = 0u;
#pragma unroll
        for (unsigned j = 0; j < 16; ++j) { const unsigned c = xb_ld(&bar[XB_XCNT(j)]); sum += c; cnt += (c > 0u) ? 1u : 0u; mine = (j == x) ? c : mine; }
        if (sum == G) break;
        __builtin_amdgcn_s_sleep(1);
        if ((++sp & 255u) == 0u) { if (xb_ld(&bar[XB_TMO])) break; if (sp > XB_SPIN_CAP) { atomicAdd(&bar[XB_TMO], 1u); break; } }
    }
    nloc = mine > 0u ? mine : 1u; nx = cnt > 0u ? cnt : 1u;
}

__device__ __forceinline__ void xcd_barrier(const XcdBarrier& b) {
    asm volatile("s_waitcnt vmcnt(0)" ::: "memory");
    __syncthreads();
    if (b.wv == 0u && xb_lane() == 0u) {
        unsigned* bar = b.bar;
        __builtin_amdgcn_s_waitcnt(0);
        unsigned nloc = b.st[0], nx = b.st[1];
        if (nloc == 0u) { xcd_barrier_complete(bar, b.x, nloc, nx); b.st[0] = nloc; b.st[1] = nx; }
        const unsigned old = xb_add(&bar[XB_XSUB(b.x)], 1u);
        const unsigned gen = old / nloc;
        if (old + 1u == (gen + 1u) * nloc) {
            __builtin_amdgcn_fence(__ATOMIC_RELEASE, "agent");
            asm volatile("s_waitcnt vmcnt(0)" ::: "memory");
            const unsigned og = xb_add(&bar[XB_TOP], 1u);
            const unsigned tg = og / nx;
            if (og + 1u == (tg + 1u) * nx) xb_add(&bar[XB_TOPGEN], 1u);
            else XB_SPIN(xb_ld(&bar[XB_TOPGEN]) == tg, bar);
            __builtin_amdgcn_fence(__ATOMIC_ACQUIRE, "agent");
            xb_add(&bar[XB_XGEN(b.x)], 1u);
            asm volatile("s_waitcnt vmcnt(0)" ::: "memory");
        } else {
            XB_SPIN(xb_ld(&bar[XB_XGEN(b.x)]) == gen, bar);
            __builtin_amdgcn_fence(__ATOMIC_ACQUIRE, "agent");
            asm volatile("s_waitcnt vmcnt(0)" ::: "memory");
        }
    }
    __syncthreads();
}

struct Frame {
    LAS unsigned char* lds;
    volatile LAS unsigned* MISC;
    gu32* ctl;
    int wave, vcu, G;
    unsigned char* ws;
    __device__ __forceinline__ int ln() const { return hw_lane(); }
    __device__ __forceinline__ int td() const { return wave * 64 + ln(); }
};

__device__ __forceinline__ int dmap64(int s) { if (s >= 32) return s; const int nn = s >> 4, fq = (s >> 2) & 3, j = s & 3; return fq < 2 ? 8 * nn + 4 * fq + j : 16 + 8 * nn + 4 * (fq - 2) + j; }
__device__ __forceinline__ int src_col(int kind, int n) {
    if (kind == 0) return n;
    const int pn = n >> 8, p = n & 255;
    if (kind == 1) {
        if (pn < 12) return n;
        if (pn < 16) return 3072 + (pn - 12) * 256 + (p >> 6) * 64 + dmap64(p & 63);
        if (p < 64) return 4096 + dmap64(p);
        if (p < 80) return 4160 + (p - 64);
        return -1;
    }
    if (pn < 8) return n;
    const int i = pn - 8; return p < 128 ? 2048 + 128 * i + p : 4096 + 128 * i + (p - 128);
}
struct P0Desc { const float* src; const float* g; bf16* dst; int Nsrc, K, fp8, hasg; };
__device__ __forceinline__ void p0_desc(const float* W, const float* g, int K, int Nsrc, int Npad, int kind, bf16* WT, int item, int lane, P0Desc& d, int fp8 = 0) {
    const int nblk = Npad / 32, kb = item / nblk, nb = item % nblk, kg = lane >> 3, ng = lane & 7, k0 = 64 * kb + 8 * kg, n0 = 32 * nb + 4 * ng;
    const int col = src_col(kind, n0);
    d.src = col >= 0 ? W + (size_t)k0 * Nsrc + col : nullptr; d.g = g ? g + k0 : nullptr; d.dst = fp8 ? (bf16*)((unsigned char*)WT + (size_t)n0 * K + k0) : WT + (size_t)n0 * K + k0; d.Nsrc = Nsrc; d.K = K; d.fp8 = fp8; d.hasg = g != nullptr;
}
__device__ __forceinline__ void p0_load(const P0Desc& d, f32x4 (&v)[8], f32x4& ga, f32x4& gb) {
#pragma unroll
    for (int i = 0; i < 8; ++i) v[i] = d.src ? P0_LOAD((const f32x4*)(d.src + (size_t)i * d.Nsrc)) : (f32x4){0.f, 0.f, 0.f, 0.f};
    if (d.g) { ga = *(const f32x4*)d.g; gb = *(const f32x4*)(d.g + 4); } else { ga = (f32x4){1.f, 1.f, 1.f, 1.f}; gb = ga; }
}
#ifndef P0_HWPK
#define P0_HWPK 1
#endif
#if P0_HWPK
#define P0_PK(a, b) pg8::cvt_pk_bf16(a, b)
#else
#define P0_PK(a, b) pk2(a, b)
#endif
__device__ __forceinline__ void p0_load_nn(const P0Desc& d, f32x4 (&v)[8], f32x4& ga, f32x4& gb) {
    const GAS float* sp = (const GAS float*)d.src;
#pragma unroll
    for (int i = 0; i < 8; ++i) v[i] = P0_LOAD((const GAS f32x4*)(sp + (size_t)i * d.Nsrc));
    if (d.hasg) { const GAS float* gp = (const GAS float*)d.g; ga = *(const GAS f32x4*)gp; gb = *(const GAS f32x4*)(gp + 4); } else { ga = (f32x4){1.f, 1.f, 1.f, 1.f}; gb = ga; }
}
template <bool NT = false> __device__ __forceinline__ void p0_store(const P0Desc& d, const f32x4 (&v)[8], const f32x4& ga, const f32x4& gb) {
    if (d.fp8) {
        const float s = d.fp8 == 2 ? pg8::FP8_SWC : pg8::FP8_SW; float gs[8];
#pragma unroll
        for (int i = 0; i < 8; ++i) gs[i] = (i < 4 ? ga[i & 3] : gb[i & 3]) * s;
#pragma unroll
        for (int q = 0; q < 4; ++q) { int w0 = 0, w1 = 0;
            float e[8];
#pragma unroll
            for (int i = 0; i < 8; ++i) e[i] = __builtin_amdgcn_fmed3f(v[i][q] * gs[i], -448.f, 448.f);
            w0 = __builtin_amdgcn_cvt_pk_fp8_f32(e[0], e[1], w0, false); w0 = __builtin_amdgcn_cvt_pk_fp8_f32(e[2], e[3], w0, true);
            w1 = __builtin_amdgcn_cvt_pk_fp8_f32(e[4], e[5], w1, false); w1 = __builtin_amdgcn_cvt_pk_fp8_f32(e[6], e[7], w1, true);
            v2u o; o.x = (unsigned)w0; o.y = (unsigned)w1; if (NT) __builtin_nontemporal_store(o, (GAS v2u*)((unsigned char*)d.dst + (size_t)q * d.K)); else *(GAS v2u*)((unsigned char*)d.dst + (size_t)q * d.K) = o; }
        return; }
    if (!d.hasg) {
#pragma unroll
        for (int q = 0; q < 4; ++q) { v4u o; o.x = P0_PK(v[0][q], v[1][q]); o.y = P0_PK(v[2][q], v[3][q]); o.z = P0_PK(v[4][q], v[5][q]); o.w = P0_PK(v[6][q], v[7][q]);
            if (NT) __builtin_nontemporal_store(o, (GAS v4u*)(d.dst + (size_t)q * d.K)); else *(GAS v4u*)(d.dst + (size_t)q * d.K) = o; }
        return; }
#pragma unroll
    for (int q = 0; q < 4; ++q) { v4u o; o.x = P0_PK(v[0][q] * ga[0], v[1][q] * ga[1]); o.y = P0_PK(v[2][q] * ga[2], v[3][q] * ga[3]); o.z = P0_PK(v[4][q] * gb[0], v[5][q] * gb[1]); o.w = P0_PK(v[6][q] * gb[2], v[7][q] * gb[3]);
        if (NT) __builtin_nontemporal_store(o, (GAS v4u*)(d.dst + (size_t)q * d.K)); else *(GAS v4u*)(d.dst + (size_t)q * d.K) = o; }
}
struct Inputs { const float* x; const int* pos; const float *attn_norm_g, *attn_w_in, *attn_q_g, *attn_k_g, *attn_w_out, *conv_norm_g, *conv_w_in, *conv_w, *conv_w_out, *mlp_norm_g, *mlp_w1, *mlp_w2; };
constexpr int I_A1 = (DM / 64) * (NA1 / 32), I_SQ = (DM / 64) * (DM / 32), I_C1 = (DM / 64) * (NC1 / 32), I_M1 = (DM / 64) * (DFF / 32), I_M2 = (DFF / 64) * (DM / 32);
constexpr int PER_J = I_A1 + I_SQ + I_C1 + I_SQ, PER_I = I_M1 + I_M2, NITEMS = 2 * PER_J + 4 * PER_I;
__device__ __forceinline__ void p0_item_desc(Frame& F, const Inputs& I, int it, P0Desc& d, int lane_ = -1) {
    int r = it; const int ln_ = lane_ >= 0 ? lane_ : F.ln();
    if (r < 2 * PER_J) { const int j = r / PER_J; r -= j * PER_J;
        if (r < I_A1) { p0_desc(I.attn_w_in + (size_t)j * DM * NA1_SRC, I.attn_norm_g + j * DM, DM, NA1_SRC, NA1, 1, (bf16*)(F.ws + WS_WA1 + j * SZ_WA1), r, ln_, d); return; } r -= I_A1;
        if (r < I_SQ) { p0_desc(I.attn_w_out + (size_t)j * DM * DM, nullptr, DM, DM, DM, 0, (bf16*)(F.ws + WS_WA4 + j * SZ_WSQ), r, ln_, d); return; } r -= I_SQ;
        if (r < I_C1) { p0_desc(I.conv_w_in + (size_t)j * DM * NC1, I.conv_norm_g + j * DM, DM, NC1, NC1, 2, (bf16*)(F.ws + WS_WC1 + j * SZ_WC1), r, ln_, d, ((C1_FP8 >> (2 * j + 1)) & 1) ? 2 : 0); return; } r -= I_C1;
        p0_desc(I.conv_w_out + (size_t)j * DM * DM, nullptr, DM, DM, DM, 0, (bf16*)(F.ws + WS_WC2 + j * SZ_WSQ), r, ln_, d, ((C2_FP8 >> (2 * j + 1)) & 1) ? 2 : 0); return; }
    r -= 2 * PER_J; const int i = r / PER_I; r -= i * PER_I;
    if (r < I_M1) { p0_desc(I.mlp_w1 + (size_t)i * DM * DFF, I.mlp_norm_g + i * DM, DM, DFF, DFF, 0, (bf16*)(F.ws + WS_WM1 + i * SZ_WM), r, ln_, d, ((M1_FP8 >> i) & 1) ? 2 : 0); return; } r -= I_M1;
    p0_desc(I.mlp_w2 + (size_t)i * DFF * DM, nullptr, DFF, DM, DM, 0, (bf16*)(F.ws + WS_WM2 + i * SZ_WM), r, ln_, d, (MLP_FP8 >> i) & 1);
}
struct ItemRanges { int lo[4], hi[4]; };
__device__ __forceinline__ int range_item(const ItemRanges& R, int c) {
#pragma unroll
    for (int k = 0; k < 4; ++k) { const int len = R.hi[k] - R.lo[k]; if (c < len) return R.lo[k] + c; c -= len; }
    return -1;
}
__device__ __forceinline__ void convert_ranges(Frame& F, const Inputs& I, const ItemRanges& R, int gw, int nw) {
    const int total = (R.hi[0] - R.lo[0]) + (R.hi[1] - R.lo[1]) + (R.hi[2] - R.lo[2]) + (R.hi[3] - R.lo[3]);
    f32x4 va[8], vb[8], gaa, gab, gba, gbb; P0Desc da, db;
    int c = gw; bool ha = c < total;
    if (ha) { p0_item_desc(F, I, range_item(R, c), da); p0_load(da, va, gaa, gab); }
    while (ha) {
        const int cn = c + nw; const bool hb = cn < total;
        if (hb) { p0_item_desc(F, I, range_item(R, cn), db); p0_load(db, vb, gba, gbb); }
        p0_store(da, va, gaa, gab);
        c = cn; ha = hb; da = db; gaa = gba; gab = gbb;
#pragma unroll
        for (int i = 0; i < 8; ++i) va[i] = vb[i];
    }
}
#ifndef DEFER_CONV
#define DEFER_CONV 2
#endif
#ifndef A2_NT_STORE
#define A2_NT_STORE 0
#endif
#ifndef A2_STORE_MID
#define A2_STORE_MID 0
#endif
#ifndef A2_NOASSERT
#define A2_NOASSERT 0
#endif
#ifndef A2_NCV
#define A2_NCV 2
#endif
#ifndef A2_SPLIT
#define A2_SPLIT 4096
#endif
__device__ __forceinline__ const float* in_ptr(const unsigned char* ws, const int field) {
    unsigned long long p_; asm volatile("s_load_dwordx2 %0, %1, %2\n\ts_waitcnt lgkmcnt(0)" : "=s"(p_) : "s"(ws + WS_INPTR), "n"(field * 8) : "memory"); return (const float*)p_; }
__device__ __forceinline__ void a2_item_desc(Frame& F, int j, int c, int lane, P0Desc& d) {
    if (c < I_SQ) { p0_desc(in_ptr(F.ws, 6) + (size_t)j * DM * DM, nullptr, DM, DM, DM, 0, (bf16*)(F.ws + WS_WA4 + j * SZ_WSQ), c, lane, d); return; }
    c -= I_SQ; int i = 2 * j;
    if (c >= PER_I) { c += A2_SPLIT - PER_I; i += 1; }
    if (c < I_M1) { p0_desc(in_ptr(F.ws, 12) + (size_t)i * DM * DFF, in_ptr(F.ws, 11) + i * DM, DM, DFF, DFF, 0, (bf16*)(F.ws + WS_WM1 + (size_t)i * SZ_WM), c, lane, d, ((M1_FP8 >> i) & 1) ? 2 : 0); return; }
    c -= I_M1;
    p0_desc(in_ptr(F.ws, 13) + (size_t)i * DFF * DM, nullptr, DFF, DM, DM, 0, (bf16*)(F.ws + WS_WM2 + (size_t)i * SZ_WM), c, lane, d, (MLP_FP8 >> i) & 1);
}
__device__ __forceinline__ ItemRanges ranges_a2(int j) {
    return ItemRanges{{j * PER_J + I_A1, 2 * PER_J + 2 * j * PER_I, 2 * PER_J + (2 * j + 1) * PER_I + A2_SPLIT, 0}, {j * PER_J + I_A1 + I_SQ, 2 * PER_J + (2 * j + 1) * PER_I, 2 * PER_J + (2 * j + 2) * PER_I, 0}}; }
constexpr int A2_ITEMS = I_SQ + PER_I + (PER_I - A2_SPLIT);
__device__ __forceinline__ ItemRanges ranges_p0() { if (DEFER_CONV == 2) return ItemRanges{{0, PER_J, 0, 0}, {I_A1, PER_J + I_A1, 0, 0}};
    if (DEFER_CONV) return ItemRanges{{0, PER_J, 2 * PER_J, 2 * PER_J + 2 * PER_I}, {I_A1 + I_SQ, PER_J + I_A1 + I_SQ, 2 * PER_J + PER_I, 2 * PER_J + 3 * PER_I}}; return ItemRanges{{0, 0, 0, 0}, {NITEMS, 0, 0, 0}}; }
__device__ __forceinline__ ItemRanges ranges_deferred(int j) {
    if (DEFER_CONV == 2) return ItemRanges{{j * PER_J + I_A1 + I_SQ, 2 * PER_J + (2 * j + 1) * PER_I, 0, 0}, {(j + 1) * PER_J, 2 * PER_J + (2 * j + 1) * PER_I + A2_SPLIT, 0, 0}};
    return ItemRanges{{j * PER_J + I_A1 + I_SQ, 2 * PER_J + (2 * j + 1) * PER_I, 0, 0}, {(j + 1) * PER_J, 2 * PER_J + (2 * j + 2) * PER_I, 0, 0}}; }
__device__ __forceinline__ void p0_prologue(Frame& F, const Inputs& I, float* out) {
    const int gw = F.vcu * NWAVES + F.wave, NGW = F.G * NWAVES;
    if (blockIdx.x == 0 && F.td() == 0) {
        Inputs* d_ = (Inputs*)(F.ws + WS_INPTR);
        d_->x = I.x; d_->pos = I.pos; d_->attn_norm_g = I.attn_norm_g; d_->attn_w_in = I.attn_w_in; d_->attn_q_g = I.attn_q_g; d_->attn_k_g = I.attn_k_g; d_->attn_w_out = I.attn_w_out;
        d_->conv_norm_g = I.conv_norm_g; d_->conv_w_in = I.conv_w_in; d_->conv_w = I.conv_w; d_->conv_w_out = I.conv_w_out; d_->mlp_norm_g = I.mlp_norm_g; d_->mlp_w1 = I.mlp_w1; d_->mlp_w2 = I.mlp_w2; }
    P0T_BEGIN(2);
    bf16* xb = (bf16*)(F.ws + WS_XB); pg8::ssq_t* ssq0 = (pg8::ssq_t*)(F.ws + WS_SSQ);
    {
        f32x4 va[8], vb[8]; int m = gw; bool ha = m < M;
        if (ha) { const GAS f32x4* xr = (const GAS f32x4*)(I.x + (size_t)m * DM) + F.ln();
#pragma unroll
            for (int j = 0; j < 8; ++j) va[j] = __builtin_nontemporal_load(xr + 64 * j); }
        while (ha) {
            const int mn = m + NGW; const bool hb = mn < M;
            if (hb) { const GAS f32x4* xr = (const GAS f32x4*)(I.x + (size_t)mn * DM) + F.ln();
#pragma unroll
                for (int j = 0; j < 8; ++j) vb[j] = __builtin_nontemporal_load(xr + 64 * j); }
            GAS unsigned long long* o8 = (GAS unsigned long long*)(xb + (size_t)m * DM) + F.ln(); float s = 0.f;
#pragma unroll
            for (int j = 0; j < 8; ++j) { const f32x4 v = va[j]; s += (v.x * v.x + v.y * v.y) + (v.z * v.z + v.w * v.w);
                o8[64 * j] = (unsigned long long)pk2(v.x, v.y) | ((unsigned long long)pk2(v.z, v.w) << 32); }
            s = wave_sum(s); if (F.ln() == 0) ssq0[m] = pg8::ssq_fix(s);
            m = mn; ha = hb;
#pragma unroll
            for (int j = 0; j < 8; ++j) va[j] = vb[j];
        }
    }
    P0T_END(2); P0T_BEGIN(3);
    unsigned* ropeM = (unsigned*)(F.ws + WS_ROPEM); unsigned* ropeI = (unsigned*)(F.ws + WS_ROPEI);
    for (int e = F.vcu * 512 + F.td(); e < M * 24; e += F.G * 512) {
        const int row = e / 24, d = e % 24; const float p = (float)I.pos[row];
        const float ex = d < 16 ? -(float)d * (1.0f / 16.0f) : -(float)(d - 16) * (1.0f / 8.0f);
        const float inv = __builtin_amdgcn_exp2f(ex * 18.931568569324174f);
        const float ang = p * inv;
        double rev = (double)ang * 0.15915494309189535; rev -= __builtin_floor(rev); const float rf = (float)rev;
        const float c = __builtin_amdgcn_cosf(rf), s = __builtin_amdgcn_sinf(rf);
        const unsigned pk = (unsigned)__builtin_bit_cast(unsigned short, (_Float16)c) | ((unsigned)__builtin_bit_cast(unsigned short, (_Float16)s) << 16);
        if (d < 16) ropeM[(size_t)row * 16 + d] = pk; else ropeI[(size_t)row * 8 + (d - 16)] = pk;
    }
    { float* qg = (float*)(F.ws + WS_QG); float* kg = (float*)(F.ws + WS_KG); float* cw = (float*)(F.ws + WS_CONVW);
      for (int e = F.vcu * 512 + F.td(); e < 2 * 3 * DM; e += F.G * 512) { cw[e] = I.conv_w[e]; if (e < 256) { qg[e] = I.attn_q_g[e]; kg[e] = I.attn_k_g[e]; } } }
    P0T_END(3); P0T_BEGIN(1);
    convert_ranges(F, I, ranges_p0(), gw, NGW);
    P0T_END(1);
    (void)out;
}

__device__ __forceinline__ float relu_i(float x) { const int i = __float_as_int(x); return __int_as_float(i > 0 ? i : 0); }
struct IdxTensors { const bf16* QI; const bf16* KI; const float* WI; unsigned long long* MASK; float* dbg; };
#define DBG_OUT T.dbg
__device__ __forceinline__ void idx_phase(Frame& F, const IdxTensors& T, const int cj) {
    static_assert(DEFER_CONV != 2 || A2_NOASSERT || A2_ITEMS <= A2_NCV * 2048 * NWAVES, "the indexer's conversion slots do not cover its items");
    typedef float f32x2 __attribute__((ext_vector_type(2)));
    LAS float* scores = (LAS float*)(F.lds + RING_OFF);
    LAS unsigned* hist = (LAS unsigned*)(F.lds + AUX_OFF) + F.wave * 512;
    LAS float* cand = (LAS float*)(F.lds + AUX_OFF + 16384) + F.wave * 64;
    LAS float* mm = (LAS float*)(F.lds + AUX_OFF + 16384 + 2048);
    int tid_ = F.td(); asm volatile("" : "+v"(tid_));
    const int lane = tid_ & 63, w = F.wave, c32 = lane & 31, hi = lane >> 5;
    const float INF = __builtin_inff();
    const int qsel = (c32 >> 2) & 1, hh = (c32 & 3) + 4 * (c32 >> 3);
    bf16x8 afr[4][4]; bf16x8 bcur[4];
#define IDX_DECODE(uu_, b_, t0_) const int idx_ = (uu_) & 255, rr_ = (uu_) >> 8; b_ = rr_ >> 1; t0_ = ((rr_ & 1) ? 511 - idx_ : idx_) * 8
    const int qrow_w = 16 * w + (lane >> 2), qch = 2 * (lane & 3);
    LAS unsigned char* const qlds = F.lds + AUX_OFF;
#define QI_FETCH(b_, t0_) do { const bf16* qp_ = T.QI + ((size_t)((b_) * SEQ + (t0_) + w) * 1024 + lane * 16); qpre0 = *(const bf16x8*)qp_; qpre1 = *(const bf16x8*)(qp_ + 8); } while (0)
#define QI_PARK() do { *(LAS bf16x8*)(qlds + qrow_w * 128 + (((qch) ^ (qrow_w & 7)) << 4)) = qpre0; *(LAS bf16x8*)(qlds + qrow_w * 128 + (((qch + 1) ^ (qrow_w & 7)) << 4)) = qpre1; } while (0)
#define QI_READ() do { _Pragma("unroll") for (int p = 0; p < 4; ++p) _Pragma("unroll") for (int kk = 0; kk < 4; ++kk) { const int r_ = (qsel + 2 * p) * 16 + hh; \
            afr[p][kk] = *(const LAS bf16x8*)(qlds + r_ * 128 + (((hi + 2 * kk) ^ (r_ & 7)) << 4)); } } while (0)
#define IDX_LOAD(b_, t0_) do { \
        const int nt_ = ((t0_) + 7) / 32 + 1; const int j0_ = w < nt_ ? w : 0; \
        const bf16* kb_ = T.KI + (size_t)(b_) * SEQ * 64 + (size_t)c32 * 64 + 8 * hi + (size_t)j0_ * 32 * 64; \
        _Pragma("unroll") for (int kk = 0; kk < 4; ++kk) bcur[kk] = *(const bf16x8*)(kb_ + 16 * kk); } while (0)
    int uu = blockIdx.x; int b = 0, t0 = 0;
    if (uu < 2048) { IDX_DECODE(uu, b, t0); if (tid_ < 128) ((LAS float*)(F.lds + WQ_OFF))[tid_] = T.WI[(size_t)(b * SEQ + t0) * 16 + tid_]; bf16x8 qpre0, qpre1; QI_FETCH(b, t0); IDX_LOAD(b, t0); QI_PARK(); }
    LDS_WAIT(); __syncthreads();
    for (; uu < 2048; uu += F.G) {
        { IDXT_BEGIN(1);
        for (int srep = 0; srep < 1 + DBG_IDX_REP_SCORE; ++srep) {
            QI_READ();
            f32x2 wq[4][8];
            { const LAS float* wrow = (const LAS float*)(F.lds + WQ_OFF) + hi * 16;
#pragma unroll
              for (int p = 0; p < 4; ++p)
#pragma unroll
                  for (int i = 0; i < 4; ++i) { const f32x4 t4 = *(const LAS f32x4*)(wrow + p * 32 + 4 * i); wq[p][2 * i] = (f32x2){t4[0], t4[1]}; wq[p][2 * i + 1] = (f32x2){t4[2], t4[3]}; } }
            const int ntile = (t0 + 7) / 32 + 1;
            const bf16* kbase = T.KI + (size_t)b * SEQ * 64 + (size_t)c32 * 64 + 8 * hi;
            LAS float* srow = scores + hi * 4096 + c32;
            float vmax[4], vmin[4];
#pragma unroll
            for (int p = 0; p < 4; ++p) { vmax[p] = -INF; vmin[p] = INF; }
            bf16x8 bnxt[4];
            for (int jt = w; jt < ntile; jt += 8) {
                const int jn = jt + 8 < ntile ? jt + 8 : jt;
#pragma unroll
                for (int kk = 0; kk < 4; ++kk) bnxt[kk] = *(const bf16x8*)(kbase + (size_t)jn * 32 * 64 + 16 * kk);
                const int krel = jt * 32 + c32 - t0 - hi;
#pragma unroll
                for (int ph = 0; ph < 2; ++ph) {
                    f32x16 acc0 = {}, acc1 = {};
#pragma unroll
                    for (int kk = 0; kk < 4; ++kk) { acc0 = __builtin_amdgcn_mfma_f32_32x32x16_bf16(afr[2 * ph][kk], bcur[kk], acc0, 0, 0, 0);
                                                     acc1 = __builtin_amdgcn_mfma_f32_32x32x16_bf16(afr[2 * ph + 1][kk], bcur[kk], acc1, 0, 0, 0); }
#pragma unroll
                    for (int q = 0; q < 2; ++q) { const int p = 2 * ph + q; const f32x16& acc = q ? acc1 : acc0;
                        f32x2 s2 = {0.f, 0.f};
#pragma unroll
                        for (int r = 0; r < 8; ++r) { f32x2 a2 = {relu_i(acc[2 * r]), relu_i(acc[2 * r + 1])}; s2 = __builtin_elementwise_fma(wq[p][r], a2, s2); }
                        const bool valid = krel <= 2 * p;
                        const float s = valid ? s2[0] + s2[1] : -INF;
                        vmax[p] = fmaxf(vmax[p], s); vmin[p] = fminf(vmin[p], valid ? s : INF);
                        srow[p * 2 * 4096 + jt * 32] = s; }
                }
#pragma unroll
                for (int kk = 0; kk < 4; ++kk) bcur[kk] = bnxt[kk];
            }
#pragma unroll
            for (int o = 1; o < 32; o <<= 1)
#pragma unroll
                for (int p = 0; p < 4; ++p) { vmax[p] = fmaxf(vmax[p], __shfl_xor(vmax[p], o)); vmin[p] = fminf(vmin[p], __shfl_xor(vmin[p], o)); }
            if (c32 == 0) {
#pragma unroll
                for (int p = 0; p < 4; ++p) { mm[(w * 8 + 2 * p + hi) * 2] = vmin[p]; mm[(w * 8 + 2 * p + hi) * 2 + 1] = vmax[p]; } }
        }
        IDXT_END(1); }
        const int b_cur = b, t0_cur = t0;
        float wpre = 0.f; const bool has_next = uu + F.G < 2048; bf16x8 qpre0 = {}, qpre1 = {};
        if (has_next) { IDX_DECODE(uu + F.G, b, t0); if (tid_ < 128) wpre = T.WI[(size_t)(b * SEQ + t0) * 16 + tid_]; QI_FETCH(b, t0); IDX_LOAD(b, t0); }
        IDXT_BEGIN(5);
        P0Desc cd[A2_NCV] = {}; f32x4 cv[A2_NCV][8] = {}, cga[A2_NCV] = {}, cgb[A2_NCV] = {}; bool ch[A2_NCV];
#pragma unroll
        for (int k = 0; k < A2_NCV; ++k) { const int c = uu * NWAVES + w + k * 2048 * NWAVES; ch[k] = DEFER_CONV == 2 && c < A2_ITEMS;
            if (ch[k]) { int ln = lane; asm volatile("" : "+v"(ln)); a2_item_desc(F, cj, c, ln, cd[k]); p0_load_nn(cd[k], cv[k], cga[k], cgb[k]); } }
        IDXT_END(5);
        { IDXT_BEGIN(3); LDS_WAIT(); __builtin_amdgcn_s_barrier(); asm volatile("" ::: "memory"); IDXT_END(3); }
        bool cdone = false;
#define CONV_STORE() do { if (!cdone) { _Pragma("unroll") for (int k_ = 0; k_ < A2_NCV; ++k_) if (ch[k_]) p0_store<A2_NT_STORE != 0>(cd[k_], cv[k_], cga[k_], cgb[k_]); cdone = true; } } while (0)
        { IDXT_BEGIN(2);
        for (int lrep = 0; lrep < 1 + DBG_IDX_REP_SEL; ++lrep) {
            const int t = t0_cur + w, n = t + 1;
            const LAS float* sc = scores + w * 4096;
            const int nch = (n + 63) >> 6;
            unsigned long long myword = 0ull;
            if (n <= TOPK) {
#pragma unroll 4
                for (int j = 0; j < nch; ++j) { const int i = 64 * j + lane; const unsigned long long mk = __ballot(i < n); if (lane == j) myword = mk; }
            } else {
                float lo = INF, hv = -INF;
#pragma unroll
                for (int k = 0; k < 8; ++k) { lo = fminf(lo, mm[(k * 8 + w) * 2]); hv = fmaxf(hv, mm[(k * 8 + w) * 2 + 1]); }
                int need = TOPK; bool done = false;
                for (int level = 0; level < 6 && !done; ++level) {
                    if (!(hv > lo)) break;
                    const float scale = fminf(511.9f / (hv - lo), 3.0e37f), off = -lo * scale;
#pragma unroll
                    for (int k = 0; k < 8; ++k) hist[k * 64 + lane] = 0u;
                    LDS_WAIT();
                    for (int j0 = 0; j0 < nch; j0 += 8) {
                        float vb[8];
#pragma unroll
                        for (int k = 0; k < 8; ++k) vb[k] = sc[64 * ((j0 + k) & 63) + lane];
#pragma unroll
                        for (int k = 0; k < 8; ++k) { const int i = 64 * (j0 + k) + lane; const float v = vb[k];
                            if (i < n && v >= lo && v <= hv) { int bin = (int)fmaf(v, scale, off); bin = bin > 511 ? 511 : bin; __hip_atomic_fetch_add(hist + bin, 1u, __ATOMIC_RELAXED, __HIP_MEMORY_SCOPE_WORKGROUP); } } }
                    if (A2_STORE_MID) CONV_STORE();
                    LDS_WAIT();
                    unsigned h[8]; unsigned ssum = 0;
                    { const v4u a = *(const LAS v4u*)(hist + 8 * lane), bq = *(const LAS v4u*)(hist + 8 * lane + 4); h[0] = a.x; h[1] = a.y; h[2] = a.z; h[3] = a.w; h[4] = bq.x; h[5] = bq.y; h[6] = bq.z; h[7] = bq.w; }
#pragma unroll
                    for (int k = 0; k < 8; ++k) ssum += h[k];
                    unsigned S = ssum;
#pragma unroll
                    for (int o = 1; o < 64; o <<= 1) { const unsigned tt = __shfl_down(S, o); if (lane + o < 64) S += tt; }
                    const unsigned long long bal = __ballot(S >= (unsigned)need);
                    const int L = __popcll(bal) - 1;
                    const int Lc = L < 0 ? 0 : L;
                    unsigned cum = (Lc < 63) ? (unsigned)__shfl(S, Lc + 1) : 0u; if (Lc >= 63) cum = 0u;
                    int bstar = 8 * Lc; unsigned cstar = 0, abv = cum; bool found = false;
#pragma unroll
                    for (int k = 7; k >= 0; --k) { const unsigned hk = (unsigned)__shfl(h[k], Lc);
                        if (!found && cum + hk >= (unsigned)need) { bstar = 8 * Lc + k; cstar = hk; abv = cum; found = true; }
                        cum += hk; }
                    need -= (int)abv;
                    float nlo = INF, nhv = -INF; int base = 0; const bool few = cstar <= 64u;
                    for (int j0 = 0; j0 < nch; j0 += 8) {
                        float vb[8];
#pragma unroll
                        for (int k = 0; k < 8; ++k) vb[k] = sc[64 * ((j0 + k) & 63) + lane];
#pragma unroll
                        for (int k = 0; k < 8; ++k) { const int j = j0 + k, i = 64 * j + lane; const float v = vb[k]; const bool valid = i < n;
                            int bin = (int)fmaf(v, scale, off); bin = bin > 511 ? 511 : bin;
                            const bool member = valid && v >= lo && v <= hv, inb = member && bin == bstar, sure = valid && (v > hv || (member && bin > bstar));
                            const unsigned long long ms = __ballot(sure); if (lane == j) myword = ms;
                            if (inb) { nlo = fminf(nlo, v); nhv = fmaxf(nhv, v); }
                            if (few) { const unsigned long long mk = __ballot(inb);
                                if (inb) { const int pos = base + __popcll(mk & ((1ull << lane) - 1ull)); if (pos < 64) { cand[pos] = v; ((LAS int*)hist)[pos] = i; } }
                                base += __popcll(mk); } } }
                    if (few) {
                        LDS_WAIT();
                        const int nc = base < 64 ? base : 64;
                        const float myv = lane < nc ? cand[lane] : -INF; const int myi = lane < nc ? ((const LAS int*)hist)[lane] : 0; int cnt = 0;
                        for (int i = 0; i < nc; ++i) cnt += (__shfl(myv, i) > myv) ? 1 : 0;
                        unsigned long long msel = __ballot(lane < nc && cnt < need);
                        while (msel) { const int src = __builtin_ctzll(msel); msel &= msel - 1ull; const int ki = __shfl(myi, src);
                            if (lane == (ki >> 6)) myword |= 1ull << (ki & 63); }
                        done = true;
                    } else { lo = wave_min(nlo); hv = wave_max(nhv); }
                }
                if (!done) {
#pragma unroll 4
                    for (int j = 0; j < nch; ++j) { const int i = 64 * j + lane; const float v = sc[i]; const unsigned long long mk = __ballot(i < n && v >= lo); if (lane == j) myword = mk; }
                }
            }
            const int nwords = ((t | 255) + 1) >> 6;
            if (lane < nwords) T.MASK[((size_t)b_cur * 64 + lane) * SEQ + t] = myword;
        }
        IDXT_END(2); }
        { IDXT_BEGIN(6); CONV_STORE(); IDXT_END(6); }
#undef CONV_STORE
        if (has_next && tid_ < 128) ((LAS float*)(F.lds + WQ_OFF))[tid_] = wpre;
        if (has_next) QI_PARK();
        { IDXT_BEGIN(4); LDS_WAIT(); __builtin_amdgcn_s_barrier(); asm volatile("" ::: "memory"); IDXT_END(4); }
    }
#undef IDX_DECODE
#undef IDX_LOAD
#undef QI_FETCH
#undef QI_PARK
#undef QI_READ
}

template <bool FP8OUT> __device__ __forceinline__ void conv_phase(Frame& F, const bf16* Bg, const bf16* Z, const float* cw, bf16* Gout) {
    const int nunit = (M / 32) * 4;
    for (int uu = (blockIdx.x * NWAVES + F.wave); uu < nunit; uu += F.G * NWAVES) {
        const int run = uu >> 2, cb = (uu & 3) * 512 + F.ln() * 8, r0 = run * 32;
        float w0[8], w1[8], w2[8];
#pragma unroll
        for (int j = 0; j < 8; ++j) { w0[j] = cw[cb + j]; w1[j] = cw[DM + cb + j]; w2[j] = cw[2 * DM + cb + j]; }
        float zm2[8], zm1[8];
        const bool first = (r0 % SEQ) == 0;
        { v4u a = {0, 0, 0, 0}, bq = {0, 0, 0, 0};
          if (!first) { a = *(const v4u*)(Z + (size_t)(r0 - 2) * DM + cb); bq = *(const v4u*)(Z + (size_t)(r0 - 1) * DM + cb); }
          const unsigned aw[4] = {a.x, a.y, a.z, a.w}, bw[4] = {bq.x, bq.y, bq.z, bq.w};
#pragma unroll
          for (int j = 0; j < 4; ++j) { zm2[2 * j] = __uint_as_float(aw[j] << 16); zm2[2 * j + 1] = __uint_as_float(aw[j] & 0xffff0000u); zm1[2 * j] = __uint_as_float(bw[j] << 16); zm1[2 * j + 1] = __uint_as_float(bw[j] & 0xffff0000u); } }
#pragma unroll 4
        for (int r = 0; r < 32; ++r) {
            const v4u zz = *(const v4u*)(Z + (size_t)(r0 + r) * DM + cb), bb = *(const v4u*)(Bg + (size_t)(r0 + r) * DM + cb);
            const unsigned zw[4] = {zz.x, zz.y, zz.z, zz.w}, bw[4] = {bb.x, bb.y, bb.z, bb.w};
            float z0[8], o[8];
#pragma unroll
            for (int j = 0; j < 4; ++j) { z0[2 * j] = __uint_as_float(zw[j] << 16); z0[2 * j + 1] = __uint_as_float(zw[j] & 0xffff0000u); }
#pragma unroll
            for (int j = 0; j < 8; ++j) { const float bv = (j & 1) ? __uint_as_float(bw[j >> 1] & 0xffff0000u) : __uint_as_float(bw[j >> 1] << 16);
                o[j] = bv * (w0[j] * zm2[j] + w1[j] * zm1[j] + w2[j] * z0[j]); zm2[j] = zm1[j]; zm1[j] = z0[j]; }
            if (FP8OUT) {
#pragma unroll
                for (int j = 0; j < 8; ++j) o[j] = fminf(fmaxf(o[j] * pg8::FP8_SG, -448.f), 448.f);
                int w0 = 0, w1 = 0; w0 = __builtin_amdgcn_cvt_pk_fp8_f32(o[0], o[1], w0, false); w0 = __builtin_amdgcn_cvt_pk_fp8_f32(o[2], o[3], w0, true);
                w1 = __builtin_amdgcn_cvt_pk_fp8_f32(o[4], o[5], w1, false); w1 = __builtin_amdgcn_cvt_pk_fp8_f32(o[6], o[7], w1, true);
                v2u ov; ov.x = (unsigned)w0; ov.y = (unsigned)w1; *(v2u*)((unsigned char*)Gout + (size_t)(r0 + r) * DM + cb) = ov;
            } else {
            v4u ov; ov.x = pk2(o[0], o[1]); ov.y = pk2(o[2], o[3]); ov.z = pk2(o[4], o[5]); ov.w = pk2(o[6], o[7]);
            *(v4u*)(Gout + (size_t)(r0 + r) * DM + cb) = ov; }
        }
    }
}

#ifndef PH_P0
#define PH_P0 1
#endif
#ifndef PH_A1
#define PH_A1 1
#endif
#ifndef PH_A2
#define PH_A2 1
#endif
#ifndef PH_A3
#define PH_A3 1
#endif
#ifndef PH_A4
#define PH_A4 1
#endif
#ifndef PH_C1
#define PH_C1 1
#endif
#ifndef PH_C1B
#define PH_C1B 1
#endif
#ifndef PH_C2
#define PH_C2 1
#endif
#ifndef PH_M1
#define PH_M1 1
#endif
#ifndef PH_M2
#define PH_M2 1
#endif
struct Args { Inputs in; float* out; unsigned char* ws; int ph_lo, ph_hi; };
#ifndef DBG_REP_LAYER
#define DBG_REP_LAYER -1
#endif
#ifndef DBG_REP_P0
#define DBG_REP_P0 0
#endif
#ifndef DBG_REP_A1
#define DBG_REP_A1 0
#endif
#ifndef DBG_REP_A2
#define DBG_REP_A2 0
#endif
#ifndef DBG_REP_A3
#define DBG_REP_A3 0
#endif
#ifndef DBG_REP_A4
#define DBG_REP_A4 0
#endif
#ifndef DBG_REP_C1
#define DBG_REP_C1 0
#endif
#ifndef DBG_REP_C1B
#define DBG_REP_C1B 0
#endif
#ifndef DBG_REP_C2
#define DBG_REP_C2 0
#endif
#ifndef DBG_REP_M1
#define DBG_REP_M1 0
#endif
#ifndef DBG_REP_M2
#define DBG_REP_M2 0
#endif
constexpr size_t WS_DUMMY_OUT = WS_END + 32 * MiB, WS_DUMMY_XB = WS_END + 160 * MiB, WS_DUMMY_SSQ = WS_END + 224 * MiB;
#define REPEAT(n) _Pragma("unroll") for (int rep = 0, nrep = ((li == DBG_REP_LAYER) ? 1 + (n) : 1); rep < nrep; ++rep)
#define REPBAR do { if (rep) { if (!MK_PER_PHASE) xcd_barrier(bar); } } while (0)
#define IN(k) (lo <= (k) && (k) < hi)
#define SEAM(k) do { if (IN(k) && IN((k) + 1)) { if (!MK_PER_PHASE) xcd_barrier(bar); } } while (0)
template <int li> __device__ __forceinline__ void layer_body(Frame& F, const Args& args, const XcdBarrier& bar, const int lo, const int hi, unsigned char* lds) {
    const Inputs& I = args.in; unsigned char* ws = args.ws;
    bf16* const XB = (bf16*)(ws + WS_XB); pg8::ssq_t* const SSQ = (pg8::ssq_t*)(ws + WS_SSQ);
    const unsigned* const ropeM = (const unsigned*)(ws + WS_ROPEM); const unsigned* const ropeI = (const unsigned*)(ws + WS_ROPEI);

        const int j = li >> 1, pb = 1 + 6 * li;
        if ((li & 1) == 0) {
            STAMP(pb + 0);
            if (PH_A1 && IN(pb + 0)) REPEAT(DBG_REP_A1) { REPBAR;
                pg8::Gemm g{XB, (const bf16*)(ws + WS_WA1 + j * SZ_WA1), M, NA1, DM}; pg8::StaticOrder S; S.init(M, NA1, F.G, (int)blockIdx.x);
                pg8::EpiA1 E{SSQ + (size_t)(2 * li) * M, (bf16*)(ws + WS_Q), (bf16*)(ws + WS_K), (bf16*)(ws + WS_V), (bf16*)(ws + WS_QI), (bf16*)(ws + WS_KI), (float*)(ws + WS_WI),
                             (const float*)(ws + WS_QG) + j * 128, (const float*)(ws + WS_KG) + j * 128, ropeM, ropeI, (PG8_LAS float*)(F.lds + AUX_OFF)};
                pg8::gemm_phase<pg8::EpiA1, pg8::StaticOrder, true, true>(F.lds + RING_OFF, g, S, E, F.wave);
                if (DEFER_CONV) {
                    const bool part = F.G == 256; const int bx = (int)blockIdx.x;
                    if (!part || bx >= 64) { const Inputs Iw = *(const Inputs*)(ws + WS_INPTR);
                        convert_ranges(F, Iw, ranges_deferred(j), (part ? bx - 64 : bx) * NWAVES + F.wave, (part ? 192 : F.G) * NWAVES); } }
            } SEAM(pb + 0);
            STAMP(pb + 1);
            if (PH_A2 && IN(pb + 1)) REPEAT(DBG_REP_A2) { REPBAR; IdxTensors T{(const bf16*)(ws + WS_QI), (const bf16*)(ws + WS_KI), (const float*)(ws + WS_WI), (unsigned long long*)(ws + WS_MASK), args.out};
#if defined(DBG_DUMP)
                for (size_t e = (size_t)blockIdx.x * 512 + F.td(); e < (size_t)M * DM; e += (size_t)F.G * 512) { const int row = (int)(e / DM), c = (int)(e % DM); float v = 0.f;
                    if (c < 1024) v = bf2f(T.QI[(size_t)row * 1024 + c]); else if (c < 1088) v = bf2f(T.KI[(size_t)row * 64 + c - 1024]); else if (c < 1104) v = T.WI[(size_t)row * 16 + c - 1088];
                    args.out[e] = v; }
#else
                idx_phase(F, T, j);
#endif
                } SEAM(pb + 1);
            STAMP(pb + 2);
            if (PH_A3 && IN(pb + 2)) REPEAT(DBG_REP_A3) { REPBAR; const att::Tensors T{(const att::bf16*)(ws + WS_Q), (const att::bf16*)(ws + WS_K), (const att::bf16*)(ws + WS_V), (att::bf16*)(ws + WS_O), (const att::u64*)(ws + WS_MASK)};
                att::attn_phase((char*)lds + RING_OFF, T, (int)blockIdx.x, F.G, F.wave); } SEAM(pb + 2);
            STAMP(pb + 3);
            if (PH_A4 && IN(pb + 3)) REPEAT(DBG_REP_A4) { REPBAR; const bool dummy = rep + 1 < nrep;
                pg8::Gemm g{(const bf16*)(ws + DBG_A4_SRC), (const bf16*)(ws + WS_WA4 + j * SZ_WSQ), M, DM, DM}; pg8::StaticOrder S; S.init(M, DM, F.G, (int)blockIdx.x);
                pg8::EpiRes<false, ((M1_FP8 >> li) & 1) != 0> E{XB, dummy ? (bf16*)(ws + WS_DUMMY_XB) : XB, nullptr, dummy ? (pg8::ssq_t*)(ws + WS_DUMMY_SSQ) : SSQ + (size_t)(2 * li + 1) * M, 1.0f, ws + WS_XB8};
                pg8::gemm_phase<pg8::EpiRes<false, ((M1_FP8 >> li) & 1) != 0>, pg8::StaticOrder, PG8_ALIGN_X, PG8_SP2_X>(F.lds + RING_OFF, g, S, E, F.wave);
            } SEAM(pb + 3);
        } else {
            STAMP(pb + 0);
            if (PH_C1 && IN(pb + 0)) REPEAT(DBG_REP_C1) { REPBAR;
                constexpr bool c1f8 = ((C1_FP8 >> li) & 1) != 0;
                pg8::Gemm g{c1f8 ? (const bf16*)(ws + WS_XB8) : XB, (const bf16*)(ws + WS_WC1 + j * SZ_WC1), M, NC1, c1f8 ? DM / 2 : DM}; pg8::StaticOrder S; S.init(M, NC1, F.G, (int)blockIdx.x);
                pg8::EpiC1 E{(bf16*)(ws + WS_BG), (bf16*)(ws + WS_Z), SSQ + (size_t)(2 * li) * M, c1f8 ? 1.0f / (pg8::FP8_SX * pg8::FP8_SWI) : 1.0f};
                pg8::gemm_phase<pg8::EpiC1, pg8::StaticOrder, PG8_ALIGN_X, PG8_SP2_X, c1f8>(F.lds + RING_OFF, g, S, E, F.wave);
            } SEAM(pb + 0);
            STAMP(pb + 1);
            if (PH_C1B && IN(pb + 1)) REPEAT(DBG_REP_C1B) { REPBAR; conv_phase<((C2_FP8 >> li) & 1) != 0>(F, (const bf16*)(ws + WS_BG), (const bf16*)(ws + WS_Z), (const float*)(ws + WS_CONVW) + (size_t)j * 3 * DM, (bf16*)(ws + WS_G)); } SEAM(pb + 1);
            STAMP(pb + 2);
            if (PH_C2 && IN(pb + 2)) REPEAT(DBG_REP_C2) { REPBAR; const bool dummy = rep + 1 < nrep;
                pg8::Gemm g{(const bf16*)(ws + WS_G), (const bf16*)(ws + WS_WC2 + j * SZ_WSQ), M, DM, ((C2_FP8 >> li) & 1) ? DM / 2 : DM}; pg8::StaticOrder S; S.init(M, DM, F.G, (int)blockIdx.x);
                pg8::EpiRes<false, ((M1_FP8 >> li) & 1) != 0> E{XB, dummy ? (bf16*)(ws + WS_DUMMY_XB) : XB, nullptr, dummy ? (pg8::ssq_t*)(ws + WS_DUMMY_SSQ) : SSQ + (size_t)(2 * li + 1) * M, ((C2_FP8 >> li) & 1) ? 1.0f / (pg8::FP8_SG * pg8::FP8_SWC) : 1.0f, ws + WS_XB8};
                pg8::gemm_phase<pg8::EpiRes<false, ((M1_FP8 >> li) & 1) != 0>, pg8::StaticOrder, PG8_ALIGN_X, PG8_SP2_X, ((C2_FP8 >> li) & 1) != 0>(F.lds + RING_OFF, g, S, E, F.wave);
            } SEAM(pb + 2);
            STAMP(pb + 3);
        }
        STAMP(pb + 4);
        if (PH_M1 && IN(pb + 4)) REPEAT(DBG_REP_M1) { REPBAR;
            constexpr bool m1f8 = ((M1_FP8 >> li) & 1) != 0;
            pg8::Gemm g{m1f8 ? (const bf16*)(ws + WS_XB8) : XB, (const bf16*)(ws + WS_WM1 + li * SZ_WM), M, DFF, m1f8 ? DM / 2 : DM}; pg8::StaticOrder S; S.init(M, DFF, F.G, (int)blockIdx.x);
            pg8::EpiM1<((MLP_FP8 >> li) & 1) != 0> E{(bf16*)(ws + WS_H), SSQ + (size_t)(2 * li + 1) * M, m1f8 ? 1.0f / (pg8::FP8_SX * pg8::FP8_SWI) : 1.0f};
            pg8::gemm_phase<pg8::EpiM1<((MLP_FP8 >> li) & 1) != 0>, pg8::StaticOrder, PG8_ALIGN_X, PG8_SP2_X, m1f8>(F.lds + RING_OFF, g, S, E, F.wave);
        } SEAM(pb + 4);
        STAMP(pb + 5);
        if (PH_M2 && IN(pb + 5)) REPEAT(DBG_REP_M2) { REPBAR; const bool dummy = rep + 1 < nrep;
            pg8::Gemm g{(const bf16*)(ws + WS_H), (const bf16*)(ws + WS_WM2 + li * SZ_WM), M, DM, ((MLP_FP8 >> li) & 1) ? DFF / 2 : DFF}; pg8::StaticOrder S; S.init(M, DM, F.G, (int)blockIdx.x);
            constexpr bool nx8 = li + 1 < DEPTH && ((C1_FP8 >> (li + 1)) & 1) != 0;
            pg8::EpiRes<li == DEPTH - 1, nx8> E{XB, dummy ? (bf16*)(ws + WS_DUMMY_XB) : XB, dummy ? (float*)(ws + WS_DUMMY_OUT) : args.out, dummy ? (pg8::ssq_t*)(ws + WS_DUMMY_SSQ) : SSQ + (size_t)(2 * li + 2) * M, ((MLP_FP8 >> li) & 1) ? 1.0f / (pg8::FP8_SA * pg8::FP8_SW) : 1.0f, ws + WS_XB8};
            pg8::gemm_phase<pg8::EpiRes<li == DEPTH - 1, nx8>, pg8::StaticOrder, PG8_ALIGN_X, (((MLP_FP8 >> li) & 1) ? PG8_SP2_F8 : PG8_SP2_X), ((MLP_FP8 >> li) & 1) != 0>(F.lds + RING_OFF, g, S, E, F.wave);
        } SEAM(pb + 5);
    }
#undef IN
#undef SEAM
__global__ void __launch_bounds__(NWAVES * 64, 2) trunk_fwd(Args args) {
    extern __shared__ __attribute__((aligned(16))) unsigned char lds[];
    Frame F;
    F.lds = (LAS unsigned char*)lds;
    F.MISC = (volatile LAS unsigned*)(F.lds + MISC_OFF);
    F.wave = __builtin_amdgcn_readfirstlane((int)threadIdx.x >> 6);
    F.G = gridDim.x; { const int bx = blockIdx.x; F.vcu = (F.G % 8 == 0) ? (bx % 8) * (F.G / 8) + bx / 8 : bx; }
    F.ws = args.ws; F.ctl = (gu32*)(args.ws + WS_CTL);
    for (int u = F.td(); u < 64; u += NWAVES * 64) ((LAS unsigned*)(F.lds + MISC_OFF))[u] = 0u;
    __syncthreads();
    XcdBarrier bar; bar.bar = (unsigned*)(F.ctl + CW_BAR); bar.x = 0; bar.st = nullptr; bar.wv = (unsigned)F.wave;
    if (!MK_PER_PHASE) bar = xcd_barrier_post((unsigned*)(F.ctl + CW_BAR), F.MISC + 8, (unsigned)F.wave);
    const int lo = args.ph_lo, hi = args.ph_hi;
    const Inputs& I = args.in;
    unsigned char* ws = args.ws;
#define IN(k) (lo <= (k) && (k) < hi)
#define SEAM(k) do { if (IN(k) && IN((k) + 1)) { if (!MK_PER_PHASE) xcd_barrier(bar); } } while (0)
    bf16* const XB = (bf16*)(ws + WS_XB);
    pg8::ssq_t* const SSQ = (pg8::ssq_t*)(ws + WS_SSQ);
    const unsigned* const ropeM = (const unsigned*)(ws + WS_ROPEM); const unsigned* const ropeI = (const unsigned*)(ws + WS_ROPEI);

    STAMP(0);
    if (PH_P0 && IN(0)) { for (int rep = 0; rep < 1 + DBG_REP_P0; ++rep) { if (rep) xcd_barrier(bar); p0_prologue(F, I, args.out); } } SEAM(0);

    layer_body<0>(F, args, bar, lo, hi, lds); layer_body<1>(F, args, bar, lo, hi, lds); layer_body<2>(F, args, bar, lo, hi, lds); layer_body<3>(F, args, bar, lo, hi, lds);
    STAMP(1 + 6 * DEPTH);
#if defined(DBG_EPI_TYPE)
    if (blockIdx.x == 0 && threadIdx.x == 0) { const unsigned long long dt = (unsigned long long)F.MISC[20] * 9ull, t0 = __builtin_amdgcn_s_memrealtime(); while (__builtin_amdgcn_s_memrealtime() - t0 < dt) __builtin_amdgcn_s_sleep(8); }
#endif
    if ((DBG_IDX_TIME > 0 || DBG_P0_TIME > 0) && blockIdx.x == 0 && threadIdx.x == 0) { const unsigned long long dt = (unsigned long long)F.MISC[20] * 9ull, t0 = __builtin_amdgcn_s_memrealtime(); while (__builtin_amdgcn_s_memrealtime() - t0 < dt) __builtin_amdgcn_s_sleep(8); }
    if (DBG_CLK_PHASE >= 0 && blockIdx.x == 0 && threadIdx.x == 0) {
        const unsigned long long c0 = (unsigned long long)F.MISC[32] | ((unsigned long long)F.MISC[33] << 32), r0 = (unsigned long long)F.MISC[34] | ((unsigned long long)F.MISC[35] << 32);
        const unsigned long long c1 = (unsigned long long)F.MISC[36] | ((unsigned long long)F.MISC[37] << 32), r1 = (unsigned long long)F.MISC[38] | ((unsigned long long)F.MISC[39] << 32);
        const unsigned long long dt = (r1 > r0) ? ((c1 - c0) * 1000ull) / (r1 - r0) : 0ull, t0 = __builtin_amdgcn_s_memrealtime(); while (__builtin_amdgcn_s_memrealtime() - t0 < dt) __builtin_amdgcn_s_sleep(8); }
    if (DBG_TIME_PHASE >= 0 && blockIdx.x == 0 && threadIdx.x == 0) { const unsigned long long tsA = (unsigned long long)F.MISC[16] | ((unsigned long long)F.MISC[17] << 32), tsB = (unsigned long long)F.MISC[18] | ((unsigned long long)F.MISC[19] << 32); const unsigned long long dt = (tsB - tsA) * 9ull, t0 = __builtin_amdgcn_s_memrealtime(); while (__builtin_amdgcn_s_memrealtime() - t0 < dt) __builtin_amdgcn_s_sleep(8); }
#undef IN
#undef SEAM
}

#ifndef DBG_NPH
#define DBG_NPH (1 + 6 * DEPTH)
#endif
constexpr int N_PHASES = DBG_NPH;
extern "C" void kernel_launch(void* const* d_in, const int* in_sizes, int n_in, void* d_out, int out_size, void* d_ws, size_t ws_size, hipStream_t stream) {
    static int grid = 0;
    if (grid == 0) {
        if (n_in != 14 || in_sizes[0] != M * DM || out_size != M * DM || ws_size < WS_END + 32 * MiB + (DBG_REP_LAYER >= 0 ? 232 * MiB : 0)) { fprintf(stderr, "kernel_launch: shape/workspace mismatch (n_in %d, in0 %d, out %d, ws %zu, need %zu)\n", n_in, n_in > 0 ? in_sizes[0] : -1, out_size, ws_size, (size_t)WS_END); grid = -1; return; }
        int dev = 0, cus = 0, per_cu = 0;
        if (hipGetDevice(&dev) != hipSuccess || hipDeviceGetAttribute(&cus, hipDeviceAttributeMultiprocessorCount, dev) != hipSuccess) { grid = -1; return; }
        if (hipFuncSetAttribute((const void*)trunk_fwd, hipFuncAttributeMaxDynamicSharedMemorySize, LDS_BYTES) != hipSuccess) { fprintf(stderr, "kernel_launch: hipFuncSetAttribute failed\n"); grid = -1; return; }
        if (hipOccupancyMaxActiveBlocksPerMultiprocessor(&per_cu, (const void*)trunk_fwd, NWAVES * 64, LDS_BYTES) != hipSuccess || per_cu < 1) fprintf(stderr, "kernel_launch: occupancy query reports %d\n", per_cu);
        (void)hipGetLastError();
        grid = cus;
    }
    if (grid < 0) return;
    if (hipMemsetAsync((char*)d_ws + WS_CTL, 0, CTL_ZERO_BYTES, stream) != hipSuccess) { fprintf(stderr, "kernel_launch: memset failed\n"); return; }
    Args a{};
    a.in.x = (const float*)d_in[0]; a.in.pos = (const int*)d_in[1]; a.in.attn_norm_g = (const float*)d_in[2]; a.in.attn_w_in = (const float*)d_in[3]; a.in.attn_q_g = (const float*)d_in[4];
    a.in.attn_k_g = (const float*)d_in[5]; a.in.attn_w_out = (const float*)d_in[6]; a.in.conv_norm_g = (const float*)d_in[7]; a.in.conv_w_in = (const float*)d_in[8]; a.in.conv_w = (const float*)d_in[9];
    a.in.conv_w_out = (const float*)d_in[10]; a.in.mlp_norm_g = (const float*)d_in[11]; a.in.mlp_w1 = (const float*)d_in[12]; a.in.mlp_w2 = (const float*)d_in[13];
    a.out = (float*)d_out; a.ws = (unsigned char*)d_ws;
#if MK_PER_PHASE
    for (int ph = 0; ph < N_PHASES; ++ph) {
        const int li = (ph - 1) / 6, k = (ph - 1) % 6;
        if (ph > 0 && (li & 1) == 1 && k == 3) continue;
        a.ph_lo = ph; a.ph_hi = ph + 1;
        hipLaunchKernelGGL(trunk_fwd, dim3(grid), dim3(NWAVES * 64), LDS_BYTES, stream, a);
    }
#else
    a.ph_lo = 0; a.ph_hi = N_PHASES;
    hipLaunchKernelGGL(trunk_fwd, dim3(grid), dim3(NWAVES * 64), LDS_BYTES, stream, a);
#endif
    const hipError_t le = hipPeekAtLastError();
    if (le != hipSuccess) fprintf(stderr, "kernel_launch: launch failed: %s\n", hipGetErrorName(le));
}
```
